# Optimizing an MI355X kernel written in HIP

```python
import math
import jax, jax.numpy as jnp
from jax import lax
import numpy as np

D_MODEL = 1024
BATCH = 8
SEQ = 2048
DEPTH = 1
DEC_BATCH = 4
DEC_SEQ = 8192
PAST_LEN = 128

GLA_HEADS = 4
GLA_DK = 64
GLA_DV = 128
GLA_QK_WIDTH = GLA_HEADS * GLA_DK
GLA_WIDTH = GLA_HEADS * GLA_DV
GLA_GATE_RANK = 16
GLA_GATE_TAU = 16.0
GLA_CHUNK = 64
RWKV_HEAD = 64
RWKV_WIDTH = D_MODEL - GLA_WIDTH
RWKV_HEADS = RWKV_WIDTH // RWKV_HEAD
RWKV_DECAY_RANK = 64
RWKV_AAA_RANK = 64
RWKV_GATE_RANK = 128
RWKV_GN_EPS = 64e-5
MIX_WIDTH = GLA_WIDTH + RWKV_WIDTH
GLA_SPLITS = (GLA_QK_WIDTH, GLA_QK_WIDTH, GLA_WIDTH, GLA_WIDTH, GLA_GATE_RANK, GLA_GATE_RANK)
RWKV_SPLITS = (RWKV_WIDTH, RWKV_WIDTH, RWKV_WIDTH, RWKV_DECAY_RANK, RWKV_DECAY_RANK, RWKV_AAA_RANK, RWKV_GATE_RANK)
GLA_COLS = sum(GLA_SPLITS)
RWKV_COLS = sum(RWKV_SPLITS)
IN_COLS = GLA_COLS + RWKV_COLS
D_FF = 2816
MEM_TOKENS = 256
MEM_HEADS = 4
MEM_HEAD_DIM = D_MODEL // MEM_HEADS
LN_EPS = 1e-5
DEEPNORM_ALPHA = (2.0 * DEPTH) ** 0.25
DEEPNORM_BETA = (8.0 * DEPTH) ** -0.25

kernel_name = 'hybrid_gla_rwkv7_macaron_encoder'


def _split(t, sizes):
    offs = np.cumsum(np.array(sizes))[:-1].tolist()
    return jnp.split(t, offs, axis=-1)


def _layer_norm(x, g, b, eps=LN_EPS):
    xf = x.astype(jnp.float32)
    mu = jnp.mean(xf, axis=-1, keepdims=True)
    var = jnp.mean(jnp.square(xf - mu), axis=-1, keepdims=True)
    return ((xf - mu) * lax.rsqrt(var + eps) * g + b).astype(x.dtype)


def _swiglu(x, w_in, w_out):
    gate, up = jnp.split(x @ w_in, 2, axis=-1)
    return (jax.nn.silu(gate) * up) @ w_out


def _gla_chunked(q, k, v, log_a):
    B, T, H, DK = q.shape
    DV = v.shape[-1]
    C = GLA_CHUNK
    n = T // C

    def blocks(t):
        return t.reshape(B, n, C, H, t.shape[-1]).transpose(0, 3, 1, 2, 4)

    q, k, v, log_a = blocks(q), blocks(k), blocks(v), blocks(log_a)
    b = jnp.cumsum(log_a, axis=3)
    b_last = b[:, :, :, -1:, :]
    b_ref = 0.5 * b_last
    scores = jnp.einsum('bhncd,bhnsd->bhncs', q * jnp.exp(b - b_ref), k * jnp.exp(b_ref - b))
    prefix_mask = jnp.tril(jnp.ones((C, C), dtype=bool))
    scores = jnp.where(prefix_mask, scores, 0.0)
    o_intra = jnp.einsum('bhncs,bhnse->bhnce', scores, v)
    kv = jnp.einsum('bhncd,bhnce->nbhde', k * jnp.exp(b_last - b), v)
    chunk_decay = jnp.exp(b_last[:, :, :, 0, :]).transpose(2, 0, 1, 3)

    def step(S, inp):
        dec, kv_n = inp
        return dec[..., None] * S + kv_n, S

    _, S_prev = lax.scan(step, jnp.zeros((B, H, DK, DV), jnp.float32), (chunk_decay, kv))
    o_inter = jnp.einsum('bhncd,nbhde->bhnce', q * jnp.exp(b), S_prev)
    o = o_intra + o_inter
    return o.transpose(0, 2, 3, 1, 4).reshape(B, T, H, DV)


def _rwkv7_scan(r, decay, k, v, kk, a, reverse):
    B, T, H, N = r.shape
    xs = tuple(t.transpose(1, 0, 2, 3) for t in (r, decay, k, v, kk, a))

    def step(S, inp):
        r_t, w_t, k_t, v_t, kk_t, a_t = inp
        sa = jnp.einsum('bhij,bhj->bhi', S, -kk_t)
        S = (S * w_t[:, :, None, :] + sa[..., None] * (kk_t * a_t)[:, :, None, :]
             + v_t[..., None] * k_t[:, :, None, :])
        y = jnp.einsum('bhij,bhj->bhi', S, r_t)
        return S, y

    _, y = lax.scan(step, jnp.zeros((B, H, N, N), jnp.float32), xs, reverse=reverse)
    return y.transpose(1, 0, 2, 3)


def _token_mix(h, w_in, gla_gate_up_fwd, gla_gate_b_fwd, gla_gate_up_bwd, gla_gate_b_bwd, gla_norm_g,
               rwkv_mu_prev, rwkv_mu_next, rwkv_w0_fwd, rwkv_w_up_fwd, rwkv_w0_bwd, rwkv_w_up_bwd,
               rwkv_a0, rwkv_a_up, rwkv_g_up, rwkv_k_k, rwkv_k_a, rwkv_r_k, rwkv_lnx_g, rwkv_lnx_b, w_out):
    B, T, _ = h.shape
    f32 = jnp.float32
    proj = h @ w_in
    gla_p, rw_p = proj[..., :GLA_COLS], proj[..., GLA_COLS:]

    def heads(t, d):
        return t.astype(f32).reshape(B, T, -1, d)

    flip = lambda t: jnp.flip(t, axis=1)

    q, k, v, g, gd_f, gd_b = _split(gla_p, GLA_SPLITS)
    q = heads(q, GLA_DK) * (GLA_DK ** -0.5)
    k = heads(k, GLA_DK)
    v = heads(v, GLA_DV)
    la_f = heads(jax.nn.log_sigmoid(gd_f @ gla_gate_up_fwd + gla_gate_b_fwd), GLA_DK) / GLA_GATE_TAU
    la_b = heads(jax.nn.log_sigmoid(gd_b @ gla_gate_up_bwd + gla_gate_b_bwd), GLA_DK) / GLA_GATE_TAU
    o = _gla_chunked(q, k, v, la_f) + flip(_gla_chunked(flip(q), flip(k), flip(v), flip(la_b)))
    o = o * lax.rsqrt(jnp.mean(jnp.square(o), axis=-1, keepdims=True) + LN_EPS)
    o = o.reshape(B, T, GLA_WIDTH) * gla_norm_g * jax.nn.silu(g.astype(f32))

    prev = jnp.pad(rw_p[:, :-1], ((0, 0), (1, 0), (0, 0)))
    nxt = jnp.pad(rw_p[:, 1:], ((0, 0), (0, 1), (0, 0)))
    rw = rw_p + rwkv_mu_prev * (prev - rw_p) + rwkv_mu_next * (nxt - rw_p)
    r, kr, vr, wd_f, wd_b, ad, gd = _split(rw, RWKV_SPLITS)

    def decay(wd, w0, up):
        w = -jax.nn.softplus(-(w0 + jnp.tanh(wd) @ up).astype(f32)) - 0.5
        return heads(jnp.exp(-jnp.exp(w)), RWKV_HEAD)

    dec_f = decay(wd_f, rwkv_w0_fwd, rwkv_w_up_fwd)
    dec_b = decay(wd_b, rwkv_w0_bwd, rwkv_w_up_bwd)
    a = jax.nn.sigmoid((rwkv_a0 + ad @ rwkv_a_up).astype(f32))
    gate = (jax.nn.sigmoid(gd) @ rwkv_g_up).astype(f32)
    kr = kr.astype(f32)
    kk = heads(kr * rwkv_k_k, RWKV_HEAD)
    kk = kk / jnp.maximum(jnp.sqrt(jnp.sum(jnp.square(kk), axis=-1, keepdims=True)), 1e-12)
    k2 = heads(kr * (1.0 + (a - 1.0) * rwkv_k_a), RWKV_HEAD)
    rH = heads(r, RWKV_HEAD)
    vH = heads(vr, RWKV_HEAD)
    aH = heads(a, RWKV_HEAD)
    y = (_rwkv7_scan(rH, dec_f, k2, vH, kk, aH, reverse=False)
         + _rwkv7_scan(rH, dec_b, k2, vH, kk, aH, reverse=True))
    mu = jnp.mean(y, axis=-1, keepdims=True)
    var = jnp.mean(jnp.square(y - mu), axis=-1, keepdims=True)
    y = ((y - mu) * lax.rsqrt(var + RWKV_GN_EPS)).reshape(B, T, RWKV_WIDTH) * rwkv_lnx_g + rwkv_lnx_b
    bonus = (jnp.sum(rH * k2 * rwkv_r_k, axis=-1, keepdims=True) * vH).reshape(B, T, RWKV_WIDTH)
    y = (y + bonus) * gate

    mixed = jnp.concatenate([o, y], axis=-1).astype(h.dtype)
    return mixed @ w_out


def _memory_attn(h, mem, mem_ln_g, mem_ln_b, w_q, w_kv, w_o):
    B, T, _ = h.shape
    M = mem.shape[1]
    m = _layer_norm(mem, mem_ln_g, mem_ln_b)
    q = (h @ w_q).reshape(B, T, MEM_HEADS, MEM_HEAD_DIM)
    k, v = jnp.split(m @ w_kv, 2, axis=-1)
    k = k.reshape(B, M, MEM_HEADS, MEM_HEAD_DIM)
    v = v.reshape(B, M, MEM_HEADS, MEM_HEAD_DIM)
    s = jnp.einsum('bthd,bmhd->bhtm', q, k).astype(jnp.float32) * (MEM_HEAD_DIM ** -0.5)
    p = jax.nn.softmax(s, axis=-1).astype(v.dtype)
    o = jnp.einsum('bhtm,bmhd->bthd', p, v).reshape(B, T, D_MODEL)
    return o @ w_o


def setup_inputs(seed: int = 0) -> dict:
    key = jax.random.key(seed)
    keys = iter(jax.random.split(key, 64))
    f32 = jnp.float32
    L = DEPTH

    def nrm(shape, scale):
        return scale * jax.random.normal(next(keys), shape, f32)

    def gain(n):
        return 1.0 + nrm((L, n), 0.02)

    def bias(n):
        return nrm((L, n), 0.02)

    d = D_MODEL
    return {
        'x_prompt': nrm((BATCH, SEQ, d), 1.0),
        'x_sample': nrm((DEC_BATCH, DEC_SEQ, d), 1.0),
        'mem_prompt': nrm((BATCH, MEM_TOKENS, d), 1.0),
        'mem_sample': nrm((DEC_BATCH, MEM_TOKENS, d), 1.0),
        'ffn1_w_in': nrm((L, d, 2 * D_FF), d ** -0.5),
        'ffn1_w_out': nrm((L, D_FF, d), DEEPNORM_BETA * D_FF ** -0.5),
        'ln_ffn1_g': gain(d),
        'ln_ffn1_b': bias(d),
        'mix_w_in': nrm((L, d, IN_COLS), d ** -0.5),
        'gla_gate_up_fwd': nrm((L, GLA_GATE_RANK, GLA_QK_WIDTH), GLA_GATE_RANK ** -0.5),
        'gla_gate_b_fwd': nrm((L, GLA_QK_WIDTH), 0.1),
        'gla_gate_up_bwd': nrm((L, GLA_GATE_RANK, GLA_QK_WIDTH), GLA_GATE_RANK ** -0.5),
        'gla_gate_b_bwd': nrm((L, GLA_QK_WIDTH), 0.1),
        'gla_norm_g': gain(GLA_WIDTH),
        'rwkv_mu_prev': jax.random.uniform(next(keys), (L, RWKV_COLS), f32, 0.1, 0.5),
        'rwkv_mu_next': jax.random.uniform(next(keys), (L, RWKV_COLS), f32, 0.1, 0.5),
        'rwkv_w0_fwd': -2.0 + nrm((L, RWKV_WIDTH), 0.5),
        'rwkv_w_up_fwd': nrm((L, RWKV_DECAY_RANK, RWKV_WIDTH), 0.1 * RWKV_DECAY_RANK ** -0.5),
        'rwkv_w0_bwd': -2.0 + nrm((L, RWKV_WIDTH), 0.5),
        'rwkv_w_up_bwd': nrm((L, RWKV_DECAY_RANK, RWKV_WIDTH), 0.1 * RWKV_DECAY_RANK ** -0.5),
        'rwkv_a0': nrm((L, RWKV_WIDTH), 0.1),
        'rwkv_a_up': nrm((L, RWKV_AAA_RANK, RWKV_WIDTH), 0.5 * RWKV_AAA_RANK ** -0.5),
        'rwkv_g_up': nrm((L, RWKV_GATE_RANK, RWKV_WIDTH), RWKV_GATE_RANK ** -0.5),
        'rwkv_k_k': 0.85 + nrm((L, RWKV_WIDTH), 0.05),
        'rwkv_k_a': 1.0 + nrm((L, RWKV_WIDTH), 0.05),
        'rwkv_r_k': nrm((L, RWKV_HEADS, RWKV_HEAD), 0.1),
        'rwkv_lnx_g': gain(RWKV_WIDTH),
        'rwkv_lnx_b': bias(RWKV_WIDTH),
        'mix_w_out': nrm((L, MIX_WIDTH, d), DEEPNORM_BETA * MIX_WIDTH ** -0.5),
        'ln_mix_g': gain(d),
        'ln_mix_b': bias(d),
        'mem_ln_g': gain(d),
        'mem_ln_b': bias(d),
        'ca_w_q': nrm((L, d, d), d ** -0.5),
        'ca_w_kv': nrm((L, d, 2 * d), d ** -0.5),
        'ca_w_o': nrm((L, d, d), DEEPNORM_BETA * d ** -0.5),
        'ln_ca_g': gain(d),
        'ln_ca_b': bias(d),
        'ffn2_w_in': nrm((L, d, 2 * D_FF), d ** -0.5),
        'ffn2_w_out': nrm((L, D_FF, d), DEEPNORM_BETA * D_FF ** -0.5),
        'ln_ffn2_g': gain(d),
        'ln_ffn2_b': bias(d),
    }


def reference(x_prompt, x_sample, mem_prompt, mem_sample,
              ffn1_w_in, ffn1_w_out, ln_ffn1_g, ln_ffn1_b,
              mix_w_in, gla_gate_up_fwd, gla_gate_b_fwd, gla_gate_up_bwd, gla_gate_b_bwd, gla_norm_g,
              rwkv_mu_prev, rwkv_mu_next, rwkv_w0_fwd, rwkv_w_up_fwd, rwkv_w0_bwd, rwkv_w_up_bwd,
              rwkv_a0, rwkv_a_up, rwkv_g_up, rwkv_k_k, rwkv_k_a, rwkv_r_k, rwkv_lnx_g, rwkv_lnx_b,
              mix_w_out, ln_mix_g, ln_mix_b,
              mem_ln_g, mem_ln_b, ca_w_q, ca_w_kv, ca_w_o, ln_ca_g, ln_ca_b,
              ffn2_w_in, ffn2_w_out, ln_ffn2_g, ln_ffn2_b):
    alpha = DEEPNORM_ALPHA

    def layer(x, mem, l):
        x = _layer_norm(alpha * x + 0.5 * _swiglu(x, ffn1_w_in[l], ffn1_w_out[l]), ln_ffn1_g[l], ln_ffn1_b[l])
        tm = _token_mix(x, mix_w_in[l], gla_gate_up_fwd[l], gla_gate_b_fwd[l], gla_gate_up_bwd[l],
                        gla_gate_b_bwd[l], gla_norm_g[l], rwkv_mu_prev[l], rwkv_mu_next[l],
                        rwkv_w0_fwd[l], rwkv_w_up_fwd[l], rwkv_w0_bwd[l], rwkv_w_up_bwd[l],
                        rwkv_a0[l], rwkv_a_up[l], rwkv_g_up[l], rwkv_k_k[l], rwkv_k_a[l], rwkv_r_k[l],
                        rwkv_lnx_g[l], rwkv_lnx_b[l], mix_w_out[l])
        x = _layer_norm(alpha * x + tm, ln_mix_g[l], ln_mix_b[l])
        ca = _memory_attn(x, mem, mem_ln_g[l], mem_ln_b[l], ca_w_q[l], ca_w_kv[l], ca_w_o[l])
        x = _layer_norm(alpha * x + ca, ln_ca_g[l], ln_ca_b[l])
        x = _layer_norm(alpha * x + 0.5 * _swiglu(x, ffn2_w_in[l], ffn2_w_out[l]), ln_ffn2_g[l], ln_ffn2_b[l])
        return x

    y_prompt = x_prompt
    y_sample = x_sample
    for l in range(DEPTH):
        y_prompt = layer(y_prompt, mem_prompt, l)
        y_sample = layer(y_sample, mem_sample, l)
    return (y_prompt, y_sample)
```

```cpp
#include <hip/hip_runtime.h>
#include <hip/hip_bf16.h>
#include <hip/hip_cooperative_groups.h>
#include <cstdio>
namespace cg = cooperative_groups;

#ifndef MULTI_LAUNCH
#define MULTI_LAUNCH 1
#endif

typedef unsigned short bf16_t;
using bf16x8 = __attribute__((ext_vector_type(8))) short;
using f32x16 = __attribute__((ext_vector_type(16))) float;
using u32x4 = __attribute__((ext_vector_type(4))) unsigned;

#define DEV __device__ __forceinline__

constexpr int NTOK = 49152;
constexpr int NPROMPT = 16384;
constexpr int DM = 1024;
constexpr int DFF = 2816;
constexpr int GLA_LD = 1568;
constexpr int RW_LD = 1856;
constexpr float ALPHA = 1.189207115002721f;
constexpr size_t MiB = 1ull << 20;
constexpr size_t SLAB = (size_t)NTOK * 512;

constexpr size_t W_A_FFN_IN = 0, W_A_FFN_OUT = 11 * MiB, W_A_MIX_IN = 17 * MiB, W_A_UPF = 24 * MiB,
                 W_A_UPB = 24 * MiB + 65536, W_A_AUP = 24 * MiB + 2 * 65536, W_A_GUP = 24 * MiB + 3 * 65536;
constexpr size_t W_B_MIX_OUT = 0, W_B_Q = 2 * MiB, W_B_KV = 4 * MiB, W_B_O = 8 * MiB, W_B_FFN_IN = 10 * MiB, W_B_FFN_OUT = 21 * MiB;
constexpr size_t O_XB = 27 * MiB;
constexpr size_t O_H = 123 * MiB;
constexpr size_t O_KV = 270 * MiB;
constexpr size_t O_DEC = 462 * MiB;
constexpr size_t O_DER = 297 * MiB;
constexpr size_t O_ACTG = 441 * MiB;
constexpr size_t O_BONUS = 453 * MiB;
constexpr size_t O_MIXG = 464 * MiB;
constexpr size_t O_MEMB = 219 * MiB, O_KB = 225 * MiB, O_VT = 231 * MiB, O_SCORES = 237 * MiB;
constexpr size_t WS_NEED = 512 * MiB;

struct Params {
  const float* in[42];
  float* out;
  char* ws;
};

DEV bf16_t f2bf(float f) {
  unsigned u = __float_as_uint(f);
  u += 0x7fffu + ((u >> 16) & 1u);
  return (bf16_t)(u >> 16);
}
DEV float bf2f(bf16_t b) { return __uint_as_float(((unsigned)b) << 16); }
DEV unsigned pack2(float a, float b) { return (unsigned)f2bf(a) | ((unsigned)f2bf(b) << 16); }
DEV float sigm(float x) { return 1.f / (1.f + __expf(-x)); }
DEV float silu(float x) { return x * sigm(x); }
DEV float logsig(float x) { return fminf(x, 0.f) - log1pf(__expf(-fabsf(x))); }
DEV float wave_sum(float v) {
#pragma unroll
  for (int o = 32; o > 0; o >>= 1) v += __shfl_xor(v, o);
  return v;
}
DEV float wave_max(float v) {
#pragma unroll
  for (int o = 32; o > 0; o >>= 1) v = fmaxf(v, __shfl_xor(v, o));
  return v;
}
template <int CTRL> DEV float dppf(float x) {
  return __builtin_bit_cast(float, __builtin_amdgcn_mov_dpp(__builtin_bit_cast(int, x), CTRL, 0xf, 0xf, true));
}
DEV float row16_sum(float x) {
  x += dppf<0x128>(x);
  x += dppf<0x124>(x);
  x += dppf<0x122>(x);
  x += dppf<0x121>(x);
  return x;
}
DEV void seq_of_token(int t, int& tb, int& T) {
  if (t < NPROMPT) { tb = t & ~2047; T = 2048; }
  else { int u = t - NPROMPT; tb = NPROMPT + (u & ~8191); T = 8192; }
}
DEV const float* xin_row(const Params& p, int row) {
  return row < NPROMPT ? p.in[0] + (size_t)row * DM : p.in[1] + (size_t)(row - NPROMPT) * DM;
}
DEV void unpack8(uint4 u, float* v) {
  v[0] = __uint_as_float(u.x << 16); v[1] = __uint_as_float(u.x & 0xffff0000u);
  v[2] = __uint_as_float(u.y << 16); v[3] = __uint_as_float(u.y & 0xffff0000u);
  v[4] = __uint_as_float(u.z << 16); v[5] = __uint_as_float(u.z & 0xffff0000u);
  v[6] = __uint_as_float(u.w << 16); v[7] = __uint_as_float(u.w & 0xffff0000u);
}

constexpr int LDT = 72;

struct GRegs { u32x4 a0, a1, a2, a3, b0, b1, b2, b3; };
DEV void gemm_gload(GRegs& g, const bf16_t* A0, int lda0, const bf16_t* A1, int lda1, int ksplit,
                    const bf16_t* Bt, int ldb, int k0, int tid) {
  const bf16_t* Ab; int lda, kk;
  if (k0 < ksplit) { Ab = A0; lda = lda0; kk = k0; }
  else { Ab = A1; lda = lda1; kk = k0 - ksplit; }
  const int row = tid >> 3, kc = (tid & 7) * 8;
  const bf16_t* pa = Ab + (size_t)row * lda + kk + kc;
  const bf16_t* pb = Bt + (size_t)row * ldb + k0 + kc;
  g.a0 = *(const u32x4*)(pa);
  g.a1 = *(const u32x4*)(pa + (size_t)32 * lda);
  g.a2 = *(const u32x4*)(pa + (size_t)64 * lda);
  g.a3 = *(const u32x4*)(pa + (size_t)96 * lda);
  g.b0 = *(const u32x4*)(pb);
  g.b1 = *(const u32x4*)(pb + (size_t)32 * ldb);
  g.b2 = *(const u32x4*)(pb + (size_t)64 * ldb);
  g.b3 = *(const u32x4*)(pb + (size_t)96 * ldb);
}

template <class Epi>
DEV void gemm_tile(const bf16_t* A0, int lda0, const bf16_t* A1, int lda1, int ksplit,
                   const bf16_t* Bt, int ldb, int K, char* smem, Epi epi) {
  bf16_t* sA = (bf16_t*)smem;
  bf16_t* sB = sA + 128 * LDT;
  const int tid = threadIdx.x, lane = tid & 63, wv = tid >> 6;
  const int wm = wv >> 1, wn = wv & 1;
  f32x16 acc[2][2];
#pragma unroll
  for (int i = 0; i < 2; ++i)
#pragma unroll
    for (int j = 0; j < 2; ++j)
#pragma unroll
      for (int r = 0; r < 16; ++r) acc[i][j][r] = 0.f;
  GRegs g;
  gemm_gload(g, A0, lda0, A1, lda1, ksplit, Bt, ldb, 0, tid);
  const int nk = K >> 6;
  for (int kt = 0; kt < nk; ++kt) {
    __syncthreads();
    {
      const int row = tid >> 3, kc = (tid & 7) * 8;
      bf16_t* wa = sA + row * LDT + kc;
      bf16_t* wb = sB + row * LDT + kc;
      *(u32x4*)(wa) = g.a0; *(u32x4*)(wa + 32 * LDT) = g.a1; *(u32x4*)(wa + 64 * LDT) = g.a2; *(u32x4*)(wa + 96 * LDT) = g.a3;
      *(u32x4*)(wb) = g.b0; *(u32x4*)(wb + 32 * LDT) = g.b1; *(u32x4*)(wb + 64 * LDT) = g.b2; *(u32x4*)(wb + 96 * LDT) = g.b3;
    }
    __syncthreads();
    if (kt + 1 < nk) gemm_gload(g, A0, lda0, A1, lda1, ksplit, Bt, ldb, (kt + 1) * 64, tid);
#pragma unroll
    for (int ks = 0; ks < 4; ++ks) {
      const int ko = ks * 16 + (lane >> 5) * 8;
      bf16x8 a[2], b[2];
#pragma unroll
      for (int mi = 0; mi < 2; ++mi) a[mi] = *(const bf16x8*)(sA + (wm * 64 + mi * 32 + (lane & 31)) * LDT + ko);
#pragma unroll
      for (int ni = 0; ni < 2; ++ni) b[ni] = *(const bf16x8*)(sB + (wn * 64 + ni * 32 + (lane & 31)) * LDT + ko);
#pragma unroll
      for (int mi = 0; mi < 2; ++mi)
#pragma unroll
        for (int ni = 0; ni < 2; ++ni)
          acc[mi][ni] = __builtin_amdgcn_mfma_f32_32x32x16_bf16(a[mi], b[ni], acc[mi][ni], 0, 0, 0);
    }
  }
#pragma unroll
  for (int mi = 0; mi < 2; ++mi)
#pragma unroll
    for (int r = 0; r < 16; ++r) {
      const int row = wm * 64 + mi * 32 + (r & 3) + 8 * (r >> 2) + 4 * (lane >> 5);
      const int col = wn * 64 + (lane & 31);
      epi(row, col, acc[mi][0][r], acc[mi][1][r]);
    }
}

DEV void wconv(const float* src, int ld, int K, int N, int mode, int coloff, bf16_t* dst, char* smem) {
  float* tile = (float*)smem;
  const int tid = threadIdx.x;
  const int nkt = K >> 6, nnt = N >> 5;
  for (int tl = blockIdx.x; tl < nkt * nnt; tl += gridDim.x) {
    const int kt = tl % nkt, nt = tl / nkt;
    const int cb = mode ? ((nt & 1) * DFF + (nt >> 1) * 32) : (coloff + nt * 32);
    __syncthreads();
    {
      const int n = tid & 31, kk = tid >> 5;
#pragma unroll
      for (int i = 0; i < 8; ++i) {
        const int k = kk + 8 * i;
        tile[k * 33 + n] = src[(size_t)(kt * 64 + k) * ld + cb + n];
      }
    }
    __syncthreads();
    {
      const int k2 = tid & 31, nn = tid >> 5;
#pragma unroll
      for (int i = 0; i < 4; ++i) {
        const int n = nn + 8 * i;
        const unsigned v = pack2(tile[(2 * k2) * 33 + n], tile[(2 * k2 + 1) * 33 + n]);
        *(unsigned*)(dst + (size_t)(nt * 32 + n) * K + kt * 64 + 2 * k2) = v;
      }
    }
  }
  __syncthreads();
}

DEV void ln_row(const float* src, float* dstf, bf16_t* dstb, const float* g, const float* b, int lane) {
  float4 v[4];
  float s = 0.f;
#pragma unroll
  for (int i = 0; i < 4; ++i) {
    v[i] = *(const float4*)(src + (i * 64 + lane) * 4);
    s += v[i].x + v[i].y + v[i].z + v[i].w;
  }
  const float mu = wave_sum(s) * (1.f / 1024.f);
  float q = 0.f;
#pragma unroll
  for (int i = 0; i < 4; ++i) {
    v[i].x -= mu; v[i].y -= mu; v[i].z -= mu; v[i].w -= mu;
    q += v[i].x * v[i].x + v[i].y * v[i].y + v[i].z * v[i].z + v[i].w * v[i].w;
  }
  const float rs = rsqrtf(wave_sum(q) * (1.f / 1024.f) + 1e-5f);
#pragma unroll
  for (int i = 0; i < 4; ++i) {
    const int c = (i * 64 + lane) * 4;
    const float4 gg = *(const float4*)(g + c), bb = *(const float4*)(b + c);
    float4 o;
    o.x = v[i].x * rs * gg.x + bb.x; o.y = v[i].y * rs * gg.y + bb.y;
    o.z = v[i].z * rs * gg.z + bb.z; o.w = v[i].w * rs * gg.w + bb.w;
    if (dstf) *(float4*)(dstf + c) = o;
    if (dstb) { uint2 u; u.x = pack2(o.x, o.y); u.y = pack2(o.z, o.w); *(uint2*)(dstb + c) = u; }
  }
}

DEV void phase_ln(const Params& p, const float* g, const float* b, bool write_xb, bool do_mem) {
  const int lane = threadIdx.x & 63;
  const int gw = blockIdx.x * 4 + (threadIdx.x >> 6), nw = gridDim.x * 4;
  bf16_t* xb = (bf16_t*)(p.ws + O_XB);
  const int total = NTOK + (do_mem ? 3072 : 0);
  for (int r = gw; r < total; r += nw) {
    if (r < NTOK) {
      float* row = p.out + (size_t)r * DM;
      ln_row(row, row, write_xb ? xb + (size_t)r * DM : nullptr, g, b, lane);
    } else {
      const int m = r - NTOK;
      const float* src = m < 2048 ? p.in[2] + (size_t)m * DM : p.in[3] + (size_t)(m - 2048) * DM;
      ln_row(src, nullptr, (bf16_t*)(p.ws + O_MEMB) + (size_t)m * DM, p.in[31], p.in[32], lane);
    }
  }
}

DEV void phase_ffn_in(const Params& p, const bf16_t* wt, char* smem) {
  const bf16_t* xb = (const bf16_t*)(p.ws + O_XB);
  bf16_t* h = (bf16_t*)(p.ws + O_H);
  const int nct = 44, nt = 384 * nct;
  for (int tl = blockIdx.x; tl < nt; tl += gridDim.x) {
    const int rt = tl / nct, ct = tl % nct;
    bf16_t* hb = h + (size_t)rt * 128 * DFF + ct * 64;
    gemm_tile(xb + (size_t)rt * 128 * DM, DM, nullptr, 0, DM, wt + (size_t)ct * 128 * DM, DM, DM, smem,
              [&](int r, int c, float v0, float v1) {
                hb[(size_t)r * DFF + (c >> 6) * 32 + (c & 31)] = f2bf(silu(v0) * v1);
              });
  }
}
DEV void phase_gemm_res(const Params& p, const bf16_t* A0, int lda0, const bf16_t* A1, int lda1, int ksplit, int K,
                        const bf16_t* wt, float scale, bool res_is_input, char* smem) {
  const int nct = 8, nt = 384 * nct;
  for (int tl = blockIdx.x; tl < nt; tl += gridDim.x) {
    const int rt = tl / nct, ct = tl % nct;
    const int r0 = rt * 128, c0 = ct * 128;
    const bf16_t* a1 = A1 ? A1 + (size_t)r0 * lda1 : nullptr;
    gemm_tile(A0 + (size_t)r0 * lda0, lda0, a1, lda1, ksplit, wt + (size_t)c0 * K, K, K, smem,
              [&](int r, int c, float v0, float v1) {
                const int row = r0 + r;
                const float* res = res_is_input ? xin_row(p, row) : p.out + (size_t)row * DM;
                float* o = p.out + (size_t)row * DM;
                const int cc = c0 + c;
                const float x0 = res[cc], x1 = res[cc + 32];
                o[cc] = ALPHA * x0 + scale * v0;
                o[cc + 32] = ALPHA * x1 + scale * v1;
              });
  }
}
DEV void phase_gemm_bf16(const bf16_t* A, int lda, const bf16_t* wt, int K, int N, bf16_t* out, int ldo, char* smem) {
  const int nct = (N + 127) >> 7, nt = 384 * nct;
  for (int tl = blockIdx.x; tl < nt; tl += gridDim.x) {
    const int rt = tl / nct, ct = tl % nct;
    const int r0 = rt * 128, c0 = ct * 128;
    gemm_tile(A + (size_t)r0 * lda, lda, nullptr, 0, K, wt + (size_t)c0 * K, K, K, smem,
              [&](int r, int c, float v0, float v1) {
                bf16_t* o = out + (size_t)(r0 + r) * ldo;
                const int cc = c0 + c;
                if (cc < N) o[cc] = f2bf(v0);
                if (cc + 32 < N) o[cc + 32] = f2bf(v1);
              });
  }
}

constexpr int XS = 68;
struct GlaSmem {
  float X[64 * XS];
  float Y[64 * XS];
  bf16_t vs[64 * 128];
  float gd[64 * 32];
  float blast[64];
};

DEV void gla_load_vg(const bf16_t* proj, int t0, int h, GlaSmem* s) {
  const int tid = threadIdx.x;
#pragma unroll
  for (int i = 0; i < 4; ++i) {
    const int id = tid + 256 * i, c = id >> 4, ec = id & 15;
    *(uint4*)(s->vs + c * 128 + ec * 8) = *(const uint4*)(proj + (size_t)(t0 + c) * GLA_LD + 512 + h * 128 + ec * 8);
  }
  {
    const int c = tid >> 2, part = tid & 3;
    const uint4 u = *(const uint4*)(proj + (size_t)(t0 + c) * GLA_LD + 1536 + part * 8);
    float v[8];
    unpack8(u, v);
#pragma unroll
    for (int j = 0; j < 8; ++j) s->gd[c * 32 + part * 8 + j] = v[j];
  }
}
DEV void gla_gates(const Params& p, int h, int dir, GlaSmem* s) {
  const int tid = threadIdx.x, d = tid & 63, cq = tid >> 6;
  const float* up = dir ? p.in[11] : p.in[9];
  const float* gb = dir ? p.in[12] : p.in[10];
  float u[16];
#pragma unroll
  for (int m = 0; m < 16; ++m) u[m] = up[m * 256 + h * 64 + d];
  const float bias = gb[h * 64 + d];
#pragma unroll 4
  for (int i = 0; i < 16; ++i) {
    const int c = cq + 4 * i;
    float z = bias;
#pragma unroll
    for (int m4 = 0; m4 < 4; ++m4) {
      const float4 g4 = *(const float4*)(s->gd + c * 32 + dir * 16 + m4 * 4);
      z += g4.x * u[m4 * 4] + g4.y * u[m4 * 4 + 1] + g4.z * u[m4 * 4 + 2] + g4.w * u[m4 * 4 + 3];
    }
    s->X[c * XS + d] = logsig(z) * (1.f / 16.f);
  }
  __syncthreads();
  if (tid < 64) {
    float run = 0.f;
    if (dir == 0) {
      for (int c = 0; c < 64; ++c) { run += s->X[c * XS + tid]; s->X[c * XS + tid] = run; }
    } else {
      for (int c = 63; c >= 0; --c) { run += s->X[c * XS + tid]; s->X[c * XS + tid] = run; }
    }
    s->blast[tid] = run;
  }
  __syncthreads();
}

DEV void phase_gla_a(const Params& p, char* smem) {
  GlaSmem* s = (GlaSmem*)smem;
  const bf16_t* proj = (const bf16_t*)(p.ws + O_H);
  float* kv = (float*)(p.ws + O_KV);
  float* dec = (float*)(p.ws + O_DEC);
  const int tid = threadIdx.x;
  for (int item = blockIdx.x; item < 768 * 4; item += gridDim.x) {
    const int gch = item >> 2, h = item & 3, t0 = gch * 64;
    __syncthreads();
    gla_load_vg(proj, t0, h, s);
    __syncthreads();
    for (int dir = 0; dir < 2; ++dir) {
      gla_gates(p, h, dir, s);
      {
        const int d = tid & 63, cq = tid >> 6;
        const float bl = s->blast[d];
#pragma unroll 4
        for (int i = 0; i < 16; ++i) {
          const int c = cq + 4 * i;
          const float k = bf2f(proj[(size_t)(t0 + c) * GLA_LD + 256 + h * 64 + d]);
          s->X[c * XS + d] = k * __expf(bl - s->X[c * XS + d]);
        }
      }
      __syncthreads();
      const int dg = tid >> 4, eg = tid & 15;
      float acc[4][8];
#pragma unroll
      for (int i = 0; i < 4; ++i)
#pragma unroll
        for (int j = 0; j < 8; ++j) acc[i][j] = 0.f;
#pragma unroll 4
      for (int c = 0; c < 64; ++c) {
        const float4 a4 = *(const float4*)(s->X + c * XS + dg * 4);
        float v[8];
        unpack8(*(const uint4*)(s->vs + c * 128 + eg * 8), v);
        const float a[4] = {a4.x, a4.y, a4.z, a4.w};
#pragma unroll
        for (int i = 0; i < 4; ++i)
#pragma unroll
          for (int j = 0; j < 8; ++j) acc[i][j] += a[i] * v[j];
      }
      const size_t kvi = (size_t)item * 2 + dir;
#pragma unroll
      for (int i = 0; i < 4; ++i) {
        float* o = kv + (kvi * 64 + dg * 4 + i) * 128 + eg * 8;
        *(float4*)o = make_float4(acc[i][0], acc[i][1], acc[i][2], acc[i][3]);
        *(float4*)(o + 4) = make_float4(acc[i][4], acc[i][5], acc[i][6], acc[i][7]);
      }
      if (tid < 64) dec[kvi * 64 + tid] = __expf(s->blast[tid]);
      __syncthreads();
    }
  }
}

DEV void phase_gla_b(const Params& p) {
  float* kv = (float*)(p.ws + O_KV);
  const float* dec = (const float*)(p.ws + O_DEC);
  const int tid = threadIdx.x;
  for (int unit = blockIdx.x; unit < 96 * 32; unit += gridDim.x) {
    const int sid = unit >> 5, part = unit & 31;
    const int sq = sid >> 3, h = (sid >> 1) & 3, dir = sid & 1;
    int c0, nch;
    if (sq < 4) { c0 = 256 + sq * 128; nch = 128; }
    else { c0 = (sq - 4) * 32; nch = 32; }
    const int e = part * 256 + tid;
    float S = 0.f;
#pragma unroll 8
    for (int n = 0; n < nch; ++n) {
      const int ci = dir ? (c0 + nch - 1 - n) : (c0 + n);
      const size_t idx = ((size_t)ci * 4 + h) * 2 + dir;
      float* ptr = kv + idx * 8192 + e;
      const float tmp = *ptr;
      const float dc = dec[idx * 64 + (e >> 7)];
      *ptr = S;
      S = dc * S + tmp;
    }
  }
}

DEV void phase_gla_c(const Params& p, char* smem) {
  GlaSmem* s = (GlaSmem*)smem;
  const bf16_t* proj = (const bf16_t*)(p.ws + O_H);
  const float* kv = (const float*)(p.ws + O_KV);
  bf16_t* mixed = (bf16_t*)(p.ws + O_MIXG);
  const int tid = threadIdx.x;
  const int cg_ = tid >> 4, eg = tid & 15;
  for (int item = blockIdx.x; item < 768 * 4; item += gridDim.x) {
    const int gch = item >> 2, h = item & 3, t0 = gch * 64;
    __syncthreads();
    gla_load_vg(proj, t0, h, s);
    __syncthreads();
    float o[4][8];
#pragma unroll
    for (int i = 0; i < 4; ++i)
#pragma unroll
      for (int j = 0; j < 8; ++j) o[i][j] = 0.f;
    for (int dir = 0; dir < 2; ++dir) {
      gla_gates(p, h, dir, s);
      float qb[16];
      {
        const int d = tid & 63, cq = tid >> 6;
        const float bref = 0.5f * s->blast[d];
#pragma unroll
        for (int i = 0; i < 16; ++i) {
          const int c = cq + 4 * i;
          const float b = s->X[c * XS + d];
          const bf16_t* row = proj + (size_t)(t0 + c) * GLA_LD + h * 64 + d;
          const float q = bf2f(row[0]) * 0.125f;
          const float k = bf2f(row[256]);
          s->X[c * XS + d] = q * __expf(b - bref);
          s->Y[c * XS + d] = k * __expf(bref - b);
          qb[i] = q * __expf(b);
        }
      }
      __syncthreads();
      float P[4][4];
#pragma unroll
      for (int i = 0; i < 4; ++i)
#pragma unroll
        for (int j = 0; j < 4; ++j) P[i][j] = 0.f;
#pragma unroll 2
      for (int d4 = 0; d4 < 16; ++d4) {
        float4 xa[4], yb[4];
#pragma unroll
        for (int i = 0; i < 4; ++i) xa[i] = *(const float4*)(s->X + (cg_ * 4 + i) * XS + d4 * 4);
#pragma unroll
        for (int j = 0; j < 4; ++j) yb[j] = *(const float4*)(s->Y + (eg + 16 * j) * XS + d4 * 4);
#pragma unroll
        for (int i = 0; i < 4; ++i)
#pragma unroll
          for (int j = 0; j < 4; ++j)
            P[i][j] += xa[i].x * yb[j].x + xa[i].y * yb[j].y + xa[i].z * yb[j].z + xa[i].w * yb[j].w;
      }
#pragma unroll
      for (int i = 0; i < 4; ++i)
#pragma unroll
        for (int j = 0; j < 4; ++j) {
          const int c = cg_ * 4 + i, sc = eg + 16 * j;
          const bool keep = dir ? (sc >= c) : (sc <= c);
          if (!keep) P[i][j] = 0.f;
        }
      __syncthreads();
#pragma unroll
      for (int j = 0; j < 4; ++j)
        *(float4*)(s->Y + (eg + 16 * j) * XS + cg_ * 4) = make_float4(P[0][j], P[1][j], P[2][j], P[3][j]);
      {
        const int d = tid & 63, cq = tid >> 6;
#pragma unroll
        for (int i = 0; i < 16; ++i) s->X[d * XS + cq + 4 * i] = qb[i];
      }
      __syncthreads();
#pragma unroll 2
      for (int sc = 0; sc < 64; ++sc) {
        const float4 a4 = *(const float4*)(s->Y + sc * XS + cg_ * 4);
        float v[8];
        unpack8(*(const uint4*)(s->vs + sc * 128 + eg * 8), v);
        const float a[4] = {a4.x, a4.y, a4.z, a4.w};
#pragma unroll
        for (int i = 0; i < 4; ++i)
#pragma unroll
          for (int j = 0; j < 8; ++j) o[i][j] += a[i] * v[j];
      }
      const float* Sp = kv + ((size_t)item * 2 + dir) * 8192 + eg * 8;
#pragma unroll 2
      for (int d = 0; d < 64; ++d) {
        const float4 a4 = *(const float4*)(s->X + d * XS + cg_ * 4);
        const float4 s0 = *(const float4*)(Sp + d * 128), s1 = *(const float4*)(Sp + d * 128 + 4);
        const float a[4] = {a4.x, a4.y, a4.z, a4.w};
        const float v[8] = {s0.x, s0.y, s0.z, s0.w, s1.x, s1.y, s1.z, s1.w};
#pragma unroll
        for (int i = 0; i < 4; ++i)
#pragma unroll
          for (int j = 0; j < 8; ++j) o[i][j] += a[i] * v[j];
      }
      __syncthreads();
    }
    float ng[8];
#pragma unroll
    for (int j = 0; j < 8; ++j) ng[j] = p.in[13][h * 128 + eg * 8 + j];
#pragma unroll
    for (int i = 0; i < 4; ++i) {
      float ss = 0.f;
#pragma unroll
      for (int j = 0; j < 8; ++j) ss += o[i][j] * o[i][j];
      ss = row16_sum(ss);
      const float rs = rsqrtf(ss * (1.f / 128.f) + 1e-5f);
      const int t = t0 + cg_ * 4 + i;
      float g[8];
      unpack8(*(const uint4*)(proj + (size_t)t * GLA_LD + 1024 + h * 128 + eg * 8), g);
      uint4 u;
      u.x = pack2(o[i][0] * rs * ng[0] * silu(g[0]), o[i][1] * rs * ng[1] * silu(g[1]));
      u.y = pack2(o[i][2] * rs * ng[2] * silu(g[2]), o[i][3] * rs * ng[3] * silu(g[3]));
      u.z = pack2(o[i][4] * rs * ng[4] * silu(g[4]), o[i][5] * rs * ng[5] * silu(g[5]));
      u.w = pack2(o[i][6] * rs * ng[6] * silu(g[6]), o[i][7] * rs * ng[7] * silu(g[7]));
      *(uint4*)(mixed + (size_t)t * 512 + h * 128 + eg * 8) = u;
    }
  }
}

DEV void phase_rw_act(const Params& p) {
  const bf16_t* proj = (const bf16_t*)(p.ws + O_H);
  bf16_t* awda = (bf16_t*)(p.ws + O_XB);
  bf16_t* ag = (bf16_t*)(p.ws + O_ACTG);
  const size_t total = (size_t)NTOK * 320;
  for (size_t idx = (size_t)blockIdx.x * 256 + threadIdx.x; idx < total; idx += (size_t)gridDim.x * 256) {
    const int t = (int)(idx / 320), col = (int)(idx % 320);
    int tb, T;
    seq_of_token(t, tb, T);
    const int rc = 1536 + col;
    const bf16_t* ptr = proj + (size_t)t * RW_LD + rc;
    const float x = bf2f(ptr[0]);
    const float pv = (t > tb) ? bf2f(ptr[-RW_LD]) : 0.f;
    const float nx = (t < tb + T - 1) ? bf2f(ptr[RW_LD]) : 0.f;
    const float v = x + p.in[14][rc] * (pv - x) + p.in[15][rc] * (nx - x);
    if (col < 128) awda[(size_t)t * 192 + col] = f2bf(tanhf(v));
    else if (col < 192) awda[(size_t)t * 192 + col] = f2bf(v);
    else ag[(size_t)t * 128 + (col - 192)] = f2bf(sigm(v));
  }
}

DEV void phase_rw_lowrank(const Params& p, char* smem) {
  const bf16_t* awda = (const bf16_t*)(p.ws + O_XB);
  bf16_t* der = (bf16_t*)(p.ws + O_DER);
  const int nt = 3 * 384 * 4;
  for (int tl = blockIdx.x; tl < nt; tl += gridDim.x) {
    const int which = tl / 1536, rem = tl % 1536, rt = rem >> 2, ct = rem & 3;
    const int r0 = rt * 128, c0 = ct * 128;
    const bf16_t* wt = (const bf16_t*)(p.ws + (which == 0 ? W_A_UPF : which == 1 ? W_A_UPB : W_A_AUP));
    const float* bias = which == 0 ? p.in[16] : which == 1 ? p.in[18] : p.in[20];
    bf16_t* out = der + (size_t)which * SLAB;
    gemm_tile(awda + (size_t)r0 * 192 + which * 64, 192, nullptr, 0, 64, wt + (size_t)c0 * 64, 64, 64, smem,
              [&](int r, int c, float v0, float v1) {
                bf16_t* o = out + (size_t)(r0 + r) * 512 + c0 + c;
                const float z0 = bias[c0 + c] + v0, z1 = bias[c0 + c + 32] + v1;
                if (which < 2) { o[0] = f2bf(-0.6065306597f * sigm(z0)); o[32] = f2bf(-0.6065306597f * sigm(z1)); }
                else { o[0] = f2bf(sigm(z0)); o[32] = f2bf(sigm(z1)); }
              });
  }
}

template <int RPL>
DEV void rwkv_scan(const Params& p, int tb, int T, int head, int dir, int split, float* st) {
  const int tid = threadIdx.x, lane = tid & 63, wv = tid >> 6;
  const int jl = lane & 15, ig = lane >> 4;
  const int hc = head * 64 + lane;
  const bf16_t* proj = (const bf16_t*)(p.ws + O_H);
  const bf16_t* ldp = (const bf16_t*)(p.ws + O_DER) + (size_t)dir * SLAB;
  const bf16_t* ap = (const bf16_t*)(p.ws + O_DER) + 2 * SLAB;
  bf16_t* yout = (bf16_t*)(p.ws + O_XB) + (size_t)dir * SLAB;
  float* bonus = (float*)(p.ws + O_BONUS);
  const float mpr = p.in[14][hc], mnr = p.in[15][hc];
  const float mpk = p.in[14][512 + hc], mnk = p.in[15][512 + hc];
  const float mpv = p.in[14][1024 + hc], mnv = p.in[15][1024 + hc];
  const float kkw = p.in[23][hc], kaw = p.in[24][hc], rkw = p.in[25][hc];
  const bool do_bonus = (dir == 0 && split == 0);
  const int rowbase = split * 16 * RPL + wv * 4 * RPL + ig * RPL;
  const int nch = T >> 4;
  float S[RPL][4];
#pragma unroll
  for (int r = 0; r < RPL; ++r)
#pragma unroll
    for (int c = 0; c < 4; ++c) S[r][c] = 0.f;
  bf16_t raw[4][11];

#define RW_LOAD(CH)                                                                     \
  _Pragma("unroll") for (int q = 0; q < 4; ++q) {                                       \
    const int tt_ = (CH) * 16 + wv * 4 + q;                                             \
    const int t_ = dir ? (T - 1 - tt_) : tt_;                                           \
    const bf16_t* row_ = proj + (size_t)(tb + t_) * RW_LD + hc;                         \
    const bool hp_ = t_ > 0, hn_ = t_ < T - 1;                                          \
    _Pragma("unroll") for (int w = 0; w < 3; ++w) {                                     \
      raw[q][w * 3 + 0] = row_[w * 512];                                                \
      raw[q][w * 3 + 1] = hp_ ? row_[w * 512 - RW_LD] : (bf16_t)0;                      \
      raw[q][w * 3 + 2] = hn_ ? row_[w * 512 + RW_LD] : (bf16_t)0;                      \
    }                                                                                   \
    raw[q][9] = ldp[(size_t)(tb + t_) * 512 + hc];                                      \
    raw[q][10] = ap[(size_t)(tb + t_) * 512 + hc];                                      \
  }
#define RW_STAGE(CH, BUF)                                                               \
  _Pragma("unroll") for (int q = 0; q < 4; ++q) {                                       \
    const int s_ = wv * 4 + q;                                                          \
    const int tt_ = (CH) * 16 + s_;                                                     \
    const int t_ = dir ? (T - 1 - tt_) : tt_;                                           \
    float x_ = bf2f(raw[q][0]);                                                         \
    const float r_ = x_ + mpr * (bf2f(raw[q][1]) - x_) + mnr * (bf2f(raw[q][2]) - x_);  \
    x_ = bf2f(raw[q][3]);                                                               \
    const float kr_ = x_ + mpk * (bf2f(raw[q][4]) - x_) + mnk * (bf2f(raw[q][5]) - x_); \
    x_ = bf2f(raw[q][6]);                                                               \
    const float v_ = x_ + mpv * (bf2f(raw[q][7]) - x_) + mnv * (bf2f(raw[q][8]) - x_);  \
    const float a_ = bf2f(raw[q][10]);                                                  \
    const float kkr_ = kr_ * kkw;                                                       \
    const float nrm_ = sqrtf(wave_sum(kkr_ * kkr_));                                    \
    const float kk_ = kkr_ / fmaxf(nrm_, 1e-12f);                                       \
    const float k2_ = kr_ * (1.f + (a_ - 1.f) * kaw);                                   \
    float* sb_ = st + (BUF) * (16 * 384) + s_ * 384;                                    \
    sb_[lane] = __expf(bf2f(raw[q][9]));                                                \
    sb_[64 + lane] = kk_;                                                               \
    sb_[128 + lane] = kk_ * a_;                                                         \
    sb_[192 + lane] = k2_;                                                              \
    sb_[256 + lane] = r_;                                                               \
    sb_[320 + lane] = v_;                                                               \
    if (do_bonus) {                                                                     \
      const float bo_ = wave_sum(r_ * k2_ * rkw);                                       \
      if (lane == 0) bonus[(size_t)(tb + t_) * 8 + head] = bo_;                         \
    }                                                                                   \
  }

  RW_LOAD(0);
  RW_STAGE(0, 0);
  __syncthreads();
  for (int ch = 0; ch < nch; ++ch) {
    const int buf = ch & 1;
    if (ch + 1 < nch) { RW_LOAD(ch + 1); }
    for (int s = 0; s < 16; ++s) {
      const float* sb = st + buf * (16 * 384) + s * 384;
      const float4 w4 = *(const float4*)(sb + jl * 4);
      const float4 kk4 = *(const float4*)(sb + 64 + jl * 4);
      const float4 ka4 = *(const float4*)(sb + 128 + jl * 4);
      const float4 k4 = *(const float4*)(sb + 192 + jl * 4);
      const float4 r4 = *(const float4*)(sb + 256 + jl * 4);
      float vv[RPL];
#pragma unroll
      for (int r = 0; r < RPL; ++r) vv[r] = sb[320 + rowbase + r];
      const int tt = ch * 16 + s;
      const int t = dir ? (T - 1 - tt) : tt;
      float yv[RPL];
#pragma unroll
      for (int r = 0; r < RPL; ++r) {
        float pz = S[r][0] * kk4.x + S[r][1] * kk4.y + S[r][2] * kk4.z + S[r][3] * kk4.w;
        pz = row16_sum(pz);
        const float sa = -pz;
        S[r][0] = S[r][0] * w4.x + sa * ka4.x + vv[r] * k4.x;
        S[r][1] = S[r][1] * w4.y + sa * ka4.y + vv[r] * k4.y;
        S[r][2] = S[r][2] * w4.z + sa * ka4.z + vv[r] * k4.z;
        S[r][3] = S[r][3] * w4.w + sa * ka4.w + vv[r] * k4.w;
        float yp = S[r][0] * r4.x + S[r][1] * r4.y + S[r][2] * r4.z + S[r][3] * r4.w;
        yv[r] = row16_sum(yp);
      }
      if (jl == 0) {
        bf16_t* yo = yout + (size_t)(tb + t) * 512 + head * 64 + rowbase;
#pragma unroll
        for (int r = 0; r < RPL; ++r) yo[r] = f2bf(yv[r]);
      }
    }
    if (ch + 1 < nch) { RW_STAGE(ch + 1, buf ^ 1); }
    __syncthreads();
  }
#undef RW_LOAD
#undef RW_STAGE
}

DEV void phase_rw_scan(const Params& p, char* smem) {
  float* st = (float*)smem;
  for (int item = blockIdx.x; item < 512; item += gridDim.x) {
    __syncthreads();
    if (item < 256) {
      const int scan = item >> 2, split = item & 3;
      const int sq = scan >> 4, head = (scan >> 1) & 7, dir = scan & 1;
      rwkv_scan<1>(p, NPROMPT + sq * 8192, 8192, head, dir, split, st);
    } else {
      const int it = item - 256;
      const int scan = it >> 1, split = it & 1;
      const int sq = scan >> 4, head = (scan >> 1) & 7, dir = scan & 1;
      rwkv_scan<2>(p, sq * 2048, 2048, head, dir, split, st);
    }
  }
}

DEV void phase_rw_post(const Params& p) {
  const bf16_t* proj = (const bf16_t*)(p.ws + O_H);
  bf16_t* yf = (bf16_t*)(p.ws + O_XB);
  const bf16_t* yb = yf + SLAB;
  const bf16_t* gate = (const bf16_t*)(p.ws + O_DER) + 2 * SLAB;
  const float* bonus = (const float*)(p.ws + O_BONUS);
  const int lane = threadIdx.x & 63;
  const int gw = blockIdx.x * 4 + (threadIdx.x >> 6), nw = gridDim.x * 4;
  for (int it = gw; it < NTOK * 8; it += nw) {
    const int t = it >> 3, h = it & 7;
    const int hc = h * 64 + lane;
    int tb, T;
    seq_of_token(t, tb, T);
    const size_t o = (size_t)t * 512 + hc;
    const float y = bf2f(yf[o]) + bf2f(yb[o]);
    const float mu = wave_sum(y) * (1.f / 64.f);
    const float dy = y - mu;
    const float var = wave_sum(dy * dy) * (1.f / 64.f);
    const float yn = dy * rsqrtf(var + 64e-5f) * p.in[26][hc] + p.in[27][hc];
    const bf16_t* vp = proj + (size_t)t * RW_LD + 1024 + hc;
    const float x = bf2f(vp[0]);
    const float pv = (t > tb) ? bf2f(vp[-RW_LD]) : 0.f;
    const float nx = (t < tb + T - 1) ? bf2f(vp[RW_LD]) : 0.f;
    const float v = x + p.in[14][1024 + hc] * (pv - x) + p.in[15][1024 + hc] * (nx - x);
    const float res = (yn + bonus[(size_t)t * 8 + h] * v) * bf2f(gate[o]);
    yf[o] = f2bf(res);
  }
}

DEV int seq_of_rowtile(int rt) { return rt < 128 ? (rt >> 4) : 8 + ((rt - 128) >> 6); }

DEV void phase_ca_qkv(const Params& p, char* smem) {
  const bf16_t* xb = (const bf16_t*)(p.ws + O_XB);
  bf16_t* qb = (bf16_t*)(p.ws + O_H);
  const bf16_t* memb = (const bf16_t*)(p.ws + O_MEMB);
  bf16_t* kb = (bf16_t*)(p.ws + O_KB);
  bf16_t* vt = (bf16_t*)(p.ws + O_VT);
  const bf16_t* wq = (const bf16_t*)(p.ws + W_B_Q);
  const bf16_t* wkv = (const bf16_t*)(p.ws + W_B_KV);
  const int ntq = 384 * 8, ntkv = 24 * 16;
  for (int tl = blockIdx.x; tl < ntq + ntkv; tl += gridDim.x) {
    if (tl < ntq) {
      const int rt = tl >> 3, ct = tl & 7;
      const int r0 = rt * 128, c0 = ct * 128;
      gemm_tile(xb + (size_t)r0 * DM, DM, nullptr, 0, DM, wq + (size_t)c0 * DM, DM, DM, smem,
                [&](int r, int c, float v0, float v1) {
                  bf16_t* o = qb + (size_t)(r0 + r) * DM + c0 + c;
                  o[0] = f2bf(v0); o[32] = f2bf(v1);
                });
    } else {
      const int t2 = tl - ntq;
      const int rt = t2 >> 4, ct = t2 & 15;
      const int r0 = rt * 128, c0 = ct * 128;
      gemm_tile(memb + (size_t)r0 * DM, DM, nullptr, 0, DM, wkv + (size_t)c0 * DM, DM, DM, smem,
                [&](int r, int c, float v0, float v1) {
                  const int row = r0 + r, cc = c0 + c;
                  if (cc < 1024) {
                    kb[(size_t)row * DM + cc] = f2bf(v0);
                    kb[(size_t)row * DM + cc + 32] = f2bf(v1);
                  } else {
                    const int b = row >> 8, m = row & 255, d = cc - 1024;
                    vt[((size_t)b * 1024 + d) * 256 + m] = f2bf(v0);
                    vt[((size_t)b * 1024 + d + 32) * 256 + m] = f2bf(v1);
                  }
                });
    }
  }
}
DEV void phase_ca_scores(const Params& p, char* smem) {
  const bf16_t* qb = (const bf16_t*)(p.ws + O_H);
  const bf16_t* kb = (const bf16_t*)(p.ws + O_KB);
  float* sc = (float*)(p.ws + O_SCORES);
  for (int tl = blockIdx.x; tl < 384 * 8; tl += gridDim.x) {
    const int rt = tl >> 3, h = (tl >> 1) & 3, nt = tl & 1;
    const int b = seq_of_rowtile(rt), r0 = rt * 128;
    gemm_tile(qb + (size_t)r0 * DM + h * 256, DM, nullptr, 0, 256,
              kb + (size_t)(b * 256 + nt * 128) * DM + h * 256, DM, 256, smem,
              [&](int r, int c, float v0, float v1) {
                float* o = sc + (size_t)(r0 + r) * DM + h * 256 + nt * 128 + c;
                o[0] = v0 * 0.0625f; o[32] = v1 * 0.0625f;
              });
  }
}
DEV void phase_ca_softmax(const Params& p) {
  const float* sc = (const float*)(p.ws + O_SCORES);
  bf16_t* pb = (bf16_t*)(p.ws + O_H);
  const int lane = threadIdx.x & 63;
  const int gw = blockIdx.x * 4 + (threadIdx.x >> 6), nw = gridDim.x * 4;
  for (int it = gw; it < NTOK * 4; it += nw) {
    const size_t o = (size_t)it * 256 + lane * 4;
    const float4 v = *(const float4*)(sc + o);
    const float mx = wave_max(fmaxf(fmaxf(v.x, v.y), fmaxf(v.z, v.w)));
    const float e0 = __expf(v.x - mx), e1 = __expf(v.y - mx), e2 = __expf(v.z - mx), e3 = __expf(v.w - mx);
    const float inv = 1.f / wave_sum(e0 + e1 + e2 + e3);
    uint2 u;
    u.x = pack2(e0 * inv, e1 * inv);
    u.y = pack2(e2 * inv, e3 * inv);
    *(uint2*)(pb + o) = u;
  }
}
DEV void phase_ca_pv(const Params& p, char* smem) {
  const bf16_t* pb = (const bf16_t*)(p.ws + O_H);
  const bf16_t* vt = (const bf16_t*)(p.ws + O_VT);
  bf16_t* attn = (bf16_t*)(p.ws + O_XB);
  for (int tl = blockIdx.x; tl < 384 * 8; tl += gridDim.x) {
    const int rt = tl >> 3, h = (tl >> 1) & 3, nt = tl & 1;
    const int b = seq_of_rowtile(rt), r0 = rt * 128;
    gemm_tile(pb + (size_t)r0 * DM + h * 256, DM, nullptr, 0, 256,
              vt + ((size_t)b * 1024 + h * 256 + nt * 128) * 256, 256, 256, smem,
              [&](int r, int c, float v0, float v1) {
                bf16_t* o = attn + (size_t)(r0 + r) * DM + h * 256 + nt * 128 + c;
                o[0] = f2bf(v0); o[32] = f2bf(v1);
              });
  }
}

DEV void phase_convert_x(const Params& p) {
  bf16_t* xb = (bf16_t*)(p.ws + O_XB);
  const size_t n4 = (size_t)NTOK * DM / 4;
  const size_t np4 = (size_t)NPROMPT * DM / 4;
  for (size_t i = (size_t)blockIdx.x * 256 + threadIdx.x; i < n4; i += (size_t)gridDim.x * 256) {
    const float4 v = i < np4 ? ((const float4*)p.in[0])[i] : ((const float4*)p.in[1])[i - np4];
    uint2 u;
    u.x = pack2(v.x, v.y);
    u.y = pack2(v.z, v.w);
    ((uint2*)xb)[i] = u;
  }
}

constexpr int NPHASE = 24;
constexpr int SMEM_BYTES = 60 * 1024;

DEV void run_phase(const Params& p, int ph, char* smem) {
  char* ws = p.ws;
    switch (ph) {
      case 0:
        wconv(p.in[4], 2 * DFF, DM, 2 * DFF, 1, 0, (bf16_t*)(ws + W_A_FFN_IN), smem);
        wconv(p.in[5], DM, DFF, DM, 0, 0, (bf16_t*)(ws + W_A_FFN_OUT), smem);
        wconv(p.in[8], 3424, DM, 1568, 0, 0, (bf16_t*)(ws + W_A_MIX_IN), smem);
        wconv(p.in[8], 3424, DM, 1856, 0, 1568, (bf16_t*)(ws + W_A_MIX_IN) + (size_t)1664 * DM, smem);
        wconv(p.in[17], 512, 64, 512, 0, 0, (bf16_t*)(ws + W_A_UPF), smem);
        wconv(p.in[19], 512, 64, 512, 0, 0, (bf16_t*)(ws + W_A_UPB), smem);
        wconv(p.in[21], 512, 64, 512, 0, 0, (bf16_t*)(ws + W_A_AUP), smem);
        wconv(p.in[22], 512, 128, 512, 0, 0, (bf16_t*)(ws + W_A_GUP), smem);
        phase_convert_x(p);
        break;
      case 1: phase_ffn_in(p, (const bf16_t*)(ws + W_A_FFN_IN), smem); break;
      case 2: phase_gemm_res(p, (const bf16_t*)(ws + O_H), DFF, nullptr, 0, DFF, DFF, (const bf16_t*)(ws + W_A_FFN_OUT), 0.5f, true, smem); break;
      case 3: phase_ln(p, p.in[6], p.in[7], true, false); break;
      case 4: phase_gemm_bf16((const bf16_t*)(ws + O_XB), DM, (const bf16_t*)(ws + W_A_MIX_IN), DM, 1568, (bf16_t*)(ws + O_H), GLA_LD, smem); break;
      case 5: phase_gla_a(p, smem); break;
      case 6: phase_gla_b(p); break;
      case 7: phase_gla_c(p, smem); break;
      case 8: phase_gemm_bf16((const bf16_t*)(ws + O_XB), DM, (const bf16_t*)(ws + W_A_MIX_IN) + (size_t)1664 * DM, DM, 1856, (bf16_t*)(ws + O_H), RW_LD, smem); break;
      case 9: phase_rw_act(p); break;
      case 10: phase_rw_lowrank(p, smem); break;
      case 11: phase_rw_scan(p, smem); break;
      case 12: phase_gemm_bf16((const bf16_t*)(ws + O_ACTG), 128, (const bf16_t*)(ws + W_A_GUP), 128, 512, (bf16_t*)(ws + O_DER) + 2 * SLAB, 512, smem); break;
      case 13:
        phase_rw_post(p);
        wconv(p.in[28], DM, DM, DM, 0, 0, (bf16_t*)(ws + W_B_MIX_OUT), smem);
        wconv(p.in[33], DM, DM, DM, 0, 0, (bf16_t*)(ws + W_B_Q), smem);
        wconv(p.in[34], 2 * DM, DM, 2 * DM, 0, 0, (bf16_t*)(ws + W_B_KV), smem);
        wconv(p.in[35], DM, DM, DM, 0, 0, (bf16_t*)(ws + W_B_O), smem);
        wconv(p.in[38], 2 * DFF, DM, 2 * DFF, 1, 0, (bf16_t*)(ws + W_B_FFN_IN), smem);
        wconv(p.in[39], DM, DFF, DM, 0, 0, (bf16_t*)(ws + W_B_FFN_OUT), smem);
        break;
      case 14: phase_gemm_res(p, (const bf16_t*)(ws + O_MIXG), 512, (const bf16_t*)(ws + O_XB), 512, 512, DM, (const bf16_t*)(ws + W_B_MIX_OUT), 1.0f, false, smem); break;
      case 15: phase_ln(p, p.in[29], p.in[30], true, true); break;
      case 16: phase_ca_qkv(p, smem); break;
      case 17: phase_ca_scores(p, smem); break;
      case 18: phase_ca_softmax(p); break;
      case 19: phase_ca_pv(p, smem); break;
      case 20: phase_gemm_res(p, (const bf16_t*)(ws + O_XB), DM, nullptr, 0, DM, DM, (const bf16_t*)(ws + W_B_O), 1.0f, false, smem); break;
      case 21: phase_ln(p, p.in[36], p.in[37], true, false); break;
      case 22: phase_ffn_in(p, (const bf16_t*)(ws + W_B_FFN_IN), smem); break;
      case 23: phase_gemm_res(p, (const bf16_t*)(ws + O_H), DFF, nullptr, 0, DFF, DFF, (const bf16_t*)(ws + W_B_FFN_OUT), 0.5f, false, smem); break;
      case 24: phase_ln(p, p.in[40], p.in[41], false, false); break;
      default: break;
    }
}

#define PHASE_STEP(N) if (ph_lo <= N && N < ph_hi) { run_phase(p, N, smem); if (N + 1 < ph_hi) grid.sync(); }
__global__ void __launch_bounds__(256, 2) mega(Params p, int ph_lo, int ph_hi) {
  __shared__ __attribute__((aligned(16))) char smem[SMEM_BYTES];
  cg::grid_group grid = cg::this_grid();
  PHASE_STEP(0)
  PHASE_STEP(1)
  PHASE_STEP(2)
  PHASE_STEP(3)
  PHASE_STEP(4)
  PHASE_STEP(5)
  PHASE_STEP(6)
  PHASE_STEP(7)
  PHASE_STEP(8)
  PHASE_STEP(9)
  PHASE_STEP(10)
  PHASE_STEP(11)
  PHASE_STEP(12)
  PHASE_STEP(13)
  PHASE_STEP(14)
  PHASE_STEP(15)
  PHASE_STEP(16)
  PHASE_STEP(17)
  PHASE_STEP(18)
  PHASE_STEP(19)
  PHASE_STEP(20)
  PHASE_STEP(21)
  PHASE_STEP(22)
  PHASE_STEP(23)
  PHASE_STEP(24)
}

#ifdef PHASE_TEST
template <int PH> __global__ void __launch_bounds__(256, 2) mega_t(Params p) {
  __shared__ __attribute__((aligned(16))) char smem[SMEM_BYTES];
  run_phase(p, PH, smem);
}
template __global__ void mega_t<0>(Params);
template __global__ void mega_t<1>(Params);
template __global__ void mega_t<2>(Params);
template __global__ void mega_t<3>(Params);
template __global__ void mega_t<4>(Params);
template __global__ void mega_t<5>(Params);
template __global__ void mega_t<6>(Params);
template __global__ void mega_t<7>(Params);
template __global__ void mega_t<9>(Params);
template __global__ void mega_t<10>(Params);
template __global__ void mega_t<11>(Params);
template __global__ void mega_t<13>(Params);
template __global__ void mega_t<16>(Params);
template __global__ void mega_t<17>(Params);
template __global__ void mega_t<18>(Params);
template __global__ void mega_t<19>(Params);
#endif

extern "C" void kernel_launch(void* const* d_in, const int* in_sizes, int n_in, void* d_out, int out_size,
                              void* d_ws, size_t ws_size, hipStream_t stream) {
  if (ws_size < WS_NEED || n_in < 42) {
    fprintf(stderr, "kernel_launch: workspace too small (%zu) or inputs missing (%d)\n", ws_size, n_in);
    return;
  }
  static int grid_blocks = 0;
  if (!grid_blocks) {
    int dev = 0, cus = 0, per_cu = 0;
    hipGetDevice(&dev);
    hipDeviceGetAttribute(&cus, hipDeviceAttributeMultiprocessorCount, dev);
    hipOccupancyMaxActiveBlocksPerMultiprocessor(&per_cu, mega, 256, 0);
    if (per_cu > 2) per_cu = 2;
    if (per_cu < 1) per_cu = 1;
    grid_blocks = cus * per_cu;
  }
  Params p{};
  for (int i = 0; i < 42; ++i) p.in[i] = (const float*)d_in[i];
  p.out = (float*)d_out;
  p.ws = (char*)d_ws;
  const int nph = NPHASE + 1;
#if MULTI_LAUNCH
  for (int ph = 0; ph < nph; ++ph) {
    hipLaunchKernelGGL(mega, dim3(grid_blocks), dim3(256), 0, stream, p, ph, ph + 1);
  }
#else
  int lo = 0, hi = nph;
  void* args[] = {&p, &lo, &hi};
  hipError_t e = hipLaunchCooperativeKernel((void*)mega, dim3(grid_blocks), dim3(256), args, 0, stream);
  if (e != hipSuccess) fprintf(stderr, "cooperative launch failed: %s (grid %d)\n", hipGetErrorString(e), grid_blocks);
#endif
}
```

```cpp
#include <hip/hip_runtime.h>
#include <hip/hip_bf16.h>
#include <hip/hip_cooperative_groups.h>
#include <cstdio>
namespace cg = cooperative_groups;

#ifndef MULTI_LAUNCH
#define MULTI_LAUNCH 0
#endif

typedef unsigned short bf16_t;
using bf16x8 = __attribute__((ext_vector_type(8))) short;
using f32x16 = __attribute__((ext_vector_type(16))) float;
using u32x4 = __attribute__((ext_vector_type(4))) unsigned;
using f32x2 = __attribute__((ext_vector_type(2))) float;
using f32x4v = __attribute__((ext_vector_type(4))) float;

#define DEV __device__ __forceinline__

constexpr int NTOK = 49152;
constexpr int NPROMPT = 16384;
constexpr int DM = 1024;
constexpr int DFF = 2816;
constexpr int GLA_LD = 1568;
constexpr int RW_LD = 1856;
constexpr float ALPHA = 1.189207115002721f;
constexpr size_t MiB = 1ull << 20;
constexpr size_t SLAB = (size_t)NTOK * 512;

constexpr size_t W_A_FFN_IN = 0, W_A_FFN_OUT = 11 * MiB, W_A_MIX_IN = 17 * MiB, W_A_UPF = 24 * MiB,
                 W_A_UPB = 24 * MiB + 65536, W_A_AUP = 24 * MiB + 2 * 65536, W_A_GUP = 24 * MiB + 3 * 65536;
constexpr size_t W_B_MIX_OUT = 0, W_B_Q = 2 * MiB, W_B_KV = 4 * MiB, W_B_O = 8 * MiB, W_B_FFN_IN = 10 * MiB, W_B_FFN_OUT = 21 * MiB;
constexpr size_t O_XB = 27 * MiB;
constexpr size_t O_H = 123 * MiB;
constexpr size_t O_KV = 270 * MiB;
constexpr size_t O_DEC = 462 * MiB;
constexpr size_t O_DER = 297 * MiB;
constexpr size_t O_ACTG = 441 * MiB;
constexpr size_t O_BONUS = 453 * MiB;
constexpr size_t O_MIXG = 464 * MiB;
constexpr size_t O_MEMB = 219 * MiB, O_KB = 225 * MiB, O_VT = 231 * MiB, O_SCORES = 237 * MiB;
constexpr size_t WS_NEED = 512 * MiB;

struct Params {
  const float* in[42];
  float* out;
  char* ws;
};

DEV bf16_t f2bf(float f) { return __builtin_bit_cast(bf16_t, (__bf16)f); }
DEV float bf2f(bf16_t b) { return __uint_as_float(((unsigned)b) << 16); }
typedef __bf16 nbf2_t __attribute__((ext_vector_type(2)));
typedef float nf2_t __attribute__((ext_vector_type(2)));
DEV unsigned pack2(float a, float b) {
  const nf2_t v = {a, b};
  return __builtin_bit_cast(unsigned, __builtin_convertvector(v, nbf2_t));
}
DEV float sigm(float x) { return __builtin_amdgcn_rcpf(1.f + __expf(-x)); }
DEV float tanh_fast(float x) { return 1.f - 2.f * __builtin_amdgcn_rcpf(1.f + __expf(2.f * x)); }
DEV float silu(float x) { return x * sigm(x); }
DEV float logsig(float x) { return fminf(x, 0.f) - __logf(1.f + __expf(-fabsf(x))); }
DEV float wave_sum(float v) {
#pragma unroll
  for (int o = 32; o > 0; o >>= 1) v += __shfl_xor(v, o);
  return v;
}
DEV float wave_max(float v) {
#pragma unroll
  for (int o = 32; o > 0; o >>= 1) v = fmaxf(v, __shfl_xor(v, o));
  return v;
}
template <int CTRL> DEV float dppf(float x) {
  return __builtin_bit_cast(float, __builtin_amdgcn_mov_dpp(__builtin_bit_cast(int, x), CTRL, 0xf, 0xf, true));
}
DEV float row16_sum(float x) {
  x += dppf<0x128>(x);
  x += dppf<0x124>(x);
  x += dppf<0x122>(x);
  x += dppf<0x121>(x);
  return x;
}
DEV void row16_sum2(float& a, float& b) {
  asm volatile("s_nop 1\n\tv_add_f32_dpp %0, %0, %0 row_ror:8 row_mask:0xf bank_mask:0xf\n\tv_add_f32_dpp %1, %1, %1 row_ror:8 row_mask:0xf bank_mask:0xf\n\t"
               "s_nop 1\n\tv_add_f32_dpp %0, %0, %0 row_ror:4 row_mask:0xf bank_mask:0xf\n\tv_add_f32_dpp %1, %1, %1 row_ror:4 row_mask:0xf bank_mask:0xf\n\t"
               "s_nop 1\n\tv_add_f32_dpp %0, %0, %0 row_ror:2 row_mask:0xf bank_mask:0xf\n\tv_add_f32_dpp %1, %1, %1 row_ror:2 row_mask:0xf bank_mask:0xf\n\t"
               "s_nop 1\n\tv_add_f32_dpp %0, %0, %0 row_ror:1 row_mask:0xf bank_mask:0xf\n\tv_add_f32_dpp %1, %1, %1 row_ror:1 row_mask:0xf bank_mask:0xf\n\t"
               "s_nop 0"
               : "+v"(a), "+v"(b));
}
DEV float wave_sum_dpp(float x) {
  x = row16_sum(x);
  const int xi = __builtin_bit_cast(int, x);
  const float s0 = __builtin_bit_cast(float, __builtin_amdgcn_readlane(xi, 0));
  const float s1 = __builtin_bit_cast(float, __builtin_amdgcn_readlane(xi, 16));
  const float s2 = __builtin_bit_cast(float, __builtin_amdgcn_readlane(xi, 32));
  const float s3 = __builtin_bit_cast(float, __builtin_amdgcn_readlane(xi, 48));
  return (s0 + s1) + (s2 + s3);
}
DEV void seq_of_token(int t, int& tb, int& T) {
  if (t < NPROMPT) { tb = t & ~2047; T = 2048; }
  else { int u = t - NPROMPT; tb = NPROMPT + (u & ~8191); T = 8192; }
}
DEV const float* xin_row(const Params& p, int row) {
  return row < NPROMPT ? p.in[0] + (size_t)row * DM : p.in[1] + (size_t)(row - NPROMPT) * DM;
}
DEV void unpack8(uint4 u, float* v) {
  v[0] = __uint_as_float(u.x << 16); v[1] = __uint_as_float(u.x & 0xffff0000u);
  v[2] = __uint_as_float(u.y << 16); v[3] = __uint_as_float(u.y & 0xffff0000u);
  v[4] = __uint_as_float(u.z << 16); v[5] = __uint_as_float(u.z & 0xffff0000u);
  v[6] = __uint_as_float(u.w << 16); v[7] = __uint_as_float(u.w & 0xffff0000u);
}

DEV void unpack8p(uint4 u, f32x2* v) {
  v[0] = (f32x2){__uint_as_float(u.x << 16), __uint_as_float(u.x & 0xffff0000u)};
  v[1] = (f32x2){__uint_as_float(u.y << 16), __uint_as_float(u.y & 0xffff0000u)};
  v[2] = (f32x2){__uint_as_float(u.z << 16), __uint_as_float(u.z & 0xffff0000u)};
  v[3] = (f32x2){__uint_as_float(u.w << 16), __uint_as_float(u.w & 0xffff0000u)};
}

constexpr int LDT = 72;

constexpr int TM = 256;
constexpr int NRT = NTOK / TM;
struct GRegs { u32x4 a0, a1, a2, a3, b0, b1; };
DEV void gemm_gload(GRegs& g, const bf16_t* A0, int lda0, const bf16_t* A1, int lda1, int ksplit,
                    const bf16_t* Bt, int ldb, int k0, int tid) {
  const bf16_t* Ab; int lda, kk;
  if (k0 < ksplit) { Ab = A0; lda = lda0; kk = k0; }
  else { Ab = A1; lda = lda1; kk = k0 - ksplit; }
  const int row = tid >> 2, kc = (tid & 3) * 8;
  const bf16_t* pa = Ab + (size_t)row * lda + kk + kc;
  const bf16_t* pb = Bt + (size_t)row * ldb + k0 + kc;
  g.a0 = *(const u32x4*)(pa);
  g.a1 = *(const u32x4*)(pa + (size_t)64 * lda);
  g.a2 = *(const u32x4*)(pa + (size_t)128 * lda);
  g.a3 = *(const u32x4*)(pa + (size_t)192 * lda);
  g.b0 = *(const u32x4*)(pb);
  g.b1 = *(const u32x4*)(pb + (size_t)64 * ldb);
}
DEV void gemm_lds_write(const GRegs& g, bf16_t* wa, bf16_t* wb) {
  *(u32x4*)(wa) = g.a0; *(u32x4*)(wa + 64 * 32) = g.a1; *(u32x4*)(wa + 128 * 32) = g.a2; *(u32x4*)(wa + 192 * 32) = g.a3;
  *(u32x4*)(wb) = g.b0; *(u32x4*)(wb + 64 * 32) = g.b1;
}

constexpr int GSA = 256 * 32;
constexpr int GST = (256 + 128) * 32;
template <bool RES, class Epi>
DEV void gemm_tile_x(const bf16_t* A0, int lda0, const bf16_t* A1, int lda1, int ksplit,
                     const bf16_t* Bt, int ldb, int K, char* smem, const float* resb, Epi epi) {
  bf16_t* sbase = (bf16_t*)smem;
  const int tid = threadIdx.x, lane = tid & 63, wv = tid >> 6;
  const int wm = wv >> 1, wn = wv & 1;
  f32x16 acc[4][2];
#pragma unroll
  for (int i = 0; i < 4; ++i)
#pragma unroll
    for (int j = 0; j < 2; ++j)
#pragma unroll
      for (int r = 0; r < 16; ++r) acc[i][j][r] = 0.f;
  GRegs g, g1;
  const int nk = K >> 5;
  const int woff = (tid >> 2) * 32 + (((tid & 3) ^ ((tid >> 4) & 3)) << 3);
  const int swz = (lane >> 2) & 3, hh = lane >> 5;
  const int raoff = (wm * 128 + (lane & 31)) * 32;
  const int rboff = GSA + (wn * 64 + (lane & 31)) * 32;
  const int ko0 = ((0 + hh) ^ swz) << 3, ko1 = ((2 + hh) ^ swz) << 3;

  __syncthreads();
  gemm_gload(g, A0, lda0, A1, lda1, ksplit, Bt, ldb, 0, tid);
  if (nk > 1) gemm_gload(g1, A0, lda0, A1, lda1, ksplit, Bt, ldb, 32, tid);
  gemm_lds_write(g, sbase + woff, sbase + GSA + woff);
  if (nk > 2) gemm_gload(g, A0, lda0, A1, lda1, ksplit, Bt, ldb, 64, tid);
  __syncthreads();
#define GEMM_COMPUTE(ST)                                                                                  \
  _Pragma("unroll") for (int ks = 0; ks < 2; ++ks) {                                                      \
    const int ko = ks ? ko1 : ko0;                                                                        \
    bf16x8 a[4], b[2];                                                                                    \
    _Pragma("unroll") for (int mi = 0; mi < 4; ++mi) a[mi] = *(const bf16x8*)((ST) + raoff + mi * 32 * 32 + ko); \
    _Pragma("unroll") for (int ni = 0; ni < 2; ++ni) b[ni] = *(const bf16x8*)((ST) + rboff + ni * 32 * 32 + ko); \
    _Pragma("unroll") for (int mi = 0; mi < 4; ++mi)                                                      \
      _Pragma("unroll") for (int ni = 0; ni < 2; ++ni)                                                    \
        acc[mi][ni] = __builtin_amdgcn_mfma_f32_32x32x16_bf16(a[mi], b[ni], acc[mi][ni], 0, 0, 0);        \
  }
  for (int kt = 0; kt < nk; kt += 2) {
    GEMM_COMPUTE(sbase);
    if (kt + 1 < nk) gemm_lds_write(g1, sbase + GST + woff, sbase + GST + GSA + woff);
    if (kt + 3 < nk) gemm_gload(g1, A0, lda0, A1, lda1, ksplit, Bt, ldb, (kt + 3) * 32, tid);
    __syncthreads();
    if (kt + 1 < nk) {
      GEMM_COMPUTE(sbase + GST);
      if (kt + 2 < nk) gemm_lds_write(g, sbase + woff, sbase + GSA + woff);
      if (kt + 4 < nk) gemm_gload(g, A0, lda0, A1, lda1, ksplit, Bt, ldb, (kt + 4) * 32, tid);
      __syncthreads();
    }
  }
#undef GEMM_COMPUTE
  const int rl = wm * 128 + 4 * (lane >> 5);
  const int col = wn * 64 + (lane & 31);
  const unsigned resoff = (unsigned)(rl * DM + col);
#pragma unroll
  for (int mi = 0; mi < 4; ++mi) {
#pragma unroll
    for (int rh = 0; rh < 2; ++rh) {
      float x0[8], x1[8];
      if (RES) {
#pragma unroll
        for (int r8 = 0; r8 < 8; ++r8) {
          const int r = rh * 8 + r8;
          const int ru = mi * 32 + (r & 3) + 8 * (r >> 2);
          const float* rp = resb + ru * DM;
          x0[r8] = rp[resoff];
          x1[r8] = rp[resoff + 32];
        }
      }
#pragma unroll
      for (int r8 = 0; r8 < 8; ++r8) {
        const int r = rh * 8 + r8;
        const int ru = mi * 32 + (r & 3) + 8 * (r >> 2);
        if (RES) epi(ru, rl, col, acc[mi][0][r], acc[mi][1][r], x0[r8], x1[r8]);
        else epi(ru, rl, col, acc[mi][0][r], acc[mi][1][r], 0.f, 0.f);
        __builtin_amdgcn_sched_barrier(0);
      }
    }
  }
}
template <class Epi>
DEV void gemm_tile(const bf16_t* A0, int lda0, const bf16_t* A1, int lda1, int ksplit,
                   const bf16_t* Bt, int ldb, int K, char* smem, Epi epi) {
  gemm_tile_x<false>(A0, lda0, A1, lda1, ksplit, Bt, ldb, K, smem, nullptr,
                     [&](int ru, int rl, int c, float v0, float v1, float, float) { epi(ru, rl, c, v0, v1); });
}

DEV void wconv(const float* src, int ld, int K, int N, int mode, int coloff, bf16_t* dst, char* smem) {
  float* tile = (float*)smem;
  const int tid = threadIdx.x;
  const int nkt = K >> 6, nnt = N >> 5, nn4 = (nnt + 3) >> 2;
  for (int tl = blockIdx.x; tl < nkt * nn4; tl += gridDim.x) {
    const int kt = tl % nkt, n4 = tl / nkt;
    __syncthreads();
    {
      const int n = tid & 31, kk = tid >> 5;
      float v[4][8];
#pragma unroll
      for (int u = 0; u < 4; ++u) {
        int nt = n4 * 4 + u;
        if (nt >= nnt) nt = nnt - 1;
        const int cb = mode ? ((nt & 1) * DFF + (nt >> 1) * 32) : (coloff + nt * 32);
#pragma unroll
        for (int i = 0; i < 8; ++i) v[u][i] = src[(size_t)(kt * 64 + kk + 8 * i) * ld + cb + n];
      }
#pragma unroll
      for (int u = 0; u < 4; ++u)
#pragma unroll
        for (int i = 0; i < 8; ++i) tile[u * (64 * 33) + (kk + 8 * i) * 33 + n] = v[u][i];
    }
    __syncthreads();
    {
      const int k2 = tid & 31, nn = tid >> 5;
#pragma unroll
      for (int u = 0; u < 4; ++u) {
        const int nt = n4 * 4 + u;
        if (nt < nnt) {
#pragma unroll
          for (int i = 0; i < 4; ++i) {
            const int n = nn + 8 * i;
            const unsigned w = pack2(tile[u * (64 * 33) + (2 * k2) * 33 + n], tile[u * (64 * 33) + (2 * k2 + 1) * 33 + n]);
            *(unsigned*)(dst + (size_t)(nt * 32 + n) * K + kt * 64 + 2 * k2) = w;
          }
        }
      }
    }
  }
  __syncthreads();
}

DEV void ln_load(const float* src, float4 (&v)[4], int lane) {
#pragma unroll
  for (int i = 0; i < 4; ++i) v[i] = *(const float4*)(src + (i * 64 + lane) * 4);
}
DEV void ln_finish(float4 (&v)[4], float* dstf, bf16_t* dstb, const float* g, const float* b, int lane) {
  float s = 0.f;
#pragma unroll
  for (int i = 0; i < 4; ++i) s += v[i].x + v[i].y + v[i].z + v[i].w;
  const float mu = wave_sum_dpp(s) * (1.f / 1024.f);
  float q = 0.f;
#pragma unroll
  for (int i = 0; i < 4; ++i) {
    v[i].x -= mu; v[i].y -= mu; v[i].z -= mu; v[i].w -= mu;
    q += v[i].x * v[i].x + v[i].y * v[i].y + v[i].z * v[i].z + v[i].w * v[i].w;
  }
  const float rs = rsqrtf(wave_sum_dpp(q) * (1.f / 1024.f) + 1e-5f);
#pragma unroll
  for (int i = 0; i < 4; ++i) {
    const int c = (i * 64 + lane) * 4;
    const float4 gg = *(const float4*)(g + c), bb = *(const float4*)(b + c);
    float4 o;
    o.x = v[i].x * rs * gg.x + bb.x; o.y = v[i].y * rs * gg.y + bb.y;
    o.z = v[i].z * rs * gg.z + bb.z; o.w = v[i].w * rs * gg.w + bb.w;
    if (dstf) *(float4*)(dstf + c) = o;
    if (dstb) { uint2 u; u.x = pack2(o.x, o.y); u.y = pack2(o.z, o.w); *(uint2*)(dstb + c) = u; }
  }
}

DEV void phase_ln(const Params& p, const float* g, const float* b, bool write_xb, bool do_mem) {
  const int lane = threadIdx.x & 63;
  const int gw = blockIdx.x * 4 + (threadIdx.x >> 6), nw = gridDim.x * 4;
  bf16_t* xb = (bf16_t*)(p.ws + O_XB);
  for (int r = gw; r < NTOK; r += 4 * nw) {
    float4 v0[4], v1[4], v2[4], v3[4];
    const int r1 = r + nw, r2 = r + 2 * nw, r3 = r + 3 * nw;
    float* row0 = p.out + (size_t)r * DM;
    float* row1 = p.out + (size_t)(r1 < NTOK ? r1 : r) * DM;
    float* row2 = p.out + (size_t)(r2 < NTOK ? r2 : r) * DM;
    float* row3 = p.out + (size_t)(r3 < NTOK ? r3 : r) * DM;
    ln_load(row0, v0, lane);
    ln_load(row1, v1, lane);
    ln_load(row2, v2, lane);
    ln_load(row3, v3, lane);
    ln_finish(v0, row0, write_xb ? xb + (size_t)r * DM : nullptr, g, b, lane);
    if (r1 < NTOK) ln_finish(v1, row1, write_xb ? xb + (size_t)r1 * DM : nullptr, g, b, lane);
    if (r2 < NTOK) ln_finish(v2, row2, write_xb ? xb + (size_t)r2 * DM : nullptr, g, b, lane);
    if (r3 < NTOK) ln_finish(v3, row3, write_xb ? xb + (size_t)r3 * DM : nullptr, g, b, lane);
  }
  if (do_mem) {
    for (int m = gw; m < 3072; m += nw) {
      const float* src = m < 2048 ? p.in[2] + (size_t)m * DM : p.in[3] + (size_t)(m - 2048) * DM;
      float4 v0[4];
      ln_load(src, v0, lane);
      ln_finish(v0, nullptr, (bf16_t*)(p.ws + O_MEMB) + (size_t)m * DM, p.in[31], p.in[32], lane);
    }
  }
}

DEV bool tile_map(int it, int nct, int& rt, int& ct) {
  const int bpx = gridDim.x >> 3, xcd = blockIdx.x & 7, j = blockIdx.x >> 3;
  const int q = j + it * bpx;
  if (q >= 24 * nct) return false;
  const int band = q / (8 * nct), qq = q - band * 8 * nct;
  rt = xcd * 24 + band * 8 + (qq & 7);
  ct = qq >> 3;
  return true;
}

DEV void phase_ffn_in(const Params& p, const bf16_t* wt, char* smem) {
  const bf16_t* xb = (const bf16_t*)(p.ws + O_XB);
  bf16_t* h = (bf16_t*)(p.ws + O_H);
  const int nct = 44;
  int rt, ct;
  for (int it = 0; tile_map(it, nct, rt, ct); ++it) {
    bf16_t* hb = h + (size_t)rt * TM * DFF + ct * 64;
    gemm_tile(xb + (size_t)rt * TM * DM, DM, nullptr, 0, DM, wt + (size_t)ct * 128 * DM, DM, DM, smem,
              [&](int ru, int rl, int c, float v0, float v1) {
                (hb + ru * DFF)[(unsigned)(rl * DFF + (c >> 6) * 32 + (c & 31))] = f2bf(silu(v0) * v1);
              });
  }
}
DEV void phase_gemm_res(const Params& p, const bf16_t* A0, int lda0, const bf16_t* A1, int lda1, int ksplit, int K,
                        const bf16_t* wt, float scale, bool res_is_input, char* smem) {
  const int nct = 8;
  int rt, ct;
  for (int it = 0; tile_map(it, nct, rt, ct); ++it) {
    const int r0 = rt * TM, c0 = ct * 128;
    const bf16_t* a1 = A1 ? A1 + (size_t)r0 * lda1 : nullptr;
    const float* resb = (res_is_input ? xin_row(p, r0) : p.out + (size_t)r0 * DM) + c0;
    float* outb = p.out + (size_t)r0 * DM + c0;
    gemm_tile_x<true>(A0 + (size_t)r0 * lda0, lda0, a1, lda1, ksplit, wt + (size_t)c0 * K, K, K, smem, resb,
              [&](int ru, int rl, int c, float v0, float v1, float x0, float x1) {
                float* op = outb + ru * DM;
                const unsigned off = (unsigned)(rl * DM + c);
                op[off] = ALPHA * x0 + scale * v0;
                op[off + 32] = ALPHA * x1 + scale * v1;
              });
  }
}
DEV void phase_gemm_bf16(const bf16_t* A, int lda, const bf16_t* wt, int K, int N, bf16_t* out, int ldo, char* smem) {
  const int nct = (N + 127) >> 7;
  int rt, ct;
  for (int it = 0; tile_map(it, nct, rt, ct); ++it) {
    const int r0 = rt * TM, c0 = ct * 128;
    gemm_tile(A + (size_t)r0 * lda, lda, nullptr, 0, K, wt + (size_t)c0 * K, K, K, smem,
              [&](int ru, int rl, int c, float v0, float v1) {
                bf16_t* o = out + (size_t)(r0 + ru) * ldo + c0;
                const unsigned off = (unsigned)(rl * ldo + c);
                const int cc = c0 + c;
                if (cc < N) o[off] = f2bf(v0);
                if (cc + 32 < N) o[off + 32] = f2bf(v1);
              });
  }
}

constexpr int GL = 72;
struct GlaSmemM {
  bf16_t VT[128 * GL];
  bf16_t R1[128 * GL];
  bf16_t QB[64 * GL];
  bf16_t P[64 * GL];
  float gd[64 * 32];
  float tot[256];
  float blast[64];
};
static_assert(sizeof(GlaSmemM) <= 65536, "GlaSmemM too big");
constexpr int OBS = 132;

DEV int mfma_row(int r, int lane) { return (r & 3) + 8 * (r >> 2) + 4 * (lane >> 5); }
DEV void mma_k64(f32x16& acc, const bf16_t* sA, const bf16_t* sB, int lane) {
  const int o = (lane & 31) * GL + (lane >> 5) * 8;
#pragma unroll
  for (int ks = 0; ks < 4; ++ks) {
    const bf16x8 a = *(const bf16x8*)(sA + o + ks * 16);
    const bf16x8 b = *(const bf16x8*)(sB + o + ks * 16);
    acc = __builtin_amdgcn_mfma_f32_32x32x16_bf16(a, b, acc, 0, 0, 0);
  }
}
DEV void gla_load_vtg(const bf16_t* proj, int t0, int h, GlaSmemM* s) {
  const int tid = threadIdx.x;
#pragma unroll
  for (int i = 0; i < 4; ++i) {
    const int id = tid + 256 * i, c = id & 63, ec = id >> 6;
    const uint4 u = *(const uint4*)(proj + (size_t)(t0 + c) * GLA_LD + 512 + h * 128 + ec * 8);
    const unsigned w[4] = {u.x, u.y, u.z, u.w};
#pragma unroll
    for (int j = 0; j < 4; ++j) {
      s->VT[(ec * 8 + 2 * j) * GL + c] = (bf16_t)(w[j] & 0xffffu);
      s->VT[(ec * 8 + 2 * j + 1) * GL + c] = (bf16_t)(w[j] >> 16);
    }
  }
  {
    const int c = tid >> 2, part = tid & 3;
    const uint4 u = *(const uint4*)(proj + (size_t)(t0 + c) * GLA_LD + 1536 + part * 8);
    float v[8];
    unpack8(u, v);
#pragma unroll
    for (int j = 0; j < 8; ++j) s->gd[c * 32 + part * 8 + j] = v[j];
  }
}
DEV void gla_gates(const Params& p, int h, int dir, const float* gd, float* tot, float (&b)[16], float& bl) {
  const int tid = threadIdx.x, d = tid & 63, cq = tid >> 6;
  const float* up = dir ? p.in[11] : p.in[9];
  const float* gb = dir ? p.in[12] : p.in[10];
  float u[16];
#pragma unroll
  for (int m = 0; m < 16; ++m) u[m] = up[m * 256 + h * 64 + d];
  const float bias = gb[h * 64 + d];
#pragma unroll
  for (int i = 0; i < 16; ++i) {
    const int c = cq * 16 + i;
    float z = bias;
#pragma unroll
    for (int m4 = 0; m4 < 4; ++m4) {
      const float4 g4 = *(const float4*)(gd + c * 32 + dir * 16 + m4 * 4);
      z += g4.x * u[m4 * 4] + g4.y * u[m4 * 4 + 1] + g4.z * u[m4 * 4 + 2] + g4.w * u[m4 * 4 + 3];
    }
    b[i] = logsig(z) * (1.f / 16.f);
  }
  float run = 0.f;
  if (dir == 0) {
#pragma unroll
    for (int i = 0; i < 16; ++i) { run += b[i]; b[i] = run; }
  } else {
#pragma unroll
    for (int i = 15; i >= 0; --i) { run += b[i]; b[i] = run; }
  }
  tot[cq * 64 + d] = run;
  __syncthreads();
  const float t0 = tot[d], t1 = tot[64 + d], t2 = tot[128 + d], t3 = tot[192 + d];
  float off;
  if (dir == 0) off = (cq > 0 ? t0 : 0.f) + (cq > 1 ? t1 : 0.f) + (cq > 2 ? t2 : 0.f);
  else off = (cq < 3 ? t3 : 0.f) + (cq < 2 ? t2 : 0.f) + (cq < 1 ? t1 : 0.f);
#pragma unroll
  for (int i = 0; i < 16; ++i) b[i] += off;
  bl = (t0 + t1) + (t2 + t3);
}

DEV void phase_gla_a(const Params& p, char* smem) {
  GlaSmemM* s = (GlaSmemM*)smem;
  const bf16_t* proj = (const bf16_t*)(p.ws + O_H);
  float* kv = (float*)(p.ws + O_KV);
  float* dec = (float*)(p.ws + O_DEC);
  const int tid = threadIdx.x, lane = tid & 63, wv = tid >> 6;
  for (int item = blockIdx.x; item < 768 * 4; item += gridDim.x) {
    const int gch = item >> 2, h = item & 3, t0 = gch * 64;
    __syncthreads();
    gla_load_vtg(proj, t0, h, s);
    float kf[16];
    {
      const int d = tid & 63, cq = tid >> 6;
#pragma unroll
      for (int i = 0; i < 16; ++i) kf[i] = bf2f(proj[(size_t)(t0 + cq * 16 + i) * GLA_LD + 256 + h * 64 + d]);
    }
    __syncthreads();
    for (int dir = 0; dir < 2; ++dir) {
      float bb[16], bl;
      gla_gates(p, h, dir, s->gd, s->tot, bb, bl);
      {
        const int d = tid & 63, cq = tid >> 6;
        unsigned w[8];
#pragma unroll
        for (int i = 0; i < 8; ++i)
          w[i] = pack2(kf[2 * i] * __expf(bl - bb[2 * i]), kf[2 * i + 1] * __expf(bl - bb[2 * i + 1]));
        bf16_t* dst = s->R1 + d * GL + cq * 16;
        *(u32x4*)(dst) = (u32x4){w[0], w[1], w[2], w[3]};
        *(u32x4*)(dst + 8) = (u32x4){w[4], w[5], w[6], w[7]};
        if (cq == 0) s->blast[d] = bl;
      }
      __syncthreads();
      f32x16 acc[2];
#pragma unroll
      for (int j = 0; j < 2; ++j)
#pragma unroll
        for (int r = 0; r < 16; ++r) acc[j][r] = 0.f;
#pragma unroll
      for (int db = 0; db < 2; ++db) mma_k64(acc[db], s->VT + wv * 32 * GL, s->R1 + db * 32 * GL, lane);
      const size_t kvi = (size_t)item * 2 + dir;
      float* ob = kv + kvi * 8192;
#pragma unroll
      for (int db = 0; db < 2; ++db)
#pragma unroll
        for (int r = 0; r < 16; ++r) {
          const int e = wv * 32 + mfma_row(r, lane), d = db * 32 + (lane & 31);
          ob[e * 64 + d] = acc[db][r];
        }
      if (tid < 64) dec[kvi * 64 + tid] = __expf(s->blast[tid]);
      __syncthreads();
    }
  }
}

DEV void phase_gla_b(const Params& p) {
  float* kv = (float*)(p.ws + O_KV);
  const float* dec = (const float*)(p.ws + O_DEC);
  const int tid = threadIdx.x;
  for (int unit = blockIdx.x; unit < 96 * 32; unit += gridDim.x) {
    const int sid = unit >> 5, part = unit & 31;
    const int sq = sid >> 3, h = (sid >> 1) & 3, dir = sid & 1;
    int c0, nch;
    if (sq < 4) { c0 = 256 + sq * 128; nch = 128; }
    else { c0 = (sq - 4) * 32; nch = 32; }
    const int e = part * 256 + tid;
    float S = 0.f;
    for (int n0 = 0; n0 < nch; n0 += 8) {
      float tmp[8], dc[8];
#pragma unroll
      for (int u = 0; u < 8; ++u) {
        const int n = n0 + u;
        const int ci = dir ? (c0 + nch - 1 - n) : (c0 + n);
        const size_t idx = ((size_t)ci * 4 + h) * 2 + dir;
        tmp[u] = kv[idx * 8192 + e];
        dc[u] = dec[idx * 64 + (e & 63)];
      }
#pragma unroll
      for (int u = 0; u < 8; ++u) {
        const int n = n0 + u;
        const int ci = dir ? (c0 + nch - 1 - n) : (c0 + n);
        const size_t idx = ((size_t)ci * 4 + h) * 2 + dir;
        kv[idx * 8192 + e] = S;
        S = dc[u] * S + tmp[u];
      }
    }
  }
}

DEV void phase_gla_c(const Params& p, char* smem) {
  GlaSmemM* s = (GlaSmemM*)smem;
  const bf16_t* proj = (const bf16_t*)(p.ws + O_H);
  const float* kv = (const float*)(p.ws + O_KV);
  bf16_t* mixed = (bf16_t*)(p.ws + O_MIXG);
  const int tid = threadIdx.x, lane = tid & 63, wv = tid >> 6;
  const int cg_ = tid >> 4, eg = tid & 15;
  float* Ob = (float*)s->R1;
  static_assert(64 * OBS * 4 <= (128 + 64 + 64) * GL * 2, "output staging does not fit");
  for (int item = blockIdx.x; item < 768 * 4; item += gridDim.x) {
    const int gch = item >> 2, h = item & 3, t0 = gch * 64;
    __syncthreads();
    gla_load_vtg(proj, t0, h, s);
    float qf[16], kf[16];
    {
      const int d = tid & 63, cq = tid >> 6;
#pragma unroll
      for (int i = 0; i < 16; ++i) {
        const bf16_t* row = proj + (size_t)(t0 + cq * 16 + i) * GLA_LD + h * 64 + d;
        qf[i] = bf2f(row[0]) * 0.125f;
        kf[i] = bf2f(row[256]);
      }
    }
    __syncthreads();
    const int cb = wv & 1, eb0 = (wv >> 1) * 2;
    f32x16 acc[2];
#pragma unroll
    for (int j = 0; j < 2; ++j)
#pragma unroll
      for (int r = 0; r < 16; ++r) acc[j][r] = 0.f;
    for (int dir = 0; dir < 2; ++dir) {
      {
        float bb[16], bl;
        gla_gates(p, h, dir, s->gd, s->tot, bb, bl);
        const int d = tid & 63, cq = tid >> 6;
        const float bref = 0.5f * bl;
#pragma unroll
        for (int i = 0; i < 16; ++i) {
          const int c = cq * 16 + i;
          const float b = bb[i];
          const float q = qf[i];
          const float k = kf[i];
          s->R1[c * GL + d] = f2bf(q * __expf(b - bref));
          s->R1[(64 + c) * GL + d] = f2bf(k * __expf(bref - b));
          s->QB[c * GL + d] = f2bf(q * __expf(b));
        }
      }
      __syncthreads();
      {
        const int sb = wv >> 1, cbs = wv & 1;
        f32x16 sc;
#pragma unroll
        for (int r = 0; r < 16; ++r) sc[r] = 0.f;
        mma_k64(sc, s->R1 + (64 + sb * 32) * GL, s->R1 + cbs * 32 * GL, lane);
        const int c = cbs * 32 + (lane & 31);
#pragma unroll
        for (int g = 0; g < 4; ++g) {
          float v[4];
#pragma unroll
          for (int i = 0; i < 4; ++i) {
            const int sr = sb * 32 + 8 * g + 4 * (lane >> 5) + i;
            const bool keep = dir ? (sr >= c) : (sr <= c);
            v[i] = keep ? sc[4 * g + i] : 0.f;
          }
          uint2 w;
          w.x = pack2(v[0], v[1]);
          w.y = pack2(v[2], v[3]);
          *(uint2*)(s->P + c * GL + sb * 32 + 8 * g + 4 * (lane >> 5)) = w;
        }
      }
      const float* Sp = kv + ((size_t)item * 2 + dir) * 8192 + tid * 4;
      f32x4v sv[8];
#pragma unroll
      for (int i = 0; i < 8; ++i) sv[i] = *(const f32x4v*)(Sp + i * 1024);
      __syncthreads();
#pragma unroll
      for (int i = 0; i < 8; ++i) {
        const int el = (tid + 256 * i) * 4, e = el >> 6, d = el & 63;
        uint2 w;
        w.x = pack2(sv[i].x, sv[i].y);
        w.y = pack2(sv[i].z, sv[i].w);
        *(uint2*)(s->R1 + e * GL + d) = w;
      }
#pragma unroll
      for (int j = 0; j < 2; ++j) mma_k64(acc[j], s->P + cb * 32 * GL, s->VT + (eb0 + j) * 32 * GL, lane);
      __syncthreads();
#pragma unroll
      for (int j = 0; j < 2; ++j) mma_k64(acc[j], s->QB + cb * 32 * GL, s->R1 + (eb0 + j) * 32 * GL, lane);
      __syncthreads();
    }
#pragma unroll
    for (int j = 0; j < 2; ++j)
#pragma unroll
      for (int r = 0; r < 16; ++r) {
        const int c = cb * 32 + mfma_row(r, lane), e = (eb0 + j) * 32 + (lane & 31);
        Ob[c * OBS + e] = acc[j][r];
      }
    __syncthreads();
    float ng[8];
#pragma unroll
    for (int j = 0; j < 8; ++j) ng[j] = p.in[13][h * 128 + eg * 8 + j];
#pragma unroll
    for (int i = 0; i < 4; ++i) {
      const int cr = cg_ * 4 + i;
      const float4 o0 = *(const float4*)(Ob + cr * OBS + eg * 8), o1 = *(const float4*)(Ob + cr * OBS + eg * 8 + 4);
      const float o[8] = {o0.x, o0.y, o0.z, o0.w, o1.x, o1.y, o1.z, o1.w};
      float ss = 0.f;
#pragma unroll
      for (int j = 0; j < 8; ++j) ss += o[j] * o[j];
      ss = row16_sum(ss);
      const float rs = rsqrtf(ss * (1.f / 128.f) + 1e-5f);
      const int t = t0 + cr;
      float g[8];
      unpack8(*(const uint4*)(proj + (size_t)t * GLA_LD + 1024 + h * 128 + eg * 8), g);
      uint4 u;
      u.x = pack2(o[0] * rs * ng[0] * silu(g[0]), o[1] * rs * ng[1] * silu(g[1]));
      u.y = pack2(o[2] * rs * ng[2] * silu(g[2]), o[3] * rs * ng[3] * silu(g[3]));
      u.z = pack2(o[4] * rs * ng[4] * silu(g[4]), o[5] * rs * ng[5] * silu(g[5]));
      u.w = pack2(o[6] * rs * ng[6] * silu(g[6]), o[7] * rs * ng[7] * silu(g[7]));
      *(uint4*)(mixed + (size_t)t * 512 + h * 128 + eg * 8) = u;
    }
  }
}

DEV void phase_rw_act(const Params& p) {
  const bf16_t* proj = (const bf16_t*)(p.ws + O_H);
  bf16_t* awda = (bf16_t*)(p.ws + O_XB);
  bf16_t* ag = (bf16_t*)(p.ws + O_ACTG);
  const int total = NTOK * 160;
  const int stride = gridDim.x * 256;
  for (int base = blockIdx.x * 256 + threadIdx.x; base < total; base += 8 * stride) {
    unsigned x[8], pv[8], nx[8];
#pragma unroll
    for (int u = 0; u < 8; ++u) {
      int idx = base + u * stride;
      if (idx >= total) idx = base;
      const int t = idx / 160, cp = idx - t * 160;
      int tb, T;
      seq_of_token(t, tb, T);
      const bf16_t* ptr = proj + (size_t)t * RW_LD + 1536 + cp * 2;
      x[u] = *(const unsigned*)ptr;
      pv[u] = *(const unsigned*)(ptr + (t > tb ? -RW_LD : 0));
      nx[u] = *(const unsigned*)(ptr + (t < tb + T - 1 ? RW_LD : 0));
    }
#pragma unroll
    for (int u = 0; u < 8; ++u) {
      const int idx = base + u * stride;
      if (idx < total) {
        const int t = idx / 160, cp = idx - t * 160;
        int tb, T;
        seq_of_token(t, tb, T);
        const bool hp = t > tb, hn = t < tb + T - 1;
        const int rc = 1536 + cp * 2;
        float v[2];
#pragma unroll
        for (int e = 0; e < 2; ++e) {
          const float xx = e ? __uint_as_float(x[u] & 0xffff0000u) : __uint_as_float(x[u] << 16);
          const float pp = hp ? (e ? __uint_as_float(pv[u] & 0xffff0000u) : __uint_as_float(pv[u] << 16)) : 0.f;
          const float nn = hn ? (e ? __uint_as_float(nx[u] & 0xffff0000u) : __uint_as_float(nx[u] << 16)) : 0.f;
          v[e] = xx + p.in[14][rc + e] * (pp - xx) + p.in[15][rc + e] * (nn - xx);
        }
        const int col = cp * 2;
        if (col < 128) *(unsigned*)(awda + (size_t)t * 192 + col) = pack2(tanh_fast(v[0]), tanh_fast(v[1]));
        else if (col < 192) *(unsigned*)(awda + (size_t)t * 192 + col) = pack2(v[0], v[1]);
        else *(unsigned*)(ag + (size_t)t * 128 + (col - 192)) = pack2(sigm(v[0]), sigm(v[1]));
      }
    }
  }
}

DEV void phase_rw_lowrank(const Params& p, char* smem) {
  const bf16_t* awda = (const bf16_t*)(p.ws + O_XB);
  bf16_t* der = (bf16_t*)(p.ws + O_DER);
  int rt, ct12;
  for (int it = 0; tile_map(it, 12, rt, ct12); ++it) {
    const int which = ct12 >> 2, ct = ct12 & 3;
    const int r0 = rt * TM, c0 = ct * 128;
    const bf16_t* wt = (const bf16_t*)(p.ws + (which == 0 ? W_A_UPF : which == 1 ? W_A_UPB : W_A_AUP));
    const float* bias = which == 0 ? p.in[16] : which == 1 ? p.in[18] : p.in[20];
    bf16_t* out = der + (size_t)which * SLAB;
    gemm_tile(awda + (size_t)r0 * 192 + which * 64, 192, nullptr, 0, 64, wt + (size_t)c0 * 64, 64, 64, smem,
              [&](int ru, int rl, int c, float v0, float v1) {
                bf16_t* o = out + (size_t)(r0 + ru) * 512 + c0;
                const unsigned off = (unsigned)(rl * 512 + c);
                const float z0 = bias[c0 + c] + v0, z1 = bias[c0 + c + 32] + v1;
                if (which < 2) { o[off] = f2bf(-0.6065306597f * sigm(z0)); o[off + 32] = f2bf(-0.6065306597f * sigm(z1)); }
                else { o[off] = f2bf(sigm(z0)); o[off + 32] = f2bf(sigm(z1)); }
              });
  }
}

constexpr int SST = 388;
template <int RPL>
struct StepV { f32x4v w, nk, ka, k, r; float v[RPL]; float kar; };
template <int RPL>
DEV void step_load(StepV<RPL>& x, const float* sb, int jl, int rowbase) {
  x.w = *(const f32x4v*)(sb + jl * 4);
  x.nk = *(const f32x4v*)(sb + 64 + jl * 4);
  x.ka = *(const f32x4v*)(sb + 128 + jl * 4);
  x.k = *(const f32x4v*)(sb + 192 + jl * 4);
  x.r = *(const f32x4v*)(sb + 256 + jl * 4);
#pragma unroll
  for (int r = 0; r < RPL; ++r) x.v[r] = sb[320 + rowbase + r];
  x.kar = sb[384];
}

template <int RPL>
DEV void rwkv_scan(const Params& p, int tb, int T, int head, int dir, int split, float* st) {
  const int tid = threadIdx.x, lane = tid & 63, wv = tid >> 6;
  const int jl = lane & 15, ig = lane >> 4;
  const int hc = head * 64 + lane;
  float* ybuf = st + 2 * 16 * SST;
  const bf16_t* proj = (const bf16_t*)(p.ws + O_H);
  const bf16_t* ldp = (const bf16_t*)(p.ws + O_DER) + (size_t)dir * SLAB;
  const bf16_t* ap = (const bf16_t*)(p.ws + O_DER) + 2 * SLAB;
  bf16_t* yout = (bf16_t*)(p.ws + O_XB) + (size_t)dir * SLAB;
  const float* scal = (const float*)(p.ws + O_BONUS);
  const float mpr = p.in[14][hc], mnr = p.in[15][hc];
  const float mpk = p.in[14][512 + hc], mnk = p.in[15][512 + hc];
  const float mpv = p.in[14][1024 + hc], mnv = p.in[15][1024 + hc];
  const float kkw = p.in[23][hc], kaw = p.in[24][hc];
  const int rowl = wv * 4 * RPL + ig * RPL;
  const int rowbase = split * 16 * RPL + rowl;
  const int nch = T >> 4;
  const int ywoff = (jl == 0) ? rowl : (2 * 16 * 16 * RPL + rowl);
  f32x2 S01[RPL], S23[RPL];
#pragma unroll
  for (int r = 0; r < RPL; ++r) { S01[r] = (f32x2){0.f, 0.f}; S23[r] = (f32x2){0.f, 0.f}; }
  bf16_t rawA[4][11];
  float2 scA[4];

#define RW_LOAD(RAW, SC, CH)                                                            \
  _Pragma("unroll") for (int q = 0; q < 4; ++q) {                                       \
    const int tt_ = (CH) * 16 + wv * 4 + q;                                             \
    const int t_ = dir ? (T - 1 - tt_) : tt_;                                           \
    const bf16_t* row_ = proj + (size_t)(tb + t_) * RW_LD + hc;                         \
    const int op_ = t_ > 0 ? -RW_LD : 0, on_ = t_ < T - 1 ? RW_LD : 0;                  \
    _Pragma("unroll") for (int w = 0; w < 3; ++w) {                                     \
      RAW[q][w * 3 + 0] = row_[w * 512];                                                \
      RAW[q][w * 3 + 1] = row_[w * 512 + op_];                                          \
      RAW[q][w * 3 + 2] = row_[w * 512 + on_];                                          \
    }                                                                                   \
    RAW[q][9] = ldp[(size_t)(tb + t_) * 512 + hc];                                      \
    RAW[q][10] = ap[(size_t)(tb + t_) * 512 + hc];                                      \
    SC[q] = *(const float2*)(scal + ((size_t)(tb + t_) * 8 + head) * 4);                \
  }
#define RW_STAGE(RAW, SC, CH, BUF)                                                      \
  _Pragma("unroll") for (int q = 0; q < 4; ++q) {                                       \
    const int s_ = wv * 4 + q;                                                          \
    const int tt_ = (CH) * 16 + s_;                                                     \
    const int t_ = dir ? (T - 1 - tt_) : tt_;                                           \
    const bool hp_ = t_ > 0, hn_ = t_ < T - 1;                                          \
    float x_ = bf2f(RAW[q][0]);                                                         \
    const float r_ = x_ + mpr * ((hp_ ? bf2f(RAW[q][1]) : 0.f) - x_) + mnr * ((hn_ ? bf2f(RAW[q][2]) : 0.f) - x_);  \
    x_ = bf2f(RAW[q][3]);                                                               \
    const float kr_ = x_ + mpk * ((hp_ ? bf2f(RAW[q][4]) : 0.f) - x_) + mnk * ((hn_ ? bf2f(RAW[q][5]) : 0.f) - x_); \
    x_ = bf2f(RAW[q][6]);                                                               \
    const float v_ = x_ + mpv * ((hp_ ? bf2f(RAW[q][7]) : 0.f) - x_) + mnv * ((hn_ ? bf2f(RAW[q][8]) : 0.f) - x_);  \
    const float a_ = bf2f(RAW[q][10]);                                                  \
    const float kk_ = kr_ * kkw * SC[q].x;                                              \
    const float k2_ = kr_ * (1.f + (a_ - 1.f) * kaw);                                   \
    float* sb_ = st + (BUF) * (16 * SST) + s_ * SST;                                    \
    sb_[lane] = __expf(bf2f(RAW[q][9]));                                                \
    sb_[64 + lane] = -kk_;                                                              \
    sb_[128 + lane] = kk_ * a_;                                                         \
    sb_[192 + lane] = k2_;                                                              \
    sb_[256 + lane] = r_;                                                               \
    sb_[320 + lane] = v_;                                                               \
    if (lane == 0) sb_[384] = SC[q].y;                                                  \
  }
#define RW_MAIN(CH)                                                                     \
  {                                                                                     \
    const int buf = (CH) & 1;                                                           \
    const float* sbase = st + buf * (16 * SST);                                         \
    float* yb = ybuf + buf * (16 * 16 * RPL);                                           \
    StepV<RPL> cur, nxt;                                                                \
    step_load<RPL>(cur, sbase, jl, rowbase);                                            \
    _Pragma("unroll 4") for (int s = 0; s < 16; ++s) {                                  \
      step_load<RPL>(nxt, sbase + ((s + 1) & 15) * SST, jl, rowbase);                   \
      const f32x2 w01 = {cur.w.x, cur.w.y}, w23 = {cur.w.z, cur.w.w};                   \
      const f32x2 n01 = {cur.nk.x, cur.nk.y}, n23 = {cur.nk.z, cur.nk.w};               \
      const f32x2 a01 = {cur.ka.x, cur.ka.y}, a23 = {cur.ka.z, cur.ka.w};               \
      const f32x2 k01 = {cur.k.x, cur.k.y}, k23 = {cur.k.z, cur.k.w};                   \
      const f32x2 r01 = {cur.r.x, cur.r.y}, r23 = {cur.r.z, cur.r.w};                   \
      _Pragma("unroll") for (int r = 0; r < RPL; ++r) {                                 \
        f32x2 pz2 = S01[r] * n01;                                                       \
        pz2 = S23[r] * n23 + pz2;                                                       \
        float sa = pz2.x + pz2.y;                                                       \
        const f32x2 vv = {cur.v[r], cur.v[r]};                                          \
        f32x2 b01 = S01[r] * w01;                                                       \
        f32x2 b23 = S23[r] * w23;                                                       \
        b01 = vv * k01 + b01;                                                           \
        b23 = vv * k23 + b23;                                                           \
        f32x2 y2 = b01 * r01;                                                           \
        y2 = b23 * r23 + y2;                                                            \
        float yb_ = y2.x + y2.y;                                                        \
        row16_sum2(sa, yb_);                                                            \
        const f32x2 sa2 = {sa, sa};                                                     \
        S01[r] = sa2 * a01 + b01;                                                       \
        S23[r] = sa2 * a23 + b23;                                                       \
        const float y = yb_ + sa * cur.kar;                                             \
        yb[s * (16 * RPL) + ywoff + r] = y;                                             \
      }                                                                                 \
      cur = nxt;                                                                        \
    }                                                                                   \
  }
#define RW_FLUSH(CH)                                                                    \
  {                                                                                     \
    const float* yb = ybuf + ((CH) & 1) * (16 * 16 * RPL);                              \
    const int s = tid >> 4, rl = (tid & 15) * RPL;                                      \
    const int tt = (CH) * 16 + s;                                                       \
    const int t = dir ? (T - 1 - tt) : tt;                                              \
    bf16_t* yo = yout + (size_t)(tb + t) * 512 + head * 64 + split * 16 * RPL + rl;     \
    if (RPL == 1) yo[0] = f2bf(yb[s * 16 + rl]);                                        \
    else if (RPL == 2) *(unsigned*)yo = pack2(yb[s * 32 + rl], yb[s * 32 + rl + 1]);    \
    else { uint2 u; u.x = pack2(yb[s * 64 + rl], yb[s * 64 + rl + 1]); u.y = pack2(yb[s * 64 + rl + 2], yb[s * 64 + rl + 3]); *(uint2*)yo = u; } \
  }

  RW_LOAD(rawA, scA, 0);
  RW_STAGE(rawA, scA, 0, 0);
  __syncthreads();
  for (int ch = 0; ch < nch; ++ch) {
    if (ch + 1 < nch) { RW_LOAD(rawA, scA, ch + 1); }
    RW_MAIN(ch);
    if (ch + 1 < nch) { RW_STAGE(rawA, scA, ch + 1, (ch + 1) & 1); }
    __syncthreads();
    RW_FLUSH(ch);
  }
#undef RW_MAIN
#undef RW_FLUSH
#undef RW_LOAD
#undef RW_STAGE
}

DEV void phase_rw_pre(const Params& p) {
  const bf16_t* proj = (const bf16_t*)(p.ws + O_H);
  const bf16_t* ap = (const bf16_t*)(p.ws + O_DER) + 2 * SLAB;
  float* scal = (float*)(p.ws + O_BONUS);
  const int lane = threadIdx.x & 63;
  const int gw = blockIdx.x * 4 + (threadIdx.x >> 6), nw = gridDim.x * 4;
  for (int t = gw; t < NTOK; t += nw) {
    int tb, T;
    seq_of_token(t, tb, T);
    const bool hp = t > tb, hn = t < tb + T - 1;
    const int op = hp ? -RW_LD : 0, on = hn ? RW_LD : 0;
    const bf16_t* row = proj + (size_t)t * RW_LD + lane;
    bf16_t raw[8][7];
#pragma unroll
    for (int h = 0; h < 8; ++h) {
      raw[h][0] = row[h * 64];
      raw[h][1] = row[h * 64 + op];
      raw[h][2] = row[h * 64 + on];
      raw[h][3] = row[512 + h * 64];
      raw[h][4] = row[512 + h * 64 + op];
      raw[h][5] = row[512 + h * 64 + on];
      raw[h][6] = ap[(size_t)t * 512 + h * 64 + lane];
    }
#pragma unroll
    for (int h = 0; h < 8; ++h) {
      const int hc = h * 64 + lane;
      float x = bf2f(raw[h][0]);
      const float r = x + p.in[14][hc] * ((hp ? bf2f(raw[h][1]) : 0.f) - x) + p.in[15][hc] * ((hn ? bf2f(raw[h][2]) : 0.f) - x);
      x = bf2f(raw[h][3]);
      const float kr = x + p.in[14][512 + hc] * ((hp ? bf2f(raw[h][4]) : 0.f) - x) + p.in[15][512 + hc] * ((hn ? bf2f(raw[h][5]) : 0.f) - x);
      const float a = bf2f(raw[h][6]);
      const float kkr = kr * p.in[23][hc];
      const float inv = rsqrtf(fmaxf(wave_sum_dpp(kkr * kkr), 1e-24f));
      const float kk = kkr * inv;
      const float k2 = kr * (1.f + (a - 1.f) * p.in[24][hc]);
      const float kar = wave_sum_dpp(kk * a * r);
      const float bo = wave_sum_dpp(r * k2 * p.in[25][hc]);
      if (lane == 0) *(float4*)(scal + ((size_t)t * 8 + h) * 4) = make_float4(inv, kar, bo, 0.f);
    }
  }
}

DEV void phase_rw_scan(const Params& p, char* smem) {
  float* st = (float*)smem;
  for (int item = blockIdx.x; item < 512; item += gridDim.x) {
    __syncthreads();
    if (item < 256) {
      const int scan = item >> 2, split = item & 3;
      const int sq = scan >> 4, head = (scan >> 1) & 7, dir = scan & 1;
      __builtin_amdgcn_s_setprio(3);
      rwkv_scan<1>(p, NPROMPT + sq * 8192, 8192, head, dir, split, st);
      __builtin_amdgcn_s_setprio(0);
    } else {
      const int it = item - 256;
      const int scan = it >> 1, split = it & 1;
      const int sq = scan >> 4, head = (scan >> 1) & 7, dir = scan & 1;
      rwkv_scan<2>(p, sq * 2048, 2048, head, dir, split, st);
    }
  }
}

DEV void phase_rw_post(const Params& p) {
  const bf16_t* proj = (const bf16_t*)(p.ws + O_H);
  bf16_t* yf = (bf16_t*)(p.ws + O_XB);
  const bf16_t* yb = yf + SLAB;
  const bf16_t* gate = (const bf16_t*)(p.ws + O_DER) + 2 * SLAB;
  const float* scal = (const float*)(p.ws + O_BONUS);
  const int lane = threadIdx.x & 63;
  const int gw = blockIdx.x * 4 + (threadIdx.x >> 6), nw = gridDim.x * 4;
  for (int t = gw; t < NTOK; t += nw) {
    int tb, T;
    seq_of_token(t, tb, T);
    const bool hp = t > tb, hn = t < tb + T - 1;
    const int op = hp ? -RW_LD : 0, on = hn ? RW_LD : 0;
    const bf16_t* vrow = proj + (size_t)t * RW_LD + 1024 + lane;
    bf16_t raw[8][6];
    float bo[8];
#pragma unroll
    for (int h = 0; h < 8; ++h) {
      const size_t o = (size_t)t * 512 + h * 64 + lane;
      raw[h][0] = yf[o];
      raw[h][1] = yb[o];
      raw[h][2] = vrow[h * 64];
      raw[h][3] = vrow[h * 64 + op];
      raw[h][4] = vrow[h * 64 + on];
      raw[h][5] = gate[o];
      bo[h] = scal[((size_t)t * 8 + h) * 4 + 2];
    }
    bf16_t res[8];
#pragma unroll
    for (int h = 0; h < 8; ++h) {
      const int hc = h * 64 + lane;
      const float y = bf2f(raw[h][0]) + bf2f(raw[h][1]);
      const float mu = wave_sum_dpp(y) * (1.f / 64.f);
      const float dy = y - mu;
      const float var = wave_sum_dpp(dy * dy) * (1.f / 64.f);
      const float yn = dy * rsqrtf(var + 64e-5f) * p.in[26][hc] + p.in[27][hc];
      const float x = bf2f(raw[h][2]);
      const float v = x + p.in[14][1024 + hc] * ((hp ? bf2f(raw[h][3]) : 0.f) - x) + p.in[15][1024 + hc] * ((hn ? bf2f(raw[h][4]) : 0.f) - x);
      res[h] = f2bf((yn + bo[h] * v) * bf2f(raw[h][5]));
    }
#pragma unroll
    for (int h = 0; h < 8; ++h) yf[(size_t)t * 512 + h * 64 + lane] = res[h];
  }
}

DEV int seq_of_rowtile(int rt) { return rt < 64 ? (rt >> 3) : 8 + ((rt - 64) >> 5); }

DEV void phase_ca_qkv(const Params& p, char* smem) {
  const bf16_t* xb = (const bf16_t*)(p.ws + O_XB);
  bf16_t* qb = (bf16_t*)(p.ws + O_H);
  const bf16_t* memb = (const bf16_t*)(p.ws + O_MEMB);
  bf16_t* kb = (bf16_t*)(p.ws + O_KB);
  bf16_t* vt = (bf16_t*)(p.ws + O_VT);
  const bf16_t* wq = (const bf16_t*)(p.ws + W_B_Q);
  const bf16_t* wkv = (const bf16_t*)(p.ws + W_B_KV);
  {
    int rt, ct;
    for (int it = 0; tile_map(it, 8, rt, ct); ++it) {
      const int r0 = rt * TM, c0 = ct * 128;
      gemm_tile(xb + (size_t)r0 * DM, DM, nullptr, 0, DM, wq + (size_t)c0 * DM, DM, DM, smem,
                [&](int ru, int rl, int c, float v0, float v1) {
                  bf16_t* o = qb + (size_t)(r0 + ru) * DM + c0;
                  const unsigned off = (unsigned)(rl * DM + c);
                  o[off] = f2bf(v0); o[off + 32] = f2bf(v1);
                });
    }
  }
  {
    for (int t2 = blockIdx.x; t2 < 12 * 16; t2 += gridDim.x) {
      const int rt = t2 >> 4, ct = t2 & 15;
      const int r0 = rt * TM, c0 = ct * 128;
      if (ct < 8) {
        bf16_t* o = kb + (size_t)r0 * DM + c0;
        gemm_tile(memb + (size_t)r0 * DM, DM, nullptr, 0, DM, wkv + (size_t)c0 * DM, DM, DM, smem,
                  [&](int ru, int rl, int c, float v0, float v1) {
                    const unsigned off = (unsigned)(rl * DM + c);
                    (o + ru * DM)[off] = f2bf(v0);
                    (o + ru * DM)[off + 32] = f2bf(v1);
                  });
      } else {
        bf16_t* o = vt + ((size_t)rt * 1024 + (c0 - 1024)) * 256;
        gemm_tile(memb + (size_t)r0 * DM, DM, nullptr, 0, DM, wkv + (size_t)c0 * DM, DM, DM, smem,
                  [&](int ru, int rl, int c, float v0, float v1) {
                    const unsigned off = (unsigned)(c * 256 + rl);
                    (o + ru)[off] = f2bf(v0);
                    (o + ru)[off + 32 * 256] = f2bf(v1);
                  });
      }
    }
  }
}
DEV void phase_ca_scores(const Params& p, char* smem) {
  const bf16_t* qb = (const bf16_t*)(p.ws + O_H);
  const bf16_t* kb = (const bf16_t*)(p.ws + O_KB);
  float* sc = (float*)(p.ws + O_SCORES);
  int rt, ct8;
  for (int it = 0; tile_map(it, 8, rt, ct8); ++it) {
    const int h = ct8 >> 1, nt = ct8 & 1;
    const int b = seq_of_rowtile(rt), r0 = rt * TM;
    gemm_tile(qb + (size_t)r0 * DM + h * 256, DM, nullptr, 0, 256,
              kb + (size_t)(b * 256 + nt * 128) * DM + h * 256, DM, 256, smem,
              [&](int ru, int rl, int c, float v0, float v1) {
                float* o = sc + (size_t)(r0 + ru) * DM + h * 256 + nt * 128;
                const unsigned off = (unsigned)(rl * DM + c);
                o[off] = v0 * 0.0625f; o[off + 32] = v1 * 0.0625f;
              });
  }
}
DEV void phase_ca_softmax(const Params& p) {
  const float* sc = (const float*)(p.ws + O_SCORES);
  bf16_t* pb = (bf16_t*)(p.ws + O_H);
  const int lane = threadIdx.x & 63;
  const int gw = blockIdx.x * 4 + (threadIdx.x >> 6), nw = gridDim.x * 4;
  const int total = NTOK * 4;
  for (int it = gw; it < total; it += 4 * nw) {
    float4 v[4];
#pragma unroll
    for (int u = 0; u < 4; ++u) {
      const int i2 = it + u * nw;
      v[u] = *(const float4*)(sc + (size_t)(i2 < total ? i2 : it) * 256 + lane * 4);
    }
#pragma unroll
    for (int u = 0; u < 4; ++u) {
      const int i2 = it + u * nw;
      float mx = fmaxf(fmaxf(v[u].x, v[u].y), fmaxf(v[u].z, v[u].w));
      mx = fmaxf(mx, dppf<0x128>(mx)); mx = fmaxf(mx, dppf<0x124>(mx)); mx = fmaxf(mx, dppf<0x122>(mx)); mx = fmaxf(mx, dppf<0x121>(mx));
      {
        const int xi = __builtin_bit_cast(int, mx);
        const float m0 = __builtin_bit_cast(float, __builtin_amdgcn_readlane(xi, 0));
        const float m1 = __builtin_bit_cast(float, __builtin_amdgcn_readlane(xi, 16));
        const float m2 = __builtin_bit_cast(float, __builtin_amdgcn_readlane(xi, 32));
        const float m3 = __builtin_bit_cast(float, __builtin_amdgcn_readlane(xi, 48));
        mx = fmaxf(fmaxf(m0, m1), fmaxf(m2, m3));
      }
      const float e0 = __expf(v[u].x - mx), e1 = __expf(v[u].y - mx), e2 = __expf(v[u].z - mx), e3 = __expf(v[u].w - mx);
      const float inv = 1.f / wave_sum_dpp(e0 + e1 + e2 + e3);
      if (i2 < total) {
        uint2 w;
        w.x = pack2(e0 * inv, e1 * inv);
        w.y = pack2(e2 * inv, e3 * inv);
        *(uint2*)(pb + (size_t)i2 * 256 + lane * 4) = w;
      }
    }
  }
}
DEV void phase_ca_pv(const Params& p, char* smem) {
  const bf16_t* pb = (const bf16_t*)(p.ws + O_H);
  const bf16_t* vt = (const bf16_t*)(p.ws + O_VT);
  bf16_t* attn = (bf16_t*)(p.ws + O_XB);
  int rt, ct8;
  for (int it = 0; tile_map(it, 8, rt, ct8); ++it) {
    const int h = ct8 >> 1, nt = ct8 & 1;
    const int b = seq_of_rowtile(rt), r0 = rt * TM;
    gemm_tile(pb + (size_t)r0 * DM + h * 256, DM, nullptr, 0, 256,
              vt + ((size_t)b * 1024 + h * 256 + nt * 128) * 256, 256, 256, smem,
              [&](int ru, int rl, int c, float v0, float v1) {
                bf16_t* o = attn + (size_t)(r0 + ru) * DM + h * 256 + nt * 128;
                const unsigned off = (unsigned)(rl * DM + c);
                o[off] = f2bf(v0); o[off + 32] = f2bf(v1);
              });
  }
}

DEV void phase_convert_x(const Params& p) {
  bf16_t* xb = (bf16_t*)(p.ws + O_XB);
  const size_t n4 = (size_t)NTOK * DM / 4;
  const size_t np4 = (size_t)NPROMPT * DM / 4;
  const size_t stride = (size_t)gridDim.x * 256;
  for (size_t i = (size_t)blockIdx.x * 256 + threadIdx.x; i < n4; i += 8 * stride) {
    float4 v[8];
#pragma unroll
    for (int u = 0; u < 8; ++u) {
      size_t j = i + u * stride;
      if (j >= n4) j = i;
      v[u] = j < np4 ? ((const float4*)p.in[0])[j] : ((const float4*)p.in[1])[j - np4];
    }
#pragma unroll
    for (int u = 0; u < 8; ++u) {
      const size_t j = i + u * stride;
      if (j < n4) {
        uint2 w;
        w.x = pack2(v[u].x, v[u].y);
        w.y = pack2(v[u].z, v[u].w);
        ((uint2*)xb)[j] = w;
      }
    }
  }
}

constexpr int NPHASE = 25;
constexpr int SMEM_BYTES = 64 * 1024;

DEV void run_phase(const Params& p, int ph, char* smem) {
  char* ws = p.ws;
    switch (ph) {
      case 0:
        wconv(p.in[4], 2 * DFF, DM, 2 * DFF, 1, 0, (bf16_t*)(ws + W_A_FFN_IN), smem);
        wconv(p.in[5], DM, DFF, DM, 0, 0, (bf16_t*)(ws + W_A_FFN_OUT), smem);
        wconv(p.in[8], 3424, DM, 1568, 0, 0, (bf16_t*)(ws + W_A_MIX_IN), smem);
        wconv(p.in[8], 3424, DM, 1856, 0, 1568, (bf16_t*)(ws + W_A_MIX_IN) + (size_t)1664 * DM, smem);
        wconv(p.in[17], 512, 64, 512, 0, 0, (bf16_t*)(ws + W_A_UPF), smem);
        wconv(p.in[19], 512, 64, 512, 0, 0, (bf16_t*)(ws + W_A_UPB), smem);
        wconv(p.in[21], 512, 64, 512, 0, 0, (bf16_t*)(ws + W_A_AUP), smem);
        wconv(p.in[22], 512, 128, 512, 0, 0, (bf16_t*)(ws + W_A_GUP), smem);
        phase_convert_x(p);
        break;
      case 1: phase_ffn_in(p, (const bf16_t*)(ws + W_A_FFN_IN), smem); break;
      case 2: phase_gemm_res(p, (const bf16_t*)(ws + O_H), DFF, nullptr, 0, DFF, DFF, (const bf16_t*)(ws + W_A_FFN_OUT), 0.5f, true, smem); break;
      case 3: phase_ln(p, p.in[6], p.in[7], true, false); break;
      case 4: phase_gemm_bf16((const bf16_t*)(ws + O_XB), DM, (const bf16_t*)(ws + W_A_MIX_IN), DM, 1568, (bf16_t*)(ws + O_H), GLA_LD, smem); break;
      case 5: phase_gla_a(p, smem); break;
      case 6: phase_gla_b(p); break;
      case 7: phase_gla_c(p, smem); break;
      case 8: phase_gemm_bf16((const bf16_t*)(ws + O_XB), DM, (const bf16_t*)(ws + W_A_MIX_IN) + (size_t)1664 * DM, DM, 1856, (bf16_t*)(ws + O_H), RW_LD, smem); break;
      case 9: phase_rw_act(p); break;
      case 10: phase_rw_lowrank(p, smem); break;
      case 11: phase_rw_pre(p); break;
      case 12: phase_rw_scan(p, smem); break;
      case 13: phase_gemm_bf16((const bf16_t*)(ws + O_ACTG), 128, (const bf16_t*)(ws + W_A_GUP), 128, 512, (bf16_t*)(ws + O_DER) + 2 * SLAB, 512, smem); break;
      case 14:
        phase_rw_post(p);
        wconv(p.in[28], DM, DM, DM, 0, 0, (bf16_t*)(ws + W_B_MIX_OUT), smem);
        wconv(p.in[33], DM, DM, DM, 0, 0, (bf16_t*)(ws + W_B_Q), smem);
        wconv(p.in[34], 2 * DM, DM, 2 * DM, 0, 0, (bf16_t*)(ws + W_B_KV), smem);
        wconv(p.in[35], DM, DM, DM, 0, 0, (bf16_t*)(ws + W_B_O), smem);
        wconv(p.in[38], 2 * DFF, DM, 2 * DFF, 1, 0, (bf16_t*)(ws + W_B_FFN_IN), smem);
        wconv(p.in[39], DM, DFF, DM, 0, 0, (bf16_t*)(ws + W_B_FFN_OUT), smem);
        break;
      case 15: phase_gemm_res(p, (const bf16_t*)(ws + O_MIXG), 512, (const bf16_t*)(ws + O_XB), 512, 512, DM, (const bf16_t*)(ws + W_B_MIX_OUT), 1.0f, false, smem); break;
      case 16: phase_ln(p, p.in[29], p.in[30], true, true); break;
      case 17: phase_ca_qkv(p, smem); break;
      case 18: phase_ca_scores(p, smem); break;
      case 19: phase_ca_softmax(p); break;
      case 20: phase_ca_pv(p, smem); break;
      case 21: phase_gemm_res(p, (const bf16_t*)(ws + O_XB), DM, nullptr, 0, DM, DM, (const bf16_t*)(ws + W_B_O), 1.0f, false, smem); break;
      case 22: phase_ln(p, p.in[36], p.in[37], true, false); break;
      case 23: phase_ffn_in(p, (const bf16_t*)(ws + W_B_FFN_IN), smem); break;
      case 24: phase_gemm_res(p, (const bf16_t*)(ws + O_H), DFF, nullptr, 0, DFF, DFF, (const bf16_t*)(ws + W_B_FFN_OUT), 0.5f, false, smem); break;
      case 25: phase_ln(p, p.in[40], p.in[41], false, false); break;
      default: break;
    }
}

constexpr size_t O_BAR = 463 * MiB + 768 * 1024;
#define XB_TMO      128
#define XB_XCNT(j)  (256  + 64 * (j))
#define XB_XSUB(j)  (1280 + 64 * (j))
#define XB_XGEN(j)  (2304 + 64 * (j))
#define XB_TOP      3328
#define XB_TOPGEN   3392
#define XCD_BAR_WORDS 3456
#define XB_SPIN_CAP (1u << 18)
#define LAS __attribute__((address_space(3)))

__device__ __forceinline__ unsigned xb_ld(unsigned* p)              { return __hip_atomic_load(p, __ATOMIC_RELAXED, __HIP_MEMORY_SCOPE_AGENT); }
__device__ __forceinline__ unsigned xb_add(unsigned* p, unsigned v) { return __hip_atomic_fetch_add(p, v, __ATOMIC_RELAXED, __HIP_MEMORY_SCOPE_AGENT); }
__device__ __forceinline__ unsigned xb_xcc_id() { return (unsigned)__builtin_amdgcn_s_getreg((3 << 11) | 20) & 0xFu; }
#define XB_SPIN(cond, bar) do { unsigned _sp = 0; while (cond) { __builtin_amdgcn_s_sleep(1); \
    if ((++_sp & 255u) == 0u) { if (xb_ld(&(bar)[XB_TMO])) break; if (_sp > XB_SPIN_CAP) { atomicAdd(&(bar)[XB_TMO], 1u); break; } } } } while (0)

struct XcdBarrier {
    unsigned* bar; unsigned x;
    volatile LAS unsigned* st;
};

__device__ __forceinline__ XcdBarrier xcd_barrier_post(unsigned* bar, volatile LAS unsigned* st) {
    XcdBarrier b; b.bar = bar; b.x = xb_xcc_id(); b.st = st;
    if (threadIdx.x == 0) (void)xb_add(&bar[XB_XCNT(b.x)], 1u);
    return b;
}
__device__ __forceinline__ void xcd_barrier_complete(unsigned* bar, unsigned x, unsigned& nloc, unsigned& nx) {
    const unsigned G = gridDim.x * gridDim.y * gridDim.z;
    unsigned sum, cnt, mine, sp = 0u;
    for (;;) {
        sum = 0u; cnt = 0u; mine = 0u;
#pragma unroll
        for (unsigned j = 0; j < 16; ++j) { const unsigned c = xb_ld(&bar[XB_XCNT(j)]); sum += c; cnt += (c > 0u) ? 1u : 0u; mine = (j == x) ? c : mine; }
        if (sum == G) break;
        __builtin_amdgcn_s_sleep(1);
        if ((++sp & 255u) == 0u) { if (xb_ld(&bar[XB_TMO])) break; if (sp > XB_SPIN_CAP) { atomicAdd(&bar[XB_TMO], 1u); break; } }
    }
    nloc = mine > 0u ? mine : 1u; nx = cnt > 0u ? cnt : 1u;
}

__device__ __forceinline__ void xcd_barrier(const XcdBarrier& b) {
    asm volatile("s_waitcnt vmcnt(0)" ::: "memory");
    __syncthreads();
    if (threadIdx.x == 0) {
        unsigned* bar = b.bar;
        __builtin_amdgcn_s_waitcnt(0);
        unsigned nloc = b.st[0], nx = b.st[1];
        if (nloc == 0u) { xcd_barrier_complete(bar, b.x, nloc, nx); b.st[0] = nloc; b.st[1] = nx; }
        const unsigned old = xb_add(&bar[XB_XSUB(b.x)], 1u);
        const unsigned gen = old / nloc;
        if (old + 1u == (gen + 1u) * nloc) {
            __builtin_amdgcn_fence(__ATOMIC_RELEASE, "agent");
            asm volatile("s_waitcnt vmcnt(0)" ::: "memory");
            const unsigned og = xb_add(&bar[XB_TOP], 1u);
            const unsigned tg = og / nx;
            if (og + 1u == (tg + 1u) * nx) xb_add(&bar[XB_TOPGEN], 1u);
            else XB_SPIN(xb_ld(&bar[XB_TOPGEN]) == tg, bar);
            __builtin_amdgcn_fence(__ATOMIC_ACQUIRE, "agent");
            xb_add(&bar[XB_XGEN(b.x)], 1u);
            asm volatile("s_waitcnt vmcnt(0)" ::: "memory");
        } else {
            XB_SPIN(xb_ld(&bar[XB_XGEN(b.x)]) == gen, bar);
            __builtin_amdgcn_fence(__ATOMIC_ACQUIRE, "agent");
            asm volatile("s_waitcnt vmcnt(0)" ::: "memory");
        }
    }
    __syncthreads();
}

#define PHASE_STEP(N) if (ph_lo <= N && N < ph_hi) { for (int rep = 0; rep <= (int)((dup >> N) & 1u); ++rep) { run_phase(p, N, smem); if (N + 1 < ph_hi) { if (ph_lo < 0) grid.sync(); else { XcdBarrier xb_; xb_.bar = (unsigned*)(p.ws + O_BAR); xb_.st = (volatile LAS unsigned*)&xb_words; xb_.x = xb_.st[2]; xcd_barrier(xb_); } } } }
__global__ void __launch_bounds__(256, 2) mega(Params p, int ph_lo, int ph_hi, unsigned dup) {
  __shared__ __attribute__((aligned(16))) char smem[SMEM_BYTES];
  cg::grid_group grid = cg::this_grid();
  __shared__ uint4 xb_words;
  if (threadIdx.x == 0) xb_words = make_uint4(0u, 0u, 0u, 0u);
  __syncthreads();
  if (ph_hi - ph_lo > 1) {
    XcdBarrier xb = xcd_barrier_post((unsigned*)(p.ws + O_BAR), (volatile LAS unsigned*)&xb_words);
    if (threadIdx.x == 0) xb_words.z = xb.x;
    __syncthreads();
  }
  PHASE_STEP(0)
  PHASE_STEP(1)
  PHASE_STEP(2)
  PHASE_STEP(3)
  PHASE_STEP(4)
  PHASE_STEP(5)
  PHASE_STEP(6)
  PHASE_STEP(7)
  PHASE_STEP(8)
  PHASE_STEP(9)
  PHASE_STEP(10)
  PHASE_STEP(11)
  PHASE_STEP(12)
  PHASE_STEP(13)
  PHASE_STEP(14)
  PHASE_STEP(15)
  PHASE_STEP(16)
  PHASE_STEP(17)
  PHASE_STEP(18)
  PHASE_STEP(19)
  PHASE_STEP(20)
  PHASE_STEP(21)
  PHASE_STEP(22)
  PHASE_STEP(23)
  PHASE_STEP(24)
  PHASE_STEP(25)
}

#ifdef PHASE_TEST
template <int PH> __global__ void __launch_bounds__(256, 2) mega_t(Params p) {
  __shared__ __attribute__((aligned(16))) char smem[SMEM_BYTES];
  run_phase(p, PH, smem);
}
template __global__ void mega_t<0>(Params);
template __global__ void mega_t<1>(Params);
template __global__ void mega_t<2>(Params);
template __global__ void mega_t<3>(Params);
template __global__ void mega_t<4>(Params);
template __global__ void mega_t<5>(Params);
template __global__ void mega_t<6>(Params);
template __global__ void mega_t<7>(Params);
template __global__ void mega_t<8>(Params);
template __global__ void mega_t<9>(Params);
template __global__ void mega_t<10>(Params);
template __global__ void mega_t<11>(Params);
template __global__ void mega_t<12>(Params);
template __global__ void mega_t<13>(Params);
template __global__ void mega_t<14>(Params);
template __global__ void mega_t<15>(Params);
template __global__ void mega_t<16>(Params);
template __global__ void mega_t<17>(Params);
template __global__ void mega_t<18>(Params);
template __global__ void mega_t<19>(Params);
template __global__ void mega_t<20>(Params);
template __global__ void mega_t<21>(Params);
template __global__ void mega_t<22>(Params);
template __global__ void mega_t<23>(Params);
template __global__ void mega_t<24>(Params);
template __global__ void mega_t<25>(Params);
#endif

extern "C" void kernel_launch(void* const* d_in, const int* in_sizes, int n_in, void* d_out, int out_size,
                              void* d_ws, size_t ws_size, hipStream_t stream) {
  if (ws_size < WS_NEED || n_in < 42) {
    fprintf(stderr, "kernel_launch: workspace too small (%zu) or inputs missing (%d)\n", ws_size, n_in);
    return;
  }
  static int grid_blocks = 0;
  if (!grid_blocks) {
    int dev = 0, cus = 0, per_cu = 0;
    hipGetDevice(&dev);
    hipDeviceGetAttribute(&cus, hipDeviceAttributeMultiprocessorCount, dev);
    hipOccupancyMaxActiveBlocksPerMultiprocessor(&per_cu, mega, 256, 0);
    if (per_cu > 2) per_cu = 2;
    if (per_cu < 1) per_cu = 1;
    grid_blocks = cus * per_cu;
  }
  Params p{};
  for (int i = 0; i < 42; ++i) p.in[i] = (const float*)d_in[i];
  p.out = (float*)d_out;
  p.ws = (char*)d_ws;
  const int nph = NPHASE + 1;
#if MULTI_LAUNCH
  for (int ph = 0; ph < nph; ++ph) {
    hipLaunchKernelGGL(mega, dim3(grid_blocks), dim3(256), 0, stream, p, ph, ph + 1, 0u);
  }
#else
#ifndef PROBE_DUP
#define PROBE_DUP 0u
#endif
  hipMemsetAsync((char*)d_ws + O_BAR, 0, XCD_BAR_WORDS * 4, stream);
  int lo = 0, hi = nph;
  unsigned dup = PROBE_DUP;
  void* args[] = {&p, &lo, &hi, &dup};
  hipError_t e = hipLaunchCooperativeKernel((void*)mega, dim3(grid_blocks), dim3(256), args, 0, stream);
  if (e != hipSuccess) fprintf(stderr, "cooperative launch failed: %s (grid %d)\n", hipGetErrorString(e), grid_blocks);
#endif
}
```

```cpp
#include <hip/hip_runtime.h>
#include <hip/hip_bf16.h>
#include <hip/hip_cooperative_groups.h>
#include <cstdio>
namespace cg = cooperative_groups;

#ifndef MULTI_LAUNCH
#define MULTI_LAUNCH 0
#endif

typedef unsigned short bf16_t;
using bf16x8 = __attribute__((ext_vector_type(8))) short;
using f32x16 = __attribute__((ext_vector_type(16))) float;
using u32x4 = __attribute__((ext_vector_type(4))) unsigned;
using f32x2 = __attribute__((ext_vector_type(2))) float;
using f32x4v = __attribute__((ext_vector_type(4))) float;

#define DEV __device__ __forceinline__

constexpr int NTOK = 49152;
constexpr int NPROMPT = 16384;
constexpr int DM = 1024;
constexpr int DFF = 2816;
constexpr int GLA_LD = 1568;
constexpr int RW_LD = 1856;
constexpr float ALPHA = 1.189207115002721f;
constexpr size_t MiB = 1ull << 20;
constexpr size_t SLAB = (size_t)NTOK * 512;

constexpr size_t W_A_FFN_IN = 0, W_A_FFN_OUT = 11 * MiB, W_A_MIX_IN = 17 * MiB, W_A_UPF = 24 * MiB,
                 W_A_UPB = 24 * MiB + 65536, W_A_AUP = 24 * MiB + 2 * 65536, W_A_GUP = 24 * MiB + 3 * 65536;
constexpr size_t W_B_MIX_OUT = 0, W_B_Q = 2 * MiB, W_B_KV = 4 * MiB, W_B_O = 8 * MiB, W_B_FFN_IN = 10 * MiB, W_B_FFN_OUT = 21 * MiB;
constexpr size_t O_XB = 27 * MiB;
constexpr size_t O_H = 123 * MiB;
constexpr size_t O_KV = 270 * MiB;
constexpr size_t O_DEC = 462 * MiB;
constexpr size_t O_DER = 297 * MiB;
constexpr size_t O_ACTG = 441 * MiB;
constexpr size_t O_BONUS = 453 * MiB;
constexpr size_t O_MIXG = 464 * MiB;
constexpr size_t O_MEMB = 219 * MiB, O_KB = 225 * MiB, O_VT = 231 * MiB, O_SCORES = 237 * MiB;
constexpr size_t WS_NEED = 512 * MiB;

struct Params {
  const float* in[42];
  float* out;
  char* ws;
};

DEV bf16_t f2bf(float f) { return __builtin_bit_cast(bf16_t, (__bf16)f); }
DEV float bf2f(bf16_t b) { return __uint_as_float(((unsigned)b) << 16); }
typedef __bf16 nbf2_t __attribute__((ext_vector_type(2)));
typedef float nf2_t __attribute__((ext_vector_type(2)));
DEV unsigned pack2(float a, float b) {
  const nf2_t v = {a, b};
  return __builtin_bit_cast(unsigned, __builtin_convertvector(v, nbf2_t));
}
DEV float sigm(float x) { return __builtin_amdgcn_rcpf(1.f + __expf(-x)); }
DEV float tanh_fast(float x) { return 1.f - 2.f * __builtin_amdgcn_rcpf(1.f + __expf(2.f * x)); }
DEV float silu(float x) { return x * sigm(x); }
DEV float logsig(float x) { return fminf(x, 0.f) - __logf(1.f + __expf(-fabsf(x))); }
DEV float wave_sum(float v) {
#pragma unroll
  for (int o = 32; o > 0; o >>= 1) v += __shfl_xor(v, o);
  return v;
}
DEV float wave_max(float v) {
#pragma unroll
  for (int o = 32; o > 0; o >>= 1) v = fmaxf(v, __shfl_xor(v, o));
  return v;
}
template <int CTRL> DEV float dppf(float x) {
  return __builtin_bit_cast(float, __builtin_amdgcn_mov_dpp(__builtin_bit_cast(int, x), CTRL, 0xf, 0xf, true));
}
DEV float row16_sum(float x) {
  x += dppf<0x128>(x);
  x += dppf<0x124>(x);
  x += dppf<0x122>(x);
  x += dppf<0x121>(x);
  return x;
}
DEV void row16_sum2(float& a, float& b) {
  asm volatile("s_nop 1\n\tv_add_f32_dpp %0, %0, %0 row_ror:8 row_mask:0xf bank_mask:0xf\n\tv_add_f32_dpp %1, %1, %1 row_ror:8 row_mask:0xf bank_mask:0xf\n\t"
               "s_nop 1\n\tv_add_f32_dpp %0, %0, %0 row_ror:4 row_mask:0xf bank_mask:0xf\n\tv_add_f32_dpp %1, %1, %1 row_ror:4 row_mask:0xf bank_mask:0xf\n\t"
               "s_nop 1\n\tv_add_f32_dpp %0, %0, %0 row_ror:2 row_mask:0xf bank_mask:0xf\n\tv_add_f32_dpp %1, %1, %1 row_ror:2 row_mask:0xf bank_mask:0xf\n\t"
               "s_nop 1\n\tv_add_f32_dpp %0, %0, %0 row_ror:1 row_mask:0xf bank_mask:0xf\n\tv_add_f32_dpp %1, %1, %1 row_ror:1 row_mask:0xf bank_mask:0xf\n\t"
               "s_nop 0"
               : "+v"(a), "+v"(b));
}
DEV float wave_sum_dpp(float x) {
  x = row16_sum(x);
  const int xi = __builtin_bit_cast(int, x);
  const float s0 = __builtin_bit_cast(float, __builtin_amdgcn_readlane(xi, 0));
  const float s1 = __builtin_bit_cast(float, __builtin_amdgcn_readlane(xi, 16));
  const float s2 = __builtin_bit_cast(float, __builtin_amdgcn_readlane(xi, 32));
  const float s3 = __builtin_bit_cast(float, __builtin_amdgcn_readlane(xi, 48));
  return (s0 + s1) + (s2 + s3);
}
DEV void seq_of_token(int t, int& tb, int& T) {
  if (t < NPROMPT) { tb = t & ~2047; T = 2048; }
  else { int u = t - NPROMPT; tb = NPROMPT + (u & ~8191); T = 8192; }
}
DEV const float* xin_row(const Params& p, int row) {
  return row < NPROMPT ? p.in[0] + (size_t)row * DM : p.in[1] + (size_t)(row - NPROMPT) * DM;
}
DEV void unpack8(uint4 u, float* v) {
  v[0] = __uint_as_float(u.x << 16); v[1] = __uint_as_float(u.x & 0xffff0000u);
  v[2] = __uint_as_float(u.y << 16); v[3] = __uint_as_float(u.y & 0xffff0000u);
  v[4] = __uint_as_float(u.z << 16); v[5] = __uint_as_float(u.z & 0xffff0000u);
  v[6] = __uint_as_float(u.w << 16); v[7] = __uint_as_float(u.w & 0xffff0000u);
}

DEV void unpack8p(uint4 u, f32x2* v) {
  v[0] = (f32x2){__uint_as_float(u.x << 16), __uint_as_float(u.x & 0xffff0000u)};
  v[1] = (f32x2){__uint_as_float(u.y << 16), __uint_as_float(u.y & 0xffff0000u)};
  v[2] = (f32x2){__uint_as_float(u.z << 16), __uint_as_float(u.z & 0xffff0000u)};
  v[3] = (f32x2){__uint_as_float(u.w << 16), __uint_as_float(u.w & 0xffff0000u)};
}

constexpr int LDT = 72;

constexpr int TM = 256;
constexpr int NRT = NTOK / TM;
struct GRegs { u32x4 a0, a1, a2, a3, b0, b1; };
DEV void gemm_gload(GRegs& g, const bf16_t* A0, int lda0, const bf16_t* A1, int lda1, int ksplit,
                    const bf16_t* Bt, int ldb, int k0, int tid) {
  const bf16_t* Ab; int lda, kk;
  if (k0 < ksplit) { Ab = A0; lda = lda0; kk = k0; }
  else { Ab = A1; lda = lda1; kk = k0 - ksplit; }
  const int row = tid >> 2, kc = (tid & 3) * 8;
  const bf16_t* pa = Ab + (size_t)row * lda + kk + kc;
  const bf16_t* pb = Bt + (size_t)row * ldb + k0 + kc;
  g.a0 = *(const u32x4*)(pa);
  g.a1 = *(const u32x4*)(pa + (size_t)64 * lda);
  g.a2 = *(const u32x4*)(pa + (size_t)128 * lda);
  g.a3 = *(const u32x4*)(pa + (size_t)192 * lda);
  g.b0 = *(const u32x4*)(pb);
  g.b1 = *(const u32x4*)(pb + (size_t)64 * ldb);
}
DEV void gemm_lds_write(const GRegs& g, bf16_t* wa, bf16_t* wb) {
  *(u32x4*)(wa) = g.a0; *(u32x4*)(wa + 64 * 32) = g.a1; *(u32x4*)(wa + 128 * 32) = g.a2; *(u32x4*)(wa + 192 * 32) = g.a3;
  *(u32x4*)(wb) = g.b0; *(u32x4*)(wb + 64 * 32) = g.b1;
}

constexpr int GSA = 256 * 32;
constexpr int GST = (256 + 128) * 32;
template <bool RES, class Epi>
DEV void gemm_tile_x(const bf16_t* A0, int lda0, const bf16_t* A1, int lda1, int ksplit,
                     const bf16_t* Bt, int ldb, int K, char* smem, const float* resb, Epi epi) {
  bf16_t* sbase = (bf16_t*)smem;
  const int tid = threadIdx.x, lane = tid & 63, wv = tid >> 6;
  const int wm = wv >> 1, wn = wv & 1;
  f32x16 acc[4][2];
#pragma unroll
  for (int i = 0; i < 4; ++i)
#pragma unroll
    for (int j = 0; j < 2; ++j)
#pragma unroll
      for (int r = 0; r < 16; ++r) acc[i][j][r] = 0.f;
  GRegs g, g1;
  const int nk = K >> 5;
  const int woff = (tid >> 2) * 32 + (((tid & 3) ^ ((tid >> 4) & 3)) << 3);
  const int swz = (lane >> 2) & 3, hh = lane >> 5;
  const int raoff = (wm * 128 + (lane & 31)) * 32;
  const int rboff = GSA + (wn * 64 + (lane & 31)) * 32;
  const int ko0 = ((0 + hh) ^ swz) << 3, ko1 = ((2 + hh) ^ swz) << 3;

  __syncthreads();
  gemm_gload(g, A0, lda0, A1, lda1, ksplit, Bt, ldb, 0, tid);
  if (nk > 1) gemm_gload(g1, A0, lda0, A1, lda1, ksplit, Bt, ldb, 32, tid);
  gemm_lds_write(g, sbase + woff, sbase + GSA + woff);
  if (nk > 2) gemm_gload(g, A0, lda0, A1, lda1, ksplit, Bt, ldb, 64, tid);
  __syncthreads();
#define GEMM_COMPUTE(ST)                                                                                  \
  _Pragma("unroll") for (int ks = 0; ks < 2; ++ks) {                                                      \
    const int ko = ks ? ko1 : ko0;                                                                        \
    bf16x8 a[4], b[2];                                                                                    \
    _Pragma("unroll") for (int mi = 0; mi < 4; ++mi) a[mi] = *(const bf16x8*)((ST) + raoff + mi * 32 * 32 + ko); \
    _Pragma("unroll") for (int ni = 0; ni < 2; ++ni) b[ni] = *(const bf16x8*)((ST) + rboff + ni * 32 * 32 + ko); \
    _Pragma("unroll") for (int mi = 0; mi < 4; ++mi)                                                      \
      _Pragma("unroll") for (int ni = 0; ni < 2; ++ni)                                                    \
        acc[mi][ni] = __builtin_amdgcn_mfma_f32_32x32x16_bf16(a[mi], b[ni], acc[mi][ni], 0, 0, 0);        \
  }
  for (int kt = 0; kt < nk; kt += 2) {
    GEMM_COMPUTE(sbase);
    if (kt + 1 < nk) gemm_lds_write(g1, sbase + GST + woff, sbase + GST + GSA + woff);
    if (kt + 3 < nk) gemm_gload(g1, A0, lda0, A1, lda1, ksplit, Bt, ldb, (kt + 3) * 32, tid);
    __syncthreads();
    if (kt + 1 < nk) {
      GEMM_COMPUTE(sbase + GST);
      if (kt + 2 < nk) gemm_lds_write(g, sbase + woff, sbase + GSA + woff);
      if (kt + 4 < nk) gemm_gload(g, A0, lda0, A1, lda1, ksplit, Bt, ldb, (kt + 4) * 32, tid);
      __syncthreads();
    }
  }
#undef GEMM_COMPUTE
  const int rl = wm * 128 + 4 * (lane >> 5);
  const int col = wn * 64 + (lane & 31);
  const unsigned resoff = (unsigned)(rl * DM + col);
#pragma unroll
  for (int mi = 0; mi < 4; ++mi) {
#pragma unroll
    for (int rh = 0; rh < 2; ++rh) {
      float x0[8], x1[8];
      if (RES) {
#pragma unroll
        for (int r8 = 0; r8 < 8; ++r8) {
          const int r = rh * 8 + r8;
          const int ru = mi * 32 + (r & 3) + 8 * (r >> 2);
          const float* rp = resb + ru * DM;
          x0[r8] = rp[resoff];
          x1[r8] = rp[resoff + 32];
        }
      }
#pragma unroll
      for (int r8 = 0; r8 < 8; ++r8) {
        const int r = rh * 8 + r8;
        const int ru = mi * 32 + (r & 3) + 8 * (r >> 2);
        if (RES) epi(ru, rl, col, acc[mi][0][r], acc[mi][1][r], x0[r8], x1[r8]);
        else epi(ru, rl, col, acc[mi][0][r], acc[mi][1][r], 0.f, 0.f);
        __builtin_amdgcn_sched_barrier(0);
      }
    }
  }
}
template <class Epi>
DEV void gemm_tile(const bf16_t* A0, int lda0, const bf16_t* A1, int lda1, int ksplit,
                   const bf16_t* Bt, int ldb, int K, char* smem, Epi epi) {
  gemm_tile_x<false>(A0, lda0, A1, lda1, ksplit, Bt, ldb, K, smem, nullptr,
                     [&](int ru, int rl, int c, float v0, float v1, float, float) { epi(ru, rl, c, v0, v1); });
}

DEV void wconv(const float* src, int ld, int K, int N, int mode, int coloff, bf16_t* dst, char* smem) {
  float* tile = (float*)smem;
  const int tid = threadIdx.x;
  const int nkt = K >> 6, nnt = N >> 5, nn4 = (nnt + 3) >> 2;
  for (int tl = blockIdx.x; tl < nkt * nn4; tl += gridDim.x) {
    const int kt = tl % nkt, n4 = tl / nkt;
    __syncthreads();
    {
      const int n = tid & 31, kk = tid >> 5;
      float v[4][8];
#pragma unroll
      for (int u = 0; u < 4; ++u) {
        int nt = n4 * 4 + u;
        if (nt >= nnt) nt = nnt - 1;
        const int cb = mode ? ((nt & 1) * DFF + (nt >> 1) * 32) : (coloff + nt * 32);
#pragma unroll
        for (int i = 0; i < 8; ++i) v[u][i] = src[(size_t)(kt * 64 + kk + 8 * i) * ld + cb + n];
      }
#pragma unroll
      for (int u = 0; u < 4; ++u)
#pragma unroll
        for (int i = 0; i < 8; ++i) tile[u * (64 * 33) + (kk + 8 * i) * 33 + n] = v[u][i];
    }
    __syncthreads();
    {
      const int k2 = tid & 31, nn = tid >> 5;
#pragma unroll
      for (int u = 0; u < 4; ++u) {
        const int nt = n4 * 4 + u;
        if (nt < nnt) {
#pragma unroll
          for (int i = 0; i < 4; ++i) {
            const int n = nn + 8 * i;
            const unsigned w = pack2(tile[u * (64 * 33) + (2 * k2) * 33 + n], tile[u * (64 * 33) + (2 * k2 + 1) * 33 + n]);
            *(unsigned*)(dst + (size_t)(nt * 32 + n) * K + kt * 64 + 2 * k2) = w;
          }
        }
      }
    }
  }
  __syncthreads();
}

DEV void ln_load(const float* src, float4 (&v)[4], int lane) {
#pragma unroll
  for (int i = 0; i < 4; ++i) v[i] = *(const float4*)(src + (i * 64 + lane) * 4);
}
DEV void ln_finish(float4 (&v)[4], float* dstf, bf16_t* dstb, const float* g, const float* b, int lane) {
  float s = 0.f;
#pragma unroll
  for (int i = 0; i < 4; ++i) s += v[i].x + v[i].y + v[i].z + v[i].w;
  const float mu = wave_sum_dpp(s) * (1.f / 1024.f);
  float q = 0.f;
#pragma unroll
  for (int i = 0; i < 4; ++i) {
    v[i].x -= mu; v[i].y -= mu; v[i].z -= mu; v[i].w -= mu;
    q += v[i].x * v[i].x + v[i].y * v[i].y + v[i].z * v[i].z + v[i].w * v[i].w;
  }
  const float rs = rsqrtf(wave_sum_dpp(q) * (1.f / 1024.f) + 1e-5f);
#pragma unroll
  for (int i = 0; i < 4; ++i) {
    const int c = (i * 64 + lane) * 4;
    const float4 gg = *(const float4*)(g + c), bb = *(const float4*)(b + c);
    float4 o;
    o.x = v[i].x * rs * gg.x + bb.x; o.y = v[i].y * rs * gg.y + bb.y;
    o.z = v[i].z * rs * gg.z + bb.z; o.w = v[i].w * rs * gg.w + bb.w;
    if (dstf) *(float4*)(dstf + c) = o;
    if (dstb) { uint2 u; u.x = pack2(o.x, o.y); u.y = pack2(o.z, o.w); *(uint2*)(dstb + c) = u; }
  }
}

DEV void phase_ln(const Params& p, const float* g, const float* b, bool write_xb, bool do_mem) {
  const int lane = threadIdx.x & 63;
  const int gw = blockIdx.x * 4 + (threadIdx.x >> 6), nw = gridDim.x * 4;
  bf16_t* xb = (bf16_t*)(p.ws + O_XB);
  for (int r = gw; r < NTOK; r += 2 * nw) {
    const int r2 = r + nw;
    float4 v0[4], v1[4];
    float* row0 = p.out + (size_t)r * DM;
    float* row1 = p.out + (size_t)(r2 < NTOK ? r2 : r) * DM;
    ln_load(row0, v0, lane);
    ln_load(row1, v1, lane);
    ln_finish(v0, row0, write_xb ? xb + (size_t)r * DM : nullptr, g, b, lane);
    if (r2 < NTOK) ln_finish(v1, row1, write_xb ? xb + (size_t)r2 * DM : nullptr, g, b, lane);
  }
  if (do_mem) {
    for (int m = gw; m < 3072; m += nw) {
      const float* src = m < 2048 ? p.in[2] + (size_t)m * DM : p.in[3] + (size_t)(m - 2048) * DM;
      float4 v0[4];
      ln_load(src, v0, lane);
      ln_finish(v0, nullptr, (bf16_t*)(p.ws + O_MEMB) + (size_t)m * DM, p.in[31], p.in[32], lane);
    }
  }
}

DEV bool tile_map(int it, int nct, int& rt, int& ct) {
  const int bpx = gridDim.x >> 3, xcd = blockIdx.x & 7, j = blockIdx.x >> 3;
  const int q = j + it * bpx;
  if (q >= 24 * nct) return false;
  const int band = q / (8 * nct), qq = q - band * 8 * nct;
  rt = xcd * 24 + band * 8 + (qq & 7);
  ct = qq >> 3;
  return true;
}

DEV void phase_ffn_in(const Params& p, const bf16_t* wt, char* smem) {
  const bf16_t* xb = (const bf16_t*)(p.ws + O_XB);
  bf16_t* h = (bf16_t*)(p.ws + O_H);
  const int nct = 44;
  int rt, ct;
  for (int it = 0; tile_map(it, nct, rt, ct); ++it) {
    bf16_t* hb = h + (size_t)rt * TM * DFF + ct * 64;
    gemm_tile(xb + (size_t)rt * TM * DM, DM, nullptr, 0, DM, wt + (size_t)ct * 128 * DM, DM, DM, smem,
              [&](int ru, int rl, int c, float v0, float v1) {
                (hb + ru * DFF)[(unsigned)(rl * DFF + (c >> 6) * 32 + (c & 31))] = f2bf(silu(v0) * v1);
              });
  }
}
DEV void phase_gemm_res(const Params& p, const bf16_t* A0, int lda0, const bf16_t* A1, int lda1, int ksplit, int K,
                        const bf16_t* wt, float scale, bool res_is_input, char* smem) {
  const int nct = 8;
  int rt, ct;
  for (int it = 0; tile_map(it, nct, rt, ct); ++it) {
    const int r0 = rt * TM, c0 = ct * 128;
    const bf16_t* a1 = A1 ? A1 + (size_t)r0 * lda1 : nullptr;
    const float* resb = (res_is_input ? xin_row(p, r0) : p.out + (size_t)r0 * DM) + c0;
    float* outb = p.out + (size_t)r0 * DM + c0;
    gemm_tile_x<true>(A0 + (size_t)r0 * lda0, lda0, a1, lda1, ksplit, wt + (size_t)c0 * K, K, K, smem, resb,
              [&](int ru, int rl, int c, float v0, float v1, float x0, float x1) {
                float* op = outb + ru * DM;
                const unsigned off = (unsigned)(rl * DM + c);
                op[off] = ALPHA * x0 + scale * v0;
                op[off + 32] = ALPHA * x1 + scale * v1;
              });
  }
}
DEV void phase_gemm_bf16(const bf16_t* A, int lda, const bf16_t* wt, int K, int N, bf16_t* out, int ldo, char* smem) {
  const int nct = (N + 127) >> 7;
  int rt, ct;
  for (int it = 0; tile_map(it, nct, rt, ct); ++it) {
    const int r0 = rt * TM, c0 = ct * 128;
    gemm_tile(A + (size_t)r0 * lda, lda, nullptr, 0, K, wt + (size_t)c0 * K, K, K, smem,
              [&](int ru, int rl, int c, float v0, float v1) {
                bf16_t* o = out + (size_t)(r0 + ru) * ldo + c0;
                const unsigned off = (unsigned)(rl * ldo + c);
                const int cc = c0 + c;
                if (cc < N) o[off] = f2bf(v0);
                if (cc + 32 < N) o[off + 32] = f2bf(v1);
              });
  }
}

constexpr int GL = 72;
struct GlaSmemM {
  bf16_t VT[128 * GL];
  bf16_t R1[128 * GL];
  bf16_t QB[64 * GL];
  bf16_t P[64 * GL];
  float gd[64 * 32];
  float tot[256];
  float blast[64];
};
static_assert(sizeof(GlaSmemM) <= 65536, "GlaSmemM too big");
constexpr int OBS = 132;

DEV int mfma_row(int r, int lane) { return (r & 3) + 8 * (r >> 2) + 4 * (lane >> 5); }
DEV void mma_k64(f32x16& acc, const bf16_t* sA, const bf16_t* sB, int lane) {
  const int o = (lane & 31) * GL + (lane >> 5) * 8;
#pragma unroll
  for (int ks = 0; ks < 4; ++ks) {
    const bf16x8 a = *(const bf16x8*)(sA + o + ks * 16);
    const bf16x8 b = *(const bf16x8*)(sB + o + ks * 16);
    acc = __builtin_amdgcn_mfma_f32_32x32x16_bf16(a, b, acc, 0, 0, 0);
  }
}
DEV void gla_load_vtg(const bf16_t* proj, int t0, int h, GlaSmemM* s) {
  const int tid = threadIdx.x;
#pragma unroll
  for (int i = 0; i < 4; ++i) {
    const int id = tid + 256 * i, c = id & 63, ec = id >> 6;
    const uint4 u = *(const uint4*)(proj + (size_t)(t0 + c) * GLA_LD + 512 + h * 128 + ec * 8);
    const unsigned w[4] = {u.x, u.y, u.z, u.w};
#pragma unroll
    for (int j = 0; j < 4; ++j) {
      s->VT[(ec * 8 + 2 * j) * GL + c] = (bf16_t)(w[j] & 0xffffu);
      s->VT[(ec * 8 + 2 * j + 1) * GL + c] = (bf16_t)(w[j] >> 16);
    }
  }
  {
    const int c = tid >> 2, part = tid & 3;
    const uint4 u = *(const uint4*)(proj + (size_t)(t0 + c) * GLA_LD + 1536 + part * 8);
    float v[8];
    unpack8(u, v);
#pragma unroll
    for (int j = 0; j < 8; ++j) s->gd[c * 32 + part * 8 + j] = v[j];
  }
}
DEV void gla_gates(const Params& p, int h, int dir, const float* gd, float* tot, float (&b)[16], float& bl) {
  const int tid = threadIdx.x, d = tid & 63, cq = tid >> 6;
  const float* up = dir ? p.in[11] : p.in[9];
  const float* gb = dir ? p.in[12] : p.in[10];
  float u[16];
#pragma unroll
  for (int m = 0; m < 16; ++m) u[m] = up[m * 256 + h * 64 + d];
  const float bias = gb[h * 64 + d];
#pragma unroll
  for (int i = 0; i < 16; ++i) {
    const int c = cq * 16 + i;
    float z = bias;
#pragma unroll
    for (int m4 = 0; m4 < 4; ++m4) {
      const float4 g4 = *(const float4*)(gd + c * 32 + dir * 16 + m4 * 4);
      z += g4.x * u[m4 * 4] + g4.y * u[m4 * 4 + 1] + g4.z * u[m4 * 4 + 2] + g4.w * u[m4 * 4 + 3];
    }
    b[i] = logsig(z) * (1.f / 16.f);
  }
  float run = 0.f;
  if (dir == 0) {
#pragma unroll
    for (int i = 0; i < 16; ++i) { run += b[i]; b[i] = run; }
  } else {
#pragma unroll
    for (int i = 15; i >= 0; --i) { run += b[i]; b[i] = run; }
  }
  tot[cq * 64 + d] = run;
  __syncthreads();
  const float t0 = tot[d], t1 = tot[64 + d], t2 = tot[128 + d], t3 = tot[192 + d];
  float off;
  if (dir == 0) off = (cq > 0 ? t0 : 0.f) + (cq > 1 ? t1 : 0.f) + (cq > 2 ? t2 : 0.f);
  else off = (cq < 3 ? t3 : 0.f) + (cq < 2 ? t2 : 0.f) + (cq < 1 ? t1 : 0.f);
#pragma unroll
  for (int i = 0; i < 16; ++i) b[i] += off;
  bl = (t0 + t1) + (t2 + t3);
}

DEV void phase_gla_a(const Params& p, char* smem) {
  GlaSmemM* s = (GlaSmemM*)smem;
  const bf16_t* proj = (const bf16_t*)(p.ws + O_H);
  float* kv = (float*)(p.ws + O_KV);
  float* dec = (float*)(p.ws + O_DEC);
  const int tid = threadIdx.x, lane = tid & 63, wv = tid >> 6;
  for (int item = blockIdx.x; item < 768 * 4; item += gridDim.x) {
    const int gch = item >> 2, h = item & 3, t0 = gch * 64;
    __syncthreads();
    gla_load_vtg(proj, t0, h, s);
    float kf[16];
    {
      const int d = tid & 63, cq = tid >> 6;
#pragma unroll
      for (int i = 0; i < 16; ++i) kf[i] = bf2f(proj[(size_t)(t0 + cq * 16 + i) * GLA_LD + 256 + h * 64 + d]);
    }
    __syncthreads();
    for (int dir = 0; dir < 2; ++dir) {
      float bb[16], bl;
      gla_gates(p, h, dir, s->gd, s->tot, bb, bl);
      {
        const int d = tid & 63, cq = tid >> 6;
        unsigned w[8];
#pragma unroll
        for (int i = 0; i < 8; ++i)
          w[i] = pack2(kf[2 * i] * __expf(bl - bb[2 * i]), kf[2 * i + 1] * __expf(bl - bb[2 * i + 1]));
        bf16_t* dst = s->R1 + d * GL + cq * 16;
        *(u32x4*)(dst) = (u32x4){w[0], w[1], w[2], w[3]};
        *(u32x4*)(dst + 8) = (u32x4){w[4], w[5], w[6], w[7]};
        if (cq == 0) s->blast[d] = bl;
      }
      __syncthreads();
      f32x16 acc[2];
#pragma unroll
      for (int j = 0; j < 2; ++j)
#pragma unroll
        for (int r = 0; r < 16; ++r) acc[j][r] = 0.f;
#pragma unroll
      for (int db = 0; db < 2; ++db) mma_k64(acc[db], s->VT + wv * 32 * GL, s->R1 + db * 32 * GL, lane);
      const size_t kvi = (size_t)item * 2 + dir;
      float* ob = kv + kvi * 8192;
#pragma unroll
      for (int db = 0; db < 2; ++db)
#pragma unroll
        for (int r = 0; r < 16; ++r) {
          const int e = wv * 32 + mfma_row(r, lane), d = db * 32 + (lane & 31);
          ob[e * 64 + d] = acc[db][r];
        }
      if (tid < 64) dec[kvi * 64 + tid] = __expf(s->blast[tid]);
      __syncthreads();
    }
  }
}

DEV void phase_gla_b(const Params& p) {
  float* kv = (float*)(p.ws + O_KV);
  const float* dec = (const float*)(p.ws + O_DEC);
  const int tid = threadIdx.x;
  for (int unit = blockIdx.x; unit < 96 * 32; unit += gridDim.x) {
    const int sid = unit >> 5, part = unit & 31;
    const int sq = sid >> 3, h = (sid >> 1) & 3, dir = sid & 1;
    int c0, nch;
    if (sq < 4) { c0 = 256 + sq * 128; nch = 128; }
    else { c0 = (sq - 4) * 32; nch = 32; }
    const int e = part * 256 + tid;
    float S = 0.f;
    for (int n0 = 0; n0 < nch; n0 += 8) {
      float tmp[8], dc[8];
#pragma unroll
      for (int u = 0; u < 8; ++u) {
        const int n = n0 + u;
        const int ci = dir ? (c0 + nch - 1 - n) : (c0 + n);
        const size_t idx = ((size_t)ci * 4 + h) * 2 + dir;
        tmp[u] = kv[idx * 8192 + e];
        dc[u] = dec[idx * 64 + (e & 63)];
      }
#pragma unroll
      for (int u = 0; u < 8; ++u) {
        const int n = n0 + u;
        const int ci = dir ? (c0 + nch - 1 - n) : (c0 + n);
        const size_t idx = ((size_t)ci * 4 + h) * 2 + dir;
        kv[idx * 8192 + e] = S;
        S = dc[u] * S + tmp[u];
      }
    }
  }
}

DEV void phase_gla_c(const Params& p, char* smem) {
  GlaSmemM* s = (GlaSmemM*)smem;
  const bf16_t* proj = (const bf16_t*)(p.ws + O_H);
  const float* kv = (const float*)(p.ws + O_KV);
  bf16_t* mixed = (bf16_t*)(p.ws + O_MIXG);
  const int tid = threadIdx.x, lane = tid & 63, wv = tid >> 6;
  const int cg_ = tid >> 4, eg = tid & 15;
  float* Ob = (float*)s->R1;
  static_assert(64 * OBS * 4 <= (128 + 64 + 64) * GL * 2, "output staging does not fit");
  for (int item = blockIdx.x; item < 768 * 4; item += gridDim.x) {
    const int gch = item >> 2, h = item & 3, t0 = gch * 64;
    __syncthreads();
    gla_load_vtg(proj, t0, h, s);
    float qf[16], kf[16];
    {
      const int d = tid & 63, cq = tid >> 6;
#pragma unroll
      for (int i = 0; i < 16; ++i) {
        const bf16_t* row = proj + (size_t)(t0 + cq * 16 + i) * GLA_LD + h * 64 + d;
        qf[i] = bf2f(row[0]) * 0.125f;
        kf[i] = bf2f(row[256]);
      }
    }
    __syncthreads();
    const int cb = wv & 1, eb0 = (wv >> 1) * 2;
    f32x16 acc[2];
#pragma unroll
    for (int j = 0; j < 2; ++j)
#pragma unroll
      for (int r = 0; r < 16; ++r) acc[j][r] = 0.f;
    for (int dir = 0; dir < 2; ++dir) {
      {
        float bb[16], bl;
        gla_gates(p, h, dir, s->gd, s->tot, bb, bl);
        const int d = tid & 63, cq = tid >> 6;
        const float bref = 0.5f * bl;
#pragma unroll
        for (int i = 0; i < 16; ++i) {
          const int c = cq * 16 + i;
          const float b = bb[i];
          const float q = qf[i];
          const float k = kf[i];
          s->R1[c * GL + d] = f2bf(q * __expf(b - bref));
          s->R1[(64 + c) * GL + d] = f2bf(k * __expf(bref - b));
          s->QB[c * GL + d] = f2bf(q * __expf(b));
        }
      }
      __syncthreads();
      {
        const int sb = wv >> 1, cbs = wv & 1;
        f32x16 sc;
#pragma unroll
        for (int r = 0; r < 16; ++r) sc[r] = 0.f;
        mma_k64(sc, s->R1 + (64 + sb * 32) * GL, s->R1 + cbs * 32 * GL, lane);
        const int c = cbs * 32 + (lane & 31);
#pragma unroll
        for (int g = 0; g < 4; ++g) {
          float v[4];
#pragma unroll
          for (int i = 0; i < 4; ++i) {
            const int sr = sb * 32 + 8 * g + 4 * (lane >> 5) + i;
            const bool keep = dir ? (sr >= c) : (sr <= c);
            v[i] = keep ? sc[4 * g + i] : 0.f;
          }
          uint2 w;
          w.x = pack2(v[0], v[1]);
          w.y = pack2(v[2], v[3]);
          *(uint2*)(s->P + c * GL + sb * 32 + 8 * g + 4 * (lane >> 5)) = w;
        }
      }
      const float* Sp = kv + ((size_t)item * 2 + dir) * 8192 + tid * 4;
      f32x4v sv[8];
#pragma unroll
      for (int i = 0; i < 8; ++i) sv[i] = *(const f32x4v*)(Sp + i * 1024);
      __syncthreads();
#pragma unroll
      for (int i = 0; i < 8; ++i) {
        const int el = (tid + 256 * i) * 4, e = el >> 6, d = el & 63;
        uint2 w;
        w.x = pack2(sv[i].x, sv[i].y);
        w.y = pack2(sv[i].z, sv[i].w);
        *(uint2*)(s->R1 + e * GL + d) = w;
      }
#pragma unroll
      for (int j = 0; j < 2; ++j) mma_k64(acc[j], s->P + cb * 32 * GL, s->VT + (eb0 + j) * 32 * GL, lane);
      __syncthreads();
#pragma unroll
      for (int j = 0; j < 2; ++j) mma_k64(acc[j], s->QB + cb * 32 * GL, s->R1 + (eb0 + j) * 32 * GL, lane);
      __syncthreads();
    }
#pragma unroll
    for (int j = 0; j < 2; ++j)
#pragma unroll
      for (int r = 0; r < 16; ++r) {
        const int c = cb * 32 + mfma_row(r, lane), e = (eb0 + j) * 32 + (lane & 31);
        Ob[c * OBS + e] = acc[j][r];
      }
    __syncthreads();
    float ng[8];
#pragma unroll
    for (int j = 0; j < 8; ++j) ng[j] = p.in[13][h * 128 + eg * 8 + j];
#pragma unroll
    for (int i = 0; i < 4; ++i) {
      const int cr = cg_ * 4 + i;
      const float4 o0 = *(const float4*)(Ob + cr * OBS + eg * 8), o1 = *(const float4*)(Ob + cr * OBS + eg * 8 + 4);
      const float o[8] = {o0.x, o0.y, o0.z, o0.w, o1.x, o1.y, o1.z, o1.w};
      float ss = 0.f;
#pragma unroll
      for (int j = 0; j < 8; ++j) ss += o[j] * o[j];
      ss = row16_sum(ss);
      const float rs = rsqrtf(ss * (1.f / 128.f) + 1e-5f);
      const int t = t0 + cr;
      float g[8];
      unpack8(*(const uint4*)(proj + (size_t)t * GLA_LD + 1024 + h * 128 + eg * 8), g);
      uint4 u;
      u.x = pack2(o[0] * rs * ng[0] * silu(g[0]), o[1] * rs * ng[1] * silu(g[1]));
      u.y = pack2(o[2] * rs * ng[2] * silu(g[2]), o[3] * rs * ng[3] * silu(g[3]));
      u.z = pack2(o[4] * rs * ng[4] * silu(g[4]), o[5] * rs * ng[5] * silu(g[5]));
      u.w = pack2(o[6] * rs * ng[6] * silu(g[6]), o[7] * rs * ng[7] * silu(g[7]));
      *(uint4*)(mixed + (size_t)t * 512 + h * 128 + eg * 8) = u;
    }
  }
}

DEV void phase_rw_act(const Params& p) {
  const bf16_t* proj = (const bf16_t*)(p.ws + O_H);
  bf16_t* awda = (bf16_t*)(p.ws + O_XB);
  bf16_t* ag = (bf16_t*)(p.ws + O_ACTG);
  const int total = NTOK * 160;
  const int stride = gridDim.x * 256;
  for (int base = blockIdx.x * 256 + threadIdx.x; base < total; base += 8 * stride) {
    unsigned x[8], pv[8], nx[8];
#pragma unroll
    for (int u = 0; u < 8; ++u) {
      int idx = base + u * stride;
      if (idx >= total) idx = base;
      const int t = idx / 160, cp = idx - t * 160;
      int tb, T;
      seq_of_token(t, tb, T);
      const bf16_t* ptr = proj + (size_t)t * RW_LD + 1536 + cp * 2;
      x[u] = *(const unsigned*)ptr;
      pv[u] = *(const unsigned*)(ptr + (t > tb ? -RW_LD : 0));
      nx[u] = *(const unsigned*)(ptr + (t < tb + T - 1 ? RW_LD : 0));
    }
#pragma unroll
    for (int u = 0; u < 8; ++u) {
      const int idx = base + u * stride;
      if (idx < total) {
        const int t = idx / 160, cp = idx - t * 160;
        int tb, T;
        seq_of_token(t, tb, T);
        const bool hp = t > tb, hn = t < tb + T - 1;
        const int rc = 1536 + cp * 2;
        float v[2];
#pragma unroll
        for (int e = 0; e < 2; ++e) {
          const float xx = e ? __uint_as_float(x[u] & 0xffff0000u) : __uint_as_float(x[u] << 16);
          const float pp = hp ? (e ? __uint_as_float(pv[u] & 0xffff0000u) : __uint_as_float(pv[u] << 16)) : 0.f;
          const float nn = hn ? (e ? __uint_as_float(nx[u] & 0xffff0000u) : __uint_as_float(nx[u] << 16)) : 0.f;
          v[e] = xx + p.in[14][rc + e] * (pp - xx) + p.in[15][rc + e] * (nn - xx);
        }
        const int col = cp * 2;
        if (col < 128) *(unsigned*)(awda + (size_t)t * 192 + col) = pack2(tanh_fast(v[0]), tanh_fast(v[1]));
        else if (col < 192) *(unsigned*)(awda + (size_t)t * 192 + col) = pack2(v[0], v[1]);
        else *(unsigned*)(ag + (size_t)t * 128 + (col - 192)) = pack2(sigm(v[0]), sigm(v[1]));
      }
    }
  }
}

DEV void phase_rw_lowrank(const Params& p, char* smem) {
  const bf16_t* awda = (const bf16_t*)(p.ws + O_XB);
  bf16_t* der = (bf16_t*)(p.ws + O_DER);
  int rt, ct12;
  for (int it = 0; tile_map(it, 12, rt, ct12); ++it) {
    const int which = ct12 >> 2, ct = ct12 & 3;
    const int r0 = rt * TM, c0 = ct * 128;
    const bf16_t* wt = (const bf16_t*)(p.ws + (which == 0 ? W_A_UPF : which == 1 ? W_A_UPB : W_A_AUP));
    const float* bias = which == 0 ? p.in[16] : which == 1 ? p.in[18] : p.in[20];
    bf16_t* out = der + (size_t)which * SLAB;
    gemm_tile(awda + (size_t)r0 * 192 + which * 64, 192, nullptr, 0, 64, wt + (size_t)c0 * 64, 64, 64, smem,
              [&](int ru, int rl, int c, float v0, float v1) {
                bf16_t* o = out + (size_t)(r0 + ru) * 512 + c0;
                const unsigned off = (unsigned)(rl * 512 + c);
                const float z0 = bias[c0 + c] + v0, z1 = bias[c0 + c + 32] + v1;
                if (which < 2) { o[off] = f2bf(-0.6065306597f * sigm(z0)); o[off + 32] = f2bf(-0.6065306597f * sigm(z1)); }
                else { o[off] = f2bf(sigm(z0)); o[off + 32] = f2bf(sigm(z1)); }
              });
  }
}

constexpr int SST = 388;
template <int RPL>
struct StepV { f32x4v w, nk, ka, k, r; float v[RPL]; float kar; };
template <int RPL>
DEV void step_load(StepV<RPL>& x, const float* sb, int jl, int rowbase) {
  x.w = *(const f32x4v*)(sb + jl * 4);
  x.nk = *(const f32x4v*)(sb + 64 + jl * 4);
  x.ka = *(const f32x4v*)(sb + 128 + jl * 4);
  x.k = *(const f32x4v*)(sb + 192 + jl * 4);
  x.r = *(const f32x4v*)(sb + 256 + jl * 4);
#pragma unroll
  for (int r = 0; r < RPL; ++r) x.v[r] = sb[320 + rowbase + r];
  x.kar = sb[384];
}

template <int RPL>
DEV void rwkv_scan(const Params& p, int tb, int T, int head, int dir, int split, float* st) {
  const int tid = threadIdx.x, lane = tid & 63, wv = tid >> 6;
  const int jl = lane & 15, ig = lane >> 4;
  const int hc = head * 64 + lane;
  float* ybuf = st + 2 * 16 * SST;
  const bf16_t* proj = (const bf16_t*)(p.ws + O_H);
  const bf16_t* ldp = (const bf16_t*)(p.ws + O_DER) + (size_t)dir * SLAB;
  const bf16_t* ap = (const bf16_t*)(p.ws + O_DER) + 2 * SLAB;
  bf16_t* yout = (bf16_t*)(p.ws + O_XB) + (size_t)dir * SLAB;
  const float* scal = (const float*)(p.ws + O_BONUS);
  const float mpr = p.in[14][hc], mnr = p.in[15][hc];
  const float mpk = p.in[14][512 + hc], mnk = p.in[15][512 + hc];
  const float mpv = p.in[14][1024 + hc], mnv = p.in[15][1024 + hc];
  const float kkw = p.in[23][hc], kaw = p.in[24][hc];
  const int rowl = wv * 4 * RPL + ig * RPL;
  const int rowbase = split * 16 * RPL + rowl;
  const int nch = T >> 4;
  const int ywoff = (jl == 0) ? rowl : (2 * 16 * 16 * RPL + rowl);
  f32x2 S01[RPL], S23[RPL];
#pragma unroll
  for (int r = 0; r < RPL; ++r) { S01[r] = (f32x2){0.f, 0.f}; S23[r] = (f32x2){0.f, 0.f}; }
  bf16_t rawA[4][11];
  float2 scA[4];

#define RW_LOAD(RAW, SC, CH)                                                            \
  _Pragma("unroll") for (int q = 0; q < 4; ++q) {                                       \
    const int tt_ = (CH) * 16 + wv * 4 + q;                                             \
    const int t_ = dir ? (T - 1 - tt_) : tt_;                                           \
    const bf16_t* row_ = proj + (size_t)(tb + t_) * RW_LD + hc;                         \
    const int op_ = t_ > 0 ? -RW_LD : 0, on_ = t_ < T - 1 ? RW_LD : 0;                  \
    _Pragma("unroll") for (int w = 0; w < 3; ++w) {                                     \
      RAW[q][w * 3 + 0] = row_[w * 512];                                                \
      RAW[q][w * 3 + 1] = row_[w * 512 + op_];                                          \
      RAW[q][w * 3 + 2] = row_[w * 512 + on_];                                          \
    }                                                                                   \
    RAW[q][9] = ldp[(size_t)(tb + t_) * 512 + hc];                                      \
    RAW[q][10] = ap[(size_t)(tb + t_) * 512 + hc];                                      \
    SC[q] = *(const float2*)(scal + ((size_t)(tb + t_) * 8 + head) * 4);                \
  }
#define RW_STAGE(RAW, SC, CH, BUF)                                                      \
  _Pragma("unroll") for (int q = 0; q < 4; ++q) {                                       \
    const int s_ = wv * 4 + q;                                                          \
    const int tt_ = (CH) * 16 + s_;                                                     \
    const int t_ = dir ? (T - 1 - tt_) : tt_;                                           \
    const bool hp_ = t_ > 0, hn_ = t_ < T - 1;                                          \
    float x_ = bf2f(RAW[q][0]);                                                         \
    const float r_ = x_ + mpr * ((hp_ ? bf2f(RAW[q][1]) : 0.f) - x_) + mnr * ((hn_ ? bf2f(RAW[q][2]) : 0.f) - x_);  \
    x_ = bf2f(RAW[q][3]);                                                               \
    const float kr_ = x_ + mpk * ((hp_ ? bf2f(RAW[q][4]) : 0.f) - x_) + mnk * ((hn_ ? bf2f(RAW[q][5]) : 0.f) - x_); \
    x_ = bf2f(RAW[q][6]);                                                               \
    const float v_ = x_ + mpv * ((hp_ ? bf2f(RAW[q][7]) : 0.f) - x_) + mnv * ((hn_ ? bf2f(RAW[q][8]) : 0.f) - x_);  \
    const float a_ = bf2f(RAW[q][10]);                                                  \
    const float kk_ = kr_ * kkw * SC[q].x;                                              \
    const float k2_ = kr_ * (1.f + (a_ - 1.f) * kaw);                                   \
    float* sb_ = st + (BUF) * (16 * SST) + s_ * SST;                                    \
    sb_[lane] = __expf(bf2f(RAW[q][9]));                                                \
    sb_[64 + lane] = -kk_;                                                              \
    sb_[128 + lane] = kk_ * a_;                                                         \
    sb_[192 + lane] = k2_;                                                              \
    sb_[256 + lane] = r_;                                                               \
    sb_[320 + lane] = v_;                                                               \
    if (lane == 0) sb_[384] = SC[q].y;                                                  \
  }
#define RW_MAIN(CH)                                                                     \
  {                                                                                     \
    const int buf = (CH) & 1;                                                           \
    const float* sbase = st + buf * (16 * SST);                                         \
    float* yb = ybuf + buf * (16 * 16 * RPL);                                           \
    StepV<RPL> cur, nxt;                                                                \
    step_load<RPL>(cur, sbase, jl, rowbase);                                            \
    _Pragma("unroll 4") for (int s = 0; s < 16; ++s) {                                  \
      step_load<RPL>(nxt, sbase + ((s + 1) & 15) * SST, jl, rowbase);                   \
      const f32x2 w01 = {cur.w.x, cur.w.y}, w23 = {cur.w.z, cur.w.w};                   \
      const f32x2 n01 = {cur.nk.x, cur.nk.y}, n23 = {cur.nk.z, cur.nk.w};               \
      const f32x2 a01 = {cur.ka.x, cur.ka.y}, a23 = {cur.ka.z, cur.ka.w};               \
      const f32x2 k01 = {cur.k.x, cur.k.y}, k23 = {cur.k.z, cur.k.w};                   \
      const f32x2 r01 = {cur.r.x, cur.r.y}, r23 = {cur.r.z, cur.r.w};                   \
      _Pragma("unroll") for (int r = 0; r < RPL; ++r) {                                 \
        f32x2 pz2 = S01[r] * n01;                                                       \
        pz2 = S23[r] * n23 + pz2;                                                       \
        float sa = pz2.x + pz2.y;                                                       \
        const f32x2 vv = {cur.v[r], cur.v[r]};                                          \
        f32x2 b01 = S01[r] * w01;                                                       \
        f32x2 b23 = S23[r] * w23;                                                       \
        b01 = vv * k01 + b01;                                                           \
        b23 = vv * k23 + b23;                                                           \
        f32x2 y2 = b01 * r01;                                                           \
        y2 = b23 * r23 + y2;                                                            \
        float yb_ = y2.x + y2.y;                                                        \
        row16_sum2(sa, yb_);                                                            \
        const f32x2 sa2 = {sa, sa};                                                     \
        S01[r] = sa2 * a01 + b01;                                                       \
        S23[r] = sa2 * a23 + b23;                                                       \
        const float y = yb_ + sa * cur.kar;                                             \
        yb[s * (16 * RPL) + ywoff + r] = y;                                             \
      }                                                                                 \
      cur = nxt;                                                                        \
    }                                                                                   \
  }
#define RW_FLUSH(CH)                                                                    \
  {                                                                                     \
    const float* yb = ybuf + ((CH) & 1) * (16 * 16 * RPL);                              \
    const int s = tid >> 4, rl = (tid & 15) * RPL;                                      \
    const int tt = (CH) * 16 + s;                                                       \
    const int t = dir ? (T - 1 - tt) : tt;                                              \
    bf16_t* yo = yout + (size_t)(tb + t) * 512 + head * 64 + split * 16 * RPL + rl;     \
    if (RPL == 1) yo[0] = f2bf(yb[s * 16 + rl]);                                        \
    else if (RPL == 2) *(unsigned*)yo = pack2(yb[s * 32 + rl], yb[s * 32 + rl + 1]);    \
    else { uint2 u; u.x = pack2(yb[s * 64 + rl], yb[s * 64 + rl + 1]); u.y = pack2(yb[s * 64 + rl + 2], yb[s * 64 + rl + 3]); *(uint2*)yo = u; } \
  }

  RW_LOAD(rawA, scA, 0);
  RW_STAGE(rawA, scA, 0, 0);
  __syncthreads();
  for (int ch = 0; ch < nch; ++ch) {
    if (ch + 1 < nch) { RW_LOAD(rawA, scA, ch + 1); }
    RW_MAIN(ch);
    if (ch + 1 < nch) { RW_STAGE(rawA, scA, ch + 1, (ch + 1) & 1); }
    __syncthreads();
    RW_FLUSH(ch);
  }
#undef RW_MAIN
#undef RW_FLUSH
#undef RW_LOAD
#undef RW_STAGE
}

DEV void phase_rw_pre(const Params& p) {
  const bf16_t* proj = (const bf16_t*)(p.ws + O_H);
  const bf16_t* ap = (const bf16_t*)(p.ws + O_DER) + 2 * SLAB;
  float* scal = (float*)(p.ws + O_BONUS);
  const int lane = threadIdx.x & 63;
  const int gw = blockIdx.x * 4 + (threadIdx.x >> 6), nw = gridDim.x * 4;
  for (int t = gw; t < NTOK; t += nw) {
    int tb, T;
    seq_of_token(t, tb, T);
    const bool hp = t > tb, hn = t < tb + T - 1;
    const int op = hp ? -RW_LD : 0, on = hn ? RW_LD : 0;
    const bf16_t* row = proj + (size_t)t * RW_LD + lane;
    bf16_t raw[8][7];
#pragma unroll
    for (int h = 0; h < 8; ++h) {
      raw[h][0] = row[h * 64];
      raw[h][1] = row[h * 64 + op];
      raw[h][2] = row[h * 64 + on];
      raw[h][3] = row[512 + h * 64];
      raw[h][4] = row[512 + h * 64 + op];
      raw[h][5] = row[512 + h * 64 + on];
      raw[h][6] = ap[(size_t)t * 512 + h * 64 + lane];
    }
#pragma unroll
    for (int h = 0; h < 8; ++h) {
      const int hc = h * 64 + lane;
      float x = bf2f(raw[h][0]);
      const float r = x + p.in[14][hc] * ((hp ? bf2f(raw[h][1]) : 0.f) - x) + p.in[15][hc] * ((hn ? bf2f(raw[h][2]) : 0.f) - x);
      x = bf2f(raw[h][3]);
      const float kr = x + p.in[14][512 + hc] * ((hp ? bf2f(raw[h][4]) : 0.f) - x) + p.in[15][512 + hc] * ((hn ? bf2f(raw[h][5]) : 0.f) - x);
      const float a = bf2f(raw[h][6]);
      const float kkr = kr * p.in[23][hc];
      const float inv = rsqrtf(fmaxf(wave_sum_dpp(kkr * kkr), 1e-24f));
      const float kk = kkr * inv;
      const float k2 = kr * (1.f + (a - 1.f) * p.in[24][hc]);
      const float kar = wave_sum_dpp(kk * a * r);
      const float bo = wave_sum_dpp(r * k2 * p.in[25][hc]);
      if (lane == 0) *(float4*)(scal + ((size_t)t * 8 + h) * 4) = make_float4(inv, kar, bo, 0.f);
    }
  }
}

DEV void phase_rw_scan(const Params& p, char* smem) {
  float* st = (float*)smem;
  for (int item = blockIdx.x; item < 512; item += gridDim.x) {
    __syncthreads();
    if (item < 256) {
      const int scan = item >> 2, split = item & 3;
      const int sq = scan >> 4, head = (scan >> 1) & 7, dir = scan & 1;
      __builtin_amdgcn_s_setprio(3);
      rwkv_scan<1>(p, NPROMPT + sq * 8192, 8192, head, dir, split, st);
      __builtin_amdgcn_s_setprio(0);
    } else {
      const int it = item - 256;
      const int scan = it >> 1, split = it & 1;
      const int sq = scan >> 4, head = (scan >> 1) & 7, dir = scan & 1;
      rwkv_scan<2>(p, sq * 2048, 2048, head, dir, split, st);
    }
  }
}

DEV void phase_rw_post(const Params& p) {
  const bf16_t* proj = (const bf16_t*)(p.ws + O_H);
  bf16_t* yf = (bf16_t*)(p.ws + O_XB);
  const bf16_t* yb = yf + SLAB;
  const bf16_t* gate = (const bf16_t*)(p.ws + O_DER) + 2 * SLAB;
  const float* scal = (const float*)(p.ws + O_BONUS);
  const int lane = threadIdx.x & 63;
  const int gw = blockIdx.x * 4 + (threadIdx.x >> 6), nw = gridDim.x * 4;
  for (int t = gw; t < NTOK; t += nw) {
    int tb, T;
    seq_of_token(t, tb, T);
    const bool hp = t > tb, hn = t < tb + T - 1;
    const int op = hp ? -RW_LD : 0, on = hn ? RW_LD : 0;
    const bf16_t* vrow = proj + (size_t)t * RW_LD + 1024 + lane;
    bf16_t raw[8][6];
    float bo[8];
#pragma unroll
    for (int h = 0; h < 8; ++h) {
      const size_t o = (size_t)t * 512 + h * 64 + lane;
      raw[h][0] = yf[o];
      raw[h][1] = yb[o];
      raw[h][2] = vrow[h * 64];
      raw[h][3] = vrow[h * 64 + op];
      raw[h][4] = vrow[h * 64 + on];
      raw[h][5] = gate[o];
      bo[h] = scal[((size_t)t * 8 + h) * 4 + 2];
    }
    bf16_t res[8];
#pragma unroll
    for (int h = 0; h < 8; ++h) {
      const int hc = h * 64 + lane;
      const float y = bf2f(raw[h][0]) + bf2f(raw[h][1]);
      const float mu = wave_sum_dpp(y) * (1.f / 64.f);
      const float dy = y - mu;
      const float var = wave_sum_dpp(dy * dy) * (1.f / 64.f);
      const float yn = dy * rsqrtf(var + 64e-5f) * p.in[26][hc] + p.in[27][hc];
      const float x = bf2f(raw[h][2]);
      const float v = x + p.in[14][1024 + hc] * ((hp ? bf2f(raw[h][3]) : 0.f) - x) + p.in[15][1024 + hc] * ((hn ? bf2f(raw[h][4]) : 0.f) - x);
      res[h] = f2bf((yn + bo[h] * v) * bf2f(raw[h][5]));
    }
#pragma unroll
    for (int h = 0; h < 8; ++h) yf[(size_t)t * 512 + h * 64 + lane] = res[h];
  }
}

DEV int seq_of_rowtile(int rt) { return rt < 64 ? (rt >> 3) : 8 + ((rt - 64) >> 5); }

DEV void phase_ca_qkv(const Params& p, char* smem) {
  const bf16_t* xb = (const bf16_t*)(p.ws + O_XB);
  bf16_t* qb = (bf16_t*)(p.ws + O_H);
  const bf16_t* memb = (const bf16_t*)(p.ws + O_MEMB);
  bf16_t* kb = (bf16_t*)(p.ws + O_KB);
  bf16_t* vt = (bf16_t*)(p.ws + O_VT);
  const bf16_t* wq = (const bf16_t*)(p.ws + W_B_Q);
  const bf16_t* wkv = (const bf16_t*)(p.ws + W_B_KV);
  {
    int rt, ct;
    for (int it = 0; tile_map(it, 8, rt, ct); ++it) {
      const int r0 = rt * TM, c0 = ct * 128;
      gemm_tile(xb + (size_t)r0 * DM, DM, nullptr, 0, DM, wq + (size_t)c0 * DM, DM, DM, smem,
                [&](int ru, int rl, int c, float v0, float v1) {
                  bf16_t* o = qb + (size_t)(r0 + ru) * DM + c0;
                  const unsigned off = (unsigned)(rl * DM + c);
                  o[off] = f2bf(v0); o[off + 32] = f2bf(v1);
                });
    }
  }
  {
    for (int t2 = blockIdx.x; t2 < 12 * 16; t2 += gridDim.x) {
      const int rt = t2 >> 4, ct = t2 & 15;
      const int r0 = rt * TM, c0 = ct * 128;
      if (ct < 8) {
        bf16_t* o = kb + (size_t)r0 * DM + c0;
        gemm_tile(memb + (size_t)r0 * DM, DM, nullptr, 0, DM, wkv + (size_t)c0 * DM, DM, DM, smem,
                  [&](int ru, int rl, int c, float v0, float v1) {
                    const unsigned off = (unsigned)(rl * DM + c);
                    (o + ru * DM)[off] = f2bf(v0);
                    (o + ru * DM)[off + 32] = f2bf(v1);
                  });
      } else {
        bf16_t* o = vt + ((size_t)rt * 1024 + (c0 - 1024)) * 256;
        gemm_tile(memb + (size_t)r0 * DM, DM, nullptr, 0, DM, wkv + (size_t)c0 * DM, DM, DM, smem,
                  [&](int ru, int rl, int c, float v0, float v1) {
                    const unsigned off = (unsigned)(c * 256 + rl);
                    (o + ru)[off] = f2bf(v0);
                    (o + ru)[off + 32 * 256] = f2bf(v1);
                  });
      }
    }
  }
}
DEV void phase_ca_scores(const Params& p, char* smem) {
  const bf16_t* qb = (const bf16_t*)(p.ws + O_H);
  const bf16_t* kb = (const bf16_t*)(p.ws + O_KB);
  float* sc = (float*)(p.ws + O_SCORES);
  int rt, ct8;
  for (int it = 0; tile_map(it, 8, rt, ct8); ++it) {
    const int h = ct8 >> 1, nt = ct8 & 1;
    const int b = seq_of_rowtile(rt), r0 = rt * TM;
    gemm_tile(qb + (size_t)r0 * DM + h * 256, DM, nullptr, 0, 256,
              kb + (size_t)(b * 256 + nt * 128) * DM + h * 256, DM, 256, smem,
              [&](int ru, int rl, int c, float v0, float v1) {
                float* o = sc + (size_t)(r0 + ru) * DM + h * 256 + nt * 128;
                const unsigned off = (unsigned)(rl * DM + c);
                o[off] = v0 * 0.0625f; o[off + 32] = v1 * 0.0625f;
              });
  }
}
DEV void phase_ca_softmax(const Params& p) {
  const float* sc = (const float*)(p.ws + O_SCORES);
  bf16_t* pb = (bf16_t*)(p.ws + O_H);
  const int lane = threadIdx.x & 63;
  const int gw = blockIdx.x * 4 + (threadIdx.x >> 6), nw = gridDim.x * 4;
  const int total = NTOK * 4;
  for (int it = gw; it < total; it += 4 * nw) {
    float4 v[4];
#pragma unroll
    for (int u = 0; u < 4; ++u) {
      const int i2 = it + u * nw;
      v[u] = *(const float4*)(sc + (size_t)(i2 < total ? i2 : it) * 256 + lane * 4);
    }
#pragma unroll
    for (int u = 0; u < 4; ++u) {
      const int i2 = it + u * nw;
      float mx = fmaxf(fmaxf(v[u].x, v[u].y), fmaxf(v[u].z, v[u].w));
      mx = fmaxf(mx, dppf<0x128>(mx)); mx = fmaxf(mx, dppf<0x124>(mx)); mx = fmaxf(mx, dppf<0x122>(mx)); mx = fmaxf(mx, dppf<0x121>(mx));
      {
        const int xi = __builtin_bit_cast(int, mx);
        const float m0 = __builtin_bit_cast(float, __builtin_amdgcn_readlane(xi, 0));
        const float m1 = __builtin_bit_cast(float, __builtin_amdgcn_readlane(xi, 16));
        const float m2 = __builtin_bit_cast(float, __builtin_amdgcn_readlane(xi, 32));
        const float m3 = __builtin_bit_cast(float, __builtin_amdgcn_readlane(xi, 48));
        mx = fmaxf(fmaxf(m0, m1), fmaxf(m2, m3));
      }
      const float e0 = __expf(v[u].x - mx), e1 = __expf(v[u].y - mx), e2 = __expf(v[u].z - mx), e3 = __expf(v[u].w - mx);
      const float inv = 1.f / wave_sum_dpp(e0 + e1 + e2 + e3);
      if (i2 < total) {
        uint2 w;
        w.x = pack2(e0 * inv, e1 * inv);
        w.y = pack2(e2 * inv, e3 * inv);
        *(uint2*)(pb + (size_t)i2 * 256 + lane * 4) = w;
      }
    }
  }
}
DEV void phase_ca_pv(const Params& p, char* smem) {
  const bf16_t* pb = (const bf16_t*)(p.ws + O_H);
  const bf16_t* vt = (const bf16_t*)(p.ws + O_VT);
  bf16_t* attn = (bf16_t*)(p.ws + O_XB);
  int rt, ct8;
  for (int it = 0; tile_map(it, 8, rt, ct8); ++it) {
    const int h = ct8 >> 1, nt = ct8 & 1;
    const int b = seq_of_rowtile(rt), r0 = rt * TM;
    gemm_tile(pb + (size_t)r0 * DM + h * 256, DM, nullptr, 0, 256,
              vt + ((size_t)b * 1024 + h * 256 + nt * 128) * 256, 256, 256, smem,
              [&](int ru, int rl, int c, float v0, float v1) {
                bf16_t* o = attn + (size_t)(r0 + ru) * DM + h * 256 + nt * 128;
                const unsigned off = (unsigned)(rl * DM + c);
                o[off] = f2bf(v0); o[off + 32] = f2bf(v1);
              });
  }
}

DEV void phase_convert_x(const Params& p) {
  bf16_t* xb = (bf16_t*)(p.ws + O_XB);
  const size_t n4 = (size_t)NTOK * DM / 4;
  const size_t np4 = (size_t)NPROMPT * DM / 4;
  const size_t stride = (size_t)gridDim.x * 256;
  for (size_t i = (size_t)blockIdx.x * 256 + threadIdx.x; i < n4; i += 8 * stride) {
    float4 v[8];
#pragma unroll
    for (int u = 0; u < 8; ++u) {
      size_t j = i + u * stride;
      if (j >= n4) j = i;
      v[u] = j < np4 ? ((const float4*)p.in[0])[j] : ((const float4*)p.in[1])[j - np4];
    }
#pragma unroll
    for (int u = 0; u < 8; ++u) {
      const size_t j = i + u * stride;
      if (j < n4) {
        uint2 w;
        w.x = pack2(v[u].x, v[u].y);
        w.y = pack2(v[u].z, v[u].w);
        ((uint2*)xb)[j] = w;
      }
    }
  }
}

constexpr int NPHASE = 25;
constexpr int SMEM_BYTES = 64 * 1024;

DEV void run_phase(const Params& p, int ph, char* smem) {
  char* ws = p.ws;
    switch (ph) {
      case 0:
        wconv(p.in[4], 2 * DFF, DM, 2 * DFF, 1, 0, (bf16_t*)(ws + W_A_FFN_IN), smem);
        wconv(p.in[5], DM, DFF, DM, 0, 0, (bf16_t*)(ws + W_A_FFN_OUT), smem);
        wconv(p.in[8], 3424, DM, 1568, 0, 0, (bf16_t*)(ws + W_A_MIX_IN), smem);
        wconv(p.in[8], 3424, DM, 1856, 0, 1568, (bf16_t*)(ws + W_A_MIX_IN) + (size_t)1664 * DM, smem);
        wconv(p.in[17], 512, 64, 512, 0, 0, (bf16_t*)(ws + W_A_UPF), smem);
        wconv(p.in[19], 512, 64, 512, 0, 0, (bf16_t*)(ws + W_A_UPB), smem);
        wconv(p.in[21], 512, 64, 512, 0, 0, (bf16_t*)(ws + W_A_AUP), smem);
        wconv(p.in[22], 512, 128, 512, 0, 0, (bf16_t*)(ws + W_A_GUP), smem);
        phase_convert_x(p);
        break;
      case 1: phase_ffn_in(p, (const bf16_t*)(ws + W_A_FFN_IN), smem); break;
      case 2: phase_gemm_res(p, (const bf16_t*)(ws + O_H), DFF, nullptr, 0, DFF, DFF, (const bf16_t*)(ws + W_A_FFN_OUT), 0.5f, true, smem); break;
      case 3: phase_ln(p, p.in[6], p.in[7], true, false); break;
      case 4: phase_gemm_bf16((const bf16_t*)(ws + O_XB), DM, (const bf16_t*)(ws + W_A_MIX_IN), DM, 1568, (bf16_t*)(ws + O_H), GLA_LD, smem); break;
      case 5: phase_gla_a(p, smem); break;
      case 6: phase_gla_b(p); break;
      case 7: phase_gla_c(p, smem); break;
      case 8: phase_gemm_bf16((const bf16_t*)(ws + O_XB), DM, (const bf16_t*)(ws + W_A_MIX_IN) + (size_t)1664 * DM, DM, 1856, (bf16_t*)(ws + O_H), RW_LD, smem); break;
      case 9: phase_rw_act(p); break;
      case 10: phase_rw_lowrank(p, smem); break;
      case 11: phase_rw_pre(p); break;
      case 12: phase_rw_scan(p, smem); break;
      case 13: phase_gemm_bf16((const bf16_t*)(ws + O_ACTG), 128, (const bf16_t*)(ws + W_A_GUP), 128, 512, (bf16_t*)(ws + O_DER) + 2 * SLAB, 512, smem); break;
      case 14:
        phase_rw_post(p);
        wconv(p.in[28], DM, DM, DM, 0, 0, (bf16_t*)(ws + W_B_MIX_OUT), smem);
        wconv(p.in[33], DM, DM, DM, 0, 0, (bf16_t*)(ws + W_B_Q), smem);
        wconv(p.in[34], 2 * DM, DM, 2 * DM, 0, 0, (bf16_t*)(ws + W_B_KV), smem);
        wconv(p.in[35], DM, DM, DM, 0, 0, (bf16_t*)(ws + W_B_O), smem);
        wconv(p.in[38], 2 * DFF, DM, 2 * DFF, 1, 0, (bf16_t*)(ws + W_B_FFN_IN), smem);
        wconv(p.in[39], DM, DFF, DM, 0, 0, (bf16_t*)(ws + W_B_FFN_OUT), smem);
        break;
      case 15: phase_gemm_res(p, (const bf16_t*)(ws + O_MIXG), 512, (const bf16_t*)(ws + O_XB), 512, 512, DM, (const bf16_t*)(ws + W_B_MIX_OUT), 1.0f, false, smem); break;
      case 16: phase_ln(p, p.in[29], p.in[30], true, true); break;
      case 17: phase_ca_qkv(p, smem); break;
      case 18: phase_ca_scores(p, smem); break;
      case 19: phase_ca_softmax(p); break;
      case 20: phase_ca_pv(p, smem); break;
      case 21: phase_gemm_res(p, (const bf16_t*)(ws + O_XB), DM, nullptr, 0, DM, DM, (const bf16_t*)(ws + W_B_O), 1.0f, false, smem); break;
      case 22: phase_ln(p, p.in[36], p.in[37], true, false); break;
      case 23: phase_ffn_in(p, (const bf16_t*)(ws + W_B_FFN_IN), smem); break;
      case 24: phase_gemm_res(p, (const bf16_t*)(ws + O_H), DFF, nullptr, 0, DFF, DFF, (const bf16_t*)(ws + W_B_FFN_OUT), 0.5f, false, smem); break;
      case 25: phase_ln(p, p.in[40], p.in[41], false, false); break;
      default: break;
    }
}

constexpr size_t O_BAR = 463 * MiB + 768 * 1024;
#define XB_TMO      128
#define XB_XCNT(j)  (256  + 64 * (j))
#define XB_XSUB(j)  (1280 + 64 * (j))
#define XB_XGEN(j)  (2304 + 64 * (j))
#define XB_TOP      3328
#define XB_TOPGEN   3392
#define XCD_BAR_WORDS 3456
#define XB_SPIN_CAP (1u << 18)
#define LAS __attribute__((address_space(3)))

__device__ __forceinline__ unsigned xb_ld(unsigned* p)              { return __hip_atomic_load(p, __ATOMIC_RELAXED, __HIP_MEMORY_SCOPE_AGENT); }
__device__ __forceinline__ unsigned xb_add(unsigned* p, unsigned v) { return __hip_atomic_fetch_add(p, v, __ATOMIC_RELAXED, __HIP_MEMORY_SCOPE_AGENT); }
__device__ __forceinline__ unsigned xb_xcc_id() { return (unsigned)__builtin_amdgcn_s_getreg((3 << 11) | 20) & 0xFu; }
#define XB_SPIN(cond, bar) do { unsigned _sp = 0; while (cond) { __builtin_amdgcn_s_sleep(1); \
    if ((++_sp & 255u) == 0u) { if (xb_ld(&(bar)[XB_TMO])) break; if (_sp > XB_SPIN_CAP) { atomicAdd(&(bar)[XB_TMO], 1u); break; } } } } while (0)

struct XcdBarrier {
    unsigned* bar; unsigned x;
    volatile LAS unsigned* st;
};

__device__ __forceinline__ XcdBarrier xcd_barrier_post(unsigned* bar, volatile LAS unsigned* st) {
    XcdBarrier b; b.bar = bar; b.x = xb_xcc_id(); b.st = st;
    if (threadIdx.x == 0) (void)xb_add(&bar[XB_XCNT(b.x)], 1u);
    return b;
}
__device__ __forceinline__ void xcd_barrier_complete(unsigned* bar, unsigned x, unsigned& nloc, unsigned& nx) {
    const unsigned G = gridDim.x * gridDim.y * gridDim.z;
    unsigned sum, cnt, mine, sp = 0u;
    for (;;) {
        sum = 0u; cnt = 0u; mine = 0u;
#pragma unroll
        for (unsigned j = 0; j < 16; ++j) { const unsigned c = xb_ld(&bar[XB_XCNT(j)]); sum += c; cnt += (c > 0u) ? 1u : 0u; mine = (j == x) ? c : mine; }
        if (sum == G) break;
        __builtin_amdgcn_s_sleep(1);
        if ((++sp & 255u) == 0u) { if (xb_ld(&bar[XB_TMO])) break; if (sp > XB_SPIN_CAP) { atomicAdd(&bar[XB_TMO], 1u); break; } }
    }
    nloc = mine > 0u ? mine : 1u; nx = cnt > 0u ? cnt : 1u;
}

__device__ __forceinline__ void xcd_barrier(const XcdBarrier& b) {
    asm volatile("s_waitcnt vmcnt(0)" ::: "memory");
    __syncthreads();
    if (threadIdx.x == 0) {
        unsigned* bar = b.bar;
        __builtin_amdgcn_s_waitcnt(0);
        unsigned nloc = b.st[0], nx = b.st[1];
        if (nloc == 0u) { xcd_barrier_complete(bar, b.x, nloc, nx); b.st[0] = nloc; b.st[1] = nx; }
        const unsigned old = xb_add(&bar[XB_XSUB(b.x)], 1u);
        const unsigned gen = old / nloc;
        if (old + 1u == (gen + 1u) * nloc) {
            __builtin_amdgcn_fence(__ATOMIC_RELEASE, "agent");
            asm volatile("s_waitcnt vmcnt(0)" ::: "memory");
            const unsigned og = xb_add(&bar[XB_TOP], 1u);
            const unsigned tg = og / nx;
            if (og + 1u == (tg + 1u) * nx) xb_add(&bar[XB_TOPGEN], 1u);
            else XB_SPIN(xb_ld(&bar[XB_TOPGEN]) == tg, bar);
            __builtin_amdgcn_fence(__ATOMIC_ACQUIRE, "agent");
            xb_add(&bar[XB_XGEN(b.x)], 1u);
            asm volatile("s_waitcnt vmcnt(0)" ::: "memory");
        } else {
            XB_SPIN(xb_ld(&bar[XB_XGEN(b.x)]) == gen, bar);
            __builtin_amdgcn_fence(__ATOMIC_ACQUIRE, "agent");
            asm volatile("s_waitcnt vmcnt(0)" ::: "memory");
        }
    }
    __syncthreads();
}

#define PHASE_STEP(N) if (ph_lo <= N && N < ph_hi) { for (int rep = 0; rep <= (int)((dup >> N) & 1u); ++rep) { run_phase(p, N, smem); if (N + 1 < ph_hi) { if (ph_lo < 0) grid.sync(); else { XcdBarrier xb_; xb_.bar = (unsigned*)(p.ws + O_BAR); xb_.st = (volatile LAS unsigned*)&xb_words; xb_.x = xb_.st[2]; xcd_barrier(xb_); } } } }
__global__ void __launch_bounds__(256, 2) mega(Params p, int ph_lo, int ph_hi, unsigned dup) {
  __shared__ __attribute__((aligned(16))) char smem[SMEM_BYTES];
  cg::grid_group grid = cg::this_grid();
  __shared__ uint4 xb_words;
  if (threadIdx.x == 0) xb_words = make_uint4(0u, 0u, 0u, 0u);
  __syncthreads();
  if (ph_hi - ph_lo > 1) {
    XcdBarrier xb = xcd_barrier_post((unsigned*)(p.ws + O_BAR), (volatile LAS unsigned*)&xb_words);
    if (threadIdx.x == 0) xb_words.z = xb.x;
    __syncthreads();
  }
  PHASE_STEP(0)
  PHASE_STEP(1)
  PHASE_STEP(2)
  PHASE_STEP(3)
  PHASE_STEP(4)
  PHASE_STEP(5)
  PHASE_STEP(6)
  PHASE_STEP(7)
  PHASE_STEP(8)
  PHASE_STEP(9)
  PHASE_STEP(10)
  PHASE_STEP(11)
  PHASE_STEP(12)
  PHASE_STEP(13)
  PHASE_STEP(14)
  PHASE_STEP(15)
  PHASE_STEP(16)
  PHASE_STEP(17)
  PHASE_STEP(18)
  PHASE_STEP(19)
  PHASE_STEP(20)
  PHASE_STEP(21)
  PHASE_STEP(22)
  PHASE_STEP(23)
  PHASE_STEP(24)
  PHASE_STEP(25)
}

#ifdef PHASE_TEST
template <int PH> __global__ void __launch_bounds__(256, 2) mega_t(Params p) {
  __shared__ __attribute__((aligned(16))) char smem[SMEM_BYTES];
  run_phase(p, PH, smem);
}
template __global__ void mega_t<0>(Params);
template __global__ void mega_t<1>(Params);
template __global__ void mega_t<2>(Params);
template __global__ void mega_t<3>(Params);
template __global__ void mega_t<4>(Params);
template __global__ void mega_t<5>(Params);
template __global__ void mega_t<6>(Params);
template __global__ void mega_t<7>(Params);
template __global__ void mega_t<8>(Params);
template __global__ void mega_t<9>(Params);
template __global__ void mega_t<10>(Params);
template __global__ void mega_t<11>(Params);
template __global__ void mega_t<12>(Params);
template __global__ void mega_t<13>(Params);
template __global__ void mega_t<14>(Params);
template __global__ void mega_t<15>(Params);
template __global__ void mega_t<16>(Params);
template __global__ void mega_t<17>(Params);
template __global__ void mega_t<18>(Params);
template __global__ void mega_t<19>(Params);
template __global__ void mega_t<20>(Params);
template __global__ void mega_t<21>(Params);
template __global__ void mega_t<22>(Params);
template __global__ void mega_t<23>(Params);
template __global__ void mega_t<24>(Params);
template __global__ void mega_t<25>(Params);
#endif

extern "C" void kernel_launch(void* const* d_in, const int* in_sizes, int n_in, void* d_out, int out_size,
                              void* d_ws, size_t ws_size, hipStream_t stream) {
  if (ws_size < WS_NEED || n_in < 42) {
    fprintf(stderr, "kernel_launch: workspace too small (%zu) or inputs missing (%d)\n", ws_size, n_in);
    return;
  }
  static int grid_blocks = 0;
  if (!grid_blocks) {
    int dev = 0, cus = 0, per_cu = 0;
    hipGetDevice(&dev);
    hipDeviceGetAttribute(&cus, hipDeviceAttributeMultiprocessorCount, dev);
    hipOccupancyMaxActiveBlocksPerMultiprocessor(&per_cu, mega, 256, 0);
    if (per_cu > 2) per_cu = 2;
    if (per_cu < 1) per_cu = 1;
    grid_blocks = cus * per_cu;
  }
  Params p{};
  for (int i = 0; i < 42; ++i) p.in[i] = (const float*)d_in[i];
  p.out = (float*)d_out;
  p.ws = (char*)d_ws;
  const int nph = NPHASE + 1;
#if MULTI_LAUNCH
  for (int ph = 0; ph < nph; ++ph) {
    hipLaunchKernelGGL(mega, dim3(grid_blocks), dim3(256), 0, stream, p, ph, ph + 1, 0u);
  }
#else
#ifndef PROBE_DUP
#define PROBE_DUP 0u
#endif
  hipMemsetAsync((char*)d_ws + O_BAR, 0, XCD_BAR_WORDS * 4, stream);
  int lo = 0, hi = nph;
  unsigned dup = PROBE_DUP;
  void* args[] = {&p, &lo, &hi, &dup};
  hipError_t e = hipLaunchCooperativeKernel((void*)mega, dim3(grid_blocks), dim3(256), args, 0, stream);
  if (e != hipSuccess) fprintf(stderr, "cooperative launch failed: %s (grid %d)\n", hipGetErrorString(e), grid_blocks);
#endif
}
```

```cpp
#include <hip/hip_runtime.h>
#include <hip/hip_bf16.h>
#include <hip/hip_cooperative_groups.h>
#include <cstdio>
namespace cg = cooperative_groups;

#ifndef MULTI_LAUNCH
#define MULTI_LAUNCH 0
#endif

typedef unsigned short bf16_t;
using bf16x8 = __attribute__((ext_vector_type(8))) short;
using f32x16 = __attribute__((ext_vector_type(16))) float;
using u32x4 = __attribute__((ext_vector_type(4))) unsigned;
using f32x2 = __attribute__((ext_vector_type(2))) float;
using f32x4v = __attribute__((ext_vector_type(4))) float;

#define DEV __device__ __forceinline__

constexpr int NTOK = 49152;
constexpr int NPROMPT = 16384;
constexpr int DM = 1024;
constexpr int DFF = 2816;
constexpr int GLA_LD = 1568;
constexpr int RW_LD = 1856;
constexpr float ALPHA = 1.189207115002721f;
constexpr size_t MiB = 1ull << 20;
constexpr size_t SLAB = (size_t)NTOK * 512;

constexpr size_t W_A_FFN_IN = 0, W_A_FFN_OUT = 11 * MiB, W_A_MIX_IN = 17 * MiB, W_A_UPF = 24 * MiB,
                 W_A_UPB = 24 * MiB + 65536, W_A_AUP = 24 * MiB + 2 * 65536, W_A_GUP = 24 * MiB + 3 * 65536;
constexpr size_t W_B_MIX_OUT = 0, W_B_Q = 2 * MiB, W_B_KV = 4 * MiB, W_B_O = 8 * MiB, W_B_FFN_IN = 10 * MiB, W_B_FFN_OUT = 21 * MiB;
constexpr size_t O_XB = 27 * MiB;
constexpr size_t O_H = 123 * MiB;
constexpr size_t O_KV = 270 * MiB;
constexpr size_t O_DEC = 462 * MiB;
constexpr size_t O_DER = 297 * MiB;
constexpr size_t O_ACTG = 441 * MiB;
constexpr size_t O_BONUS = 453 * MiB;
constexpr size_t O_MIXG = 464 * MiB;
constexpr size_t O_MEMB = 219 * MiB, O_KB = 225 * MiB, O_VT = 231 * MiB, O_SCORES = 237 * MiB;
constexpr size_t WS_NEED = 512 * MiB;

struct Params {
  const float* in[42];
  float* out;
  char* ws;
};

DEV bf16_t f2bf(float f) { return __builtin_bit_cast(bf16_t, (__bf16)f); }
DEV float bf2f(bf16_t b) { return __uint_as_float(((unsigned)b) << 16); }
typedef __bf16 nbf2_t __attribute__((ext_vector_type(2)));
typedef float nf2_t __attribute__((ext_vector_type(2)));
DEV unsigned pack2(float a, float b) {
  const nf2_t v = {a, b};
  return __builtin_bit_cast(unsigned, __builtin_convertvector(v, nbf2_t));
}
DEV float sigm(float x) { return __builtin_amdgcn_rcpf(1.f + __expf(-x)); }
DEV float tanh_fast(float x) { return 1.f - 2.f * __builtin_amdgcn_rcpf(1.f + __expf(2.f * x)); }
DEV float silu(float x) { return x * sigm(x); }
DEV float logsig(float x) { return fminf(x, 0.f) - __logf(1.f + __expf(-fabsf(x))); }
DEV float wave_sum(float v) {
#pragma unroll
  for (int o = 32; o > 0; o >>= 1) v += __shfl_xor(v, o);
  return v;
}
DEV float wave_max(float v) {
#pragma unroll
  for (int o = 32; o > 0; o >>= 1) v = fmaxf(v, __shfl_xor(v, o));
  return v;
}
template <int CTRL> DEV float dppf(float x) {
  return __builtin_bit_cast(float, __builtin_amdgcn_mov_dpp(__builtin_bit_cast(int, x), CTRL, 0xf, 0xf, true));
}
DEV float row16_sum(float x) {
  x += dppf<0x128>(x);
  x += dppf<0x124>(x);
  x += dppf<0x122>(x);
  x += dppf<0x121>(x);
  return x;
}
DEV void row16_sum2(float& a, float& b) {
  asm volatile("s_nop 1\n\tv_add_f32_dpp %0, %0, %0 row_ror:8 row_mask:0xf bank_mask:0xf\n\tv_add_f32_dpp %1, %1, %1 row_ror:8 row_mask:0xf bank_mask:0xf\n\t"
               "s_nop 1\n\tv_add_f32_dpp %0, %0, %0 row_ror:4 row_mask:0xf bank_mask:0xf\n\tv_add_f32_dpp %1, %1, %1 row_ror:4 row_mask:0xf bank_mask:0xf\n\t"
               "s_nop 1\n\tv_add_f32_dpp %0, %0, %0 row_ror:2 row_mask:0xf bank_mask:0xf\n\tv_add_f32_dpp %1, %1, %1 row_ror:2 row_mask:0xf bank_mask:0xf\n\t"
               "s_nop 1\n\tv_add_f32_dpp %0, %0, %0 row_ror:1 row_mask:0xf bank_mask:0xf\n\tv_add_f32_dpp %1, %1, %1 row_ror:1 row_mask:0xf bank_mask:0xf\n\t"
               "s_nop 0"
               : "+v"(a), "+v"(b));
}
DEV float wave_sum_dpp(float x) {
  x = row16_sum(x);
  const int xi = __builtin_bit_cast(int, x);
  const float s0 = __builtin_bit_cast(float, __builtin_amdgcn_readlane(xi, 0));
  const float s1 = __builtin_bit_cast(float, __builtin_amdgcn_readlane(xi, 16));
  const float s2 = __builtin_bit_cast(float, __builtin_amdgcn_readlane(xi, 32));
  const float s3 = __builtin_bit_cast(float, __builtin_amdgcn_readlane(xi, 48));
  return (s0 + s1) + (s2 + s3);
}
DEV void seq_of_token(int t, int& tb, int& T) {
  if (t < NPROMPT) { tb = t & ~2047; T = 2048; }
  else { int u = t - NPROMPT; tb = NPROMPT + (u & ~8191); T = 8192; }
}
DEV const float* xin_row(const Params& p, int row) {
  return row < NPROMPT ? p.in[0] + (size_t)row * DM : p.in[1] + (size_t)(row - NPROMPT) * DM;
}
DEV void unpack8(uint4 u, float* v) {
  v[0] = __uint_as_float(u.x << 16); v[1] = __uint_as_float(u.x & 0xffff0000u);
  v[2] = __uint_as_float(u.y << 16); v[3] = __uint_as_float(u.y & 0xffff0000u);
  v[4] = __uint_as_float(u.z << 16); v[5] = __uint_as_float(u.z & 0xffff0000u);
  v[6] = __uint_as_float(u.w << 16); v[7] = __uint_as_float(u.w & 0xffff0000u);
}

DEV void unpack8p(uint4 u, f32x2* v) {
  v[0] = (f32x2){__uint_as_float(u.x << 16), __uint_as_float(u.x & 0xffff0000u)};
  v[1] = (f32x2){__uint_as_float(u.y << 16), __uint_as_float(u.y & 0xffff0000u)};
  v[2] = (f32x2){__uint_as_float(u.z << 16), __uint_as_float(u.z & 0xffff0000u)};
  v[3] = (f32x2){__uint_as_float(u.w << 16), __uint_as_float(u.w & 0xffff0000u)};
}

constexpr int LDT = 72;

constexpr int TM = 256;
constexpr int NRT = NTOK / TM;
struct GRegs { u32x4 a0, a1, a2, a3, b0, b1; };
DEV void gemm_gload(GRegs& g, const bf16_t* A0, int lda0, const bf16_t* A1, int lda1, int ksplit,
                    const bf16_t* Bt, int ldb, int k0, int tid) {
  const bf16_t* Ab; int lda, kk;
  if (k0 < ksplit) { Ab = A0; lda = lda0; kk = k0; }
  else { Ab = A1; lda = lda1; kk = k0 - ksplit; }
  const int row = tid >> 2, kc = (tid & 3) * 8;
  const bf16_t* pa = Ab + (size_t)row * lda + kk + kc;
  const bf16_t* pb = Bt + (size_t)row * ldb + k0 + kc;
  g.a0 = *(const u32x4*)(pa);
  g.a1 = *(const u32x4*)(pa + (size_t)64 * lda);
  g.a2 = *(const u32x4*)(pa + (size_t)128 * lda);
  g.a3 = *(const u32x4*)(pa + (size_t)192 * lda);
  g.b0 = *(const u32x4*)(pb);
  g.b1 = *(const u32x4*)(pb + (size_t)64 * ldb);
}
DEV void gemm_lds_write(const GRegs& g, bf16_t* wa, bf16_t* wb) {
  *(u32x4*)(wa) = g.a0; *(u32x4*)(wa + 64 * 32) = g.a1; *(u32x4*)(wa + 128 * 32) = g.a2; *(u32x4*)(wa + 192 * 32) = g.a3;
  *(u32x4*)(wb) = g.b0; *(u32x4*)(wb + 64 * 32) = g.b1;
}

constexpr int GSA = 256 * 32;
constexpr int GST = (256 + 128) * 32;
template <bool RES, class Epi>
DEV void gemm_tile_x(const bf16_t* A0, int lda0, const bf16_t* A1, int lda1, int ksplit,
                     const bf16_t* Bt, int ldb, int K, char* smem, const float* resb, Epi epi) {
  bf16_t* sbase = (bf16_t*)smem;
  const int tid = threadIdx.x, lane = tid & 63, wv = tid >> 6;
  const int wm = wv >> 1, wn = wv & 1;
  f32x16 acc[4][2];
#pragma unroll
  for (int i = 0; i < 4; ++i)
#pragma unroll
    for (int j = 0; j < 2; ++j)
#pragma unroll
      for (int r = 0; r < 16; ++r) acc[i][j][r] = 0.f;
  GRegs g, g1;
  const int nk = K >> 5;
  const int woff = (tid >> 2) * 32 + (((tid & 3) ^ ((tid >> 4) & 3)) << 3);
  const int swz = (lane >> 2) & 3, hh = lane >> 5;
  const int raoff = (wm * 128 + (lane & 31)) * 32;
  const int rboff = GSA + (wn * 64 + (lane & 31)) * 32;
  const int ko0 = ((0 + hh) ^ swz) << 3, ko1 = ((2 + hh) ^ swz) << 3;

  __syncthreads();
  gemm_gload(g, A0, lda0, A1, lda1, ksplit, Bt, ldb, 0, tid);
  if (nk > 1) gemm_gload(g1, A0, lda0, A1, lda1, ksplit, Bt, ldb, 32, tid);
  gemm_lds_write(g, sbase + woff, sbase + GSA + woff);
  if (nk > 2) gemm_gload(g, A0, lda0, A1, lda1, ksplit, Bt, ldb, 64, tid);
  __syncthreads();
#define GEMM_COMPUTE(ST)                                                                                  \
  _Pragma("unroll") for (int ks = 0; ks < 2; ++ks) {                                                      \
    const int ko = ks ? ko1 : ko0;                                                                        \
    bf16x8 a[4], b[2];                                                                                    \
    _Pragma("unroll") for (int mi = 0; mi < 4; ++mi) a[mi] = *(const bf16x8*)((ST) + raoff + mi * 32 * 32 + ko); \
    _Pragma("unroll") for (int ni = 0; ni < 2; ++ni) b[ni] = *(const bf16x8*)((ST) + rboff + ni * 32 * 32 + ko); \
    _Pragma("unroll") for (int mi = 0; mi < 4; ++mi)                                                      \
      _Pragma("unroll") for (int ni = 0; ni < 2; ++ni)                                                    \
        acc[mi][ni] = __builtin_amdgcn_mfma_f32_32x32x16_bf16(a[mi], b[ni], acc[mi][ni], 0, 0, 0);        \
  }
  for (int kt = 0; kt < nk; kt += 2) {
    GEMM_COMPUTE(sbase);
    if (kt + 1 < nk) gemm_lds_write(g1, sbase + GST + woff, sbase + GST + GSA + woff);
    if (kt + 3 < nk) gemm_gload(g1, A0, lda0, A1, lda1, ksplit, Bt, ldb, (kt + 3) * 32, tid);
    __syncthreads();
    if (kt + 1 < nk) {
      GEMM_COMPUTE(sbase + GST);
      if (kt + 2 < nk) gemm_lds_write(g, sbase + woff, sbase + GSA + woff);
      if (kt + 4 < nk) gemm_gload(g, A0, lda0, A1, lda1, ksplit, Bt, ldb, (kt + 4) * 32, tid);
      __syncthreads();
    }
  }
#undef GEMM_COMPUTE
  const int rl = wm * 128 + 4 * (lane >> 5);
  const int col = wn * 64 + (lane & 31);
  const unsigned resoff = (unsigned)(rl * DM + col);
#pragma unroll
  for (int mi = 0; mi < 4; ++mi) {
#pragma unroll
    for (int rh = 0; rh < 2; ++rh) {
      float x0[8], x1[8];
      if (RES) {
#pragma unroll
        for (int r8 = 0; r8 < 8; ++r8) {
          const int r = rh * 8 + r8;
          const int ru = mi * 32 + (r & 3) + 8 * (r >> 2);
          const float* rp = resb + ru * DM;
          x0[r8] = rp[resoff];
          x1[r8] = rp[resoff + 32];
        }
      }
#pragma unroll
      for (int r8 = 0; r8 < 8; ++r8) {
        const int r = rh * 8 + r8;
        const int ru = mi * 32 + (r & 3) + 8 * (r >> 2);
        if (RES) epi(ru, rl, col, acc[mi][0][r], acc[mi][1][r], x0[r8], x1[r8]);
        else epi(ru, rl, col, acc[mi][0][r], acc[mi][1][r], 0.f, 0.f);
        if ((r8 & 3) == 3) __builtin_amdgcn_sched_barrier(0);
      }
    }
  }
}
template <class Epi>
DEV void gemm_tile(const bf16_t* A0, int lda0, const bf16_t* A1, int lda1, int ksplit,
                   const bf16_t* Bt, int ldb, int K, char* smem, Epi epi) {
  gemm_tile_x<false>(A0, lda0, A1, lda1, ksplit, Bt, ldb, K, smem, nullptr,
                     [&](int ru, int rl, int c, float v0, float v1, float, float) { epi(ru, rl, c, v0, v1); });
}

DEV void wconv(const float* src, int ld, int K, int N, int mode, int coloff, bf16_t* dst, char* smem) {
  float* tile = (float*)smem;
  const int tid = threadIdx.x;
  const int nkt = K >> 6, nnt = N >> 5, nn4 = (nnt + 3) >> 2;
  for (int tl = blockIdx.x; tl < nkt * nn4; tl += gridDim.x) {
    const int kt = tl % nkt, n4 = tl / nkt;
    __syncthreads();
    {
      const int n = tid & 31, kk = tid >> 5;
      float v[4][8];
#pragma unroll
      for (int u = 0; u < 4; ++u) {
        int nt = n4 * 4 + u;
        if (nt >= nnt) nt = nnt - 1;
        const int cb = mode ? ((nt & 1) * DFF + (nt >> 1) * 32) : (coloff + nt * 32);
#pragma unroll
        for (int i = 0; i < 8; ++i) v[u][i] = src[(size_t)(kt * 64 + kk + 8 * i) * ld + cb + n];
      }
#pragma unroll
      for (int u = 0; u < 4; ++u)
#pragma unroll
        for (int i = 0; i < 8; ++i) tile[u * (64 * 33) + (kk + 8 * i) * 33 + n] = v[u][i];
    }
    __syncthreads();
    {
      const int k2 = tid & 31, nn = tid >> 5;
#pragma unroll
      for (int u = 0; u < 4; ++u) {
        const int nt = n4 * 4 + u;
        if (nt < nnt) {
#pragma unroll
          for (int i = 0; i < 4; ++i) {
            const int n = nn + 8 * i;
            const unsigned w = pack2(tile[u * (64 * 33) + (2 * k2) * 33 + n], tile[u * (64 * 33) + (2 * k2 + 1) * 33 + n]);
            *(unsigned*)(dst + (size_t)(nt * 32 + n) * K + kt * 64 + 2 * k2) = w;
          }
        }
      }
    }
  }
  __syncthreads();
}

DEV void ln_load(const float* src, float4 (&v)[4], int lane) {
#pragma unroll
  for (int i = 0; i < 4; ++i) v[i] = *(const float4*)(src + (i * 64 + lane) * 4);
}
DEV void ln_finish(float4 (&v)[4], float* dstf, bf16_t* dstb, const float* g, const float* b, int lane) {
  float s = 0.f;
#pragma unroll
  for (int i = 0; i < 4; ++i) s += v[i].x + v[i].y + v[i].z + v[i].w;
  const float mu = wave_sum_dpp(s) * (1.f / 1024.f);
  float q = 0.f;
#pragma unroll
  for (int i = 0; i < 4; ++i) {
    v[i].x -= mu; v[i].y -= mu; v[i].z -= mu; v[i].w -= mu;
    q += v[i].x * v[i].x + v[i].y * v[i].y + v[i].z * v[i].z + v[i].w * v[i].w;
  }
  const float rs = rsqrtf(wave_sum_dpp(q) * (1.f / 1024.f) + 1e-5f);
#pragma unroll
  for (int i = 0; i < 4; ++i) {
    const int c = (i * 64 + lane) * 4;
    const float4 gg = *(const float4*)(g + c), bb = *(const float4*)(b + c);
    float4 o;
    o.x = v[i].x * rs * gg.x + bb.x; o.y = v[i].y * rs * gg.y + bb.y;
    o.z = v[i].z * rs * gg.z + bb.z; o.w = v[i].w * rs * gg.w + bb.w;
    if (dstf) *(float4*)(dstf + c) = o;
    if (dstb) { uint2 u; u.x = pack2(o.x, o.y); u.y = pack2(o.z, o.w); *(uint2*)(dstb + c) = u; }
  }
}

DEV void phase_ln(const Params& p, const float* g, const float* b, bool write_xb, bool do_mem) {
  const int lane = threadIdx.x & 63;
  const int gw = blockIdx.x * 4 + (threadIdx.x >> 6), nw = gridDim.x * 4;
  bf16_t* xb = (bf16_t*)(p.ws + O_XB);
  for (int r = gw; r < NTOK; r += 2 * nw) {
    const int r2 = r + nw;
    float4 v0[4], v1[4];
    float* row0 = p.out + (size_t)r * DM;
    float* row1 = p.out + (size_t)(r2 < NTOK ? r2 : r) * DM;
    ln_load(row0, v0, lane);
    ln_load(row1, v1, lane);
    ln_finish(v0, row0, write_xb ? xb + (size_t)r * DM : nullptr, g, b, lane);
    if (r2 < NTOK) ln_finish(v1, row1, write_xb ? xb + (size_t)r2 * DM : nullptr, g, b, lane);
  }
  if (do_mem) {
    for (int m = gw; m < 3072; m += nw) {
      const float* src = m < 2048 ? p.in[2] + (size_t)m * DM : p.in[3] + (size_t)(m - 2048) * DM;
      float4 v0[4];
      ln_load(src, v0, lane);
      ln_finish(v0, nullptr, (bf16_t*)(p.ws + O_MEMB) + (size_t)m * DM, p.in[31], p.in[32], lane);
    }
  }
}

DEV bool tile_map(int it, int nct, int& rt, int& ct) {
  const int bpx = gridDim.x >> 3, xcd = blockIdx.x & 7, j = blockIdx.x >> 3;
  const int q = j + it * bpx;
  if (q >= 24 * nct) return false;
  const int band = q / (8 * nct), qq = q - band * 8 * nct;
  rt = xcd * 24 + band * 8 + (qq & 7);
  ct = qq >> 3;
  return true;
}

DEV void phase_ffn_in(const Params& p, const bf16_t* wt, char* smem) {
  const bf16_t* xb = (const bf16_t*)(p.ws + O_XB);
  bf16_t* h = (bf16_t*)(p.ws + O_H);
  const int nct = 44;
  int rt, ct;
  for (int it = 0; tile_map(it, nct, rt, ct); ++it) {
    bf16_t* hb = h + (size_t)rt * TM * DFF + ct * 64;
    gemm_tile(xb + (size_t)rt * TM * DM, DM, nullptr, 0, DM, wt + (size_t)ct * 128 * DM, DM, DM, smem,
              [&](int ru, int rl, int c, float v0, float v1) {
                (hb + ru * DFF)[(unsigned)(rl * DFF + (c >> 6) * 32 + (c & 31))] = f2bf(silu(v0) * v1);
              });
  }
}
DEV void phase_gemm_res(const Params& p, const bf16_t* A0, int lda0, const bf16_t* A1, int lda1, int ksplit, int K,
                        const bf16_t* wt, float scale, bool res_is_input, char* smem) {
  const int nct = 8;
  int rt, ct;
  for (int it = 0; tile_map(it, nct, rt, ct); ++it) {
    const int r0 = rt * TM, c0 = ct * 128;
    const bf16_t* a1 = A1 ? A1 + (size_t)r0 * lda1 : nullptr;
    const float* resb = (res_is_input ? xin_row(p, r0) : p.out + (size_t)r0 * DM) + c0;
    float* outb = p.out + (size_t)r0 * DM + c0;
    gemm_tile_x<true>(A0 + (size_t)r0 * lda0, lda0, a1, lda1, ksplit, wt + (size_t)c0 * K, K, K, smem, resb,
              [&](int ru, int rl, int c, float v0, float v1, float x0, float x1) {
                float* op = outb + ru * DM;
                const unsigned off = (unsigned)(rl * DM + c);
                op[off] = ALPHA * x0 + scale * v0;
                op[off + 32] = ALPHA * x1 + scale * v1;
              });
  }
}
DEV void phase_gemm_bf16(const bf16_t* A, int lda, const bf16_t* wt, int K, int N, bf16_t* out, int ldo, char* smem) {
  const int nct = (N + 127) >> 7;
  int rt, ct;
  for (int it = 0; tile_map(it, nct, rt, ct); ++it) {
    const int r0 = rt * TM, c0 = ct * 128;
    gemm_tile(A + (size_t)r0 * lda, lda, nullptr, 0, K, wt + (size_t)c0 * K, K, K, smem,
              [&](int ru, int rl, int c, float v0, float v1) {
                bf16_t* o = out + (size_t)(r0 + ru) * ldo + c0;
                const unsigned off = (unsigned)(rl * ldo + c);
                const int cc = c0 + c;
                if (cc < N) o[off] = f2bf(v0);
                if (cc + 32 < N) o[off + 32] = f2bf(v1);
              });
  }
}

constexpr int GL = 72;
struct GlaSmemM {
  bf16_t VT[128 * GL];
  bf16_t R1[128 * GL];
  bf16_t QB[64 * GL];
  bf16_t P[64 * GL];
  float gd[64 * 32];
  float tot[256];
  float blast[64];
};
static_assert(sizeof(GlaSmemM) <= 65536, "GlaSmemM too big");
constexpr int OBS = 132;

DEV int mfma_row(int r, int lane) { return (r & 3) + 8 * (r >> 2) + 4 * (lane >> 5); }
DEV void mma_k64(f32x16& acc, const bf16_t* sA, const bf16_t* sB, int lane) {
  const int o = (lane & 31) * GL + (lane >> 5) * 8;
#pragma unroll
  for (int ks = 0; ks < 4; ++ks) {
    const bf16x8 a = *(const bf16x8*)(sA + o + ks * 16);
    const bf16x8 b = *(const bf16x8*)(sB + o + ks * 16);
    acc = __builtin_amdgcn_mfma_f32_32x32x16_bf16(a, b, acc, 0, 0, 0);
  }
}
DEV void gla_load_vtg(const bf16_t* proj, int t0, int h, GlaSmemM* s) {
  const int tid = threadIdx.x;
#pragma unroll
  for (int i = 0; i < 4; ++i) {
    const int id = tid + 256 * i, c = id & 63, ec = id >> 6;
    const uint4 u = *(const uint4*)(proj + (size_t)(t0 + c) * GLA_LD + 512 + h * 128 + ec * 8);
    const unsigned w[4] = {u.x, u.y, u.z, u.w};
#pragma unroll
    for (int j = 0; j < 4; ++j) {
      s->VT[(ec * 8 + 2 * j) * GL + c] = (bf16_t)(w[j] & 0xffffu);
      s->VT[(ec * 8 + 2 * j + 1) * GL + c] = (bf16_t)(w[j] >> 16);
    }
  }
  {
    const int c = tid >> 2, part = tid & 3;
    const uint4 u = *(const uint4*)(proj + (size_t)(t0 + c) * GLA_LD + 1536 + part * 8);
    float v[8];
    unpack8(u, v);
#pragma unroll
    for (int j = 0; j < 8; ++j) s->gd[c * 32 + part * 8 + j] = v[j];
  }
}
DEV void gla_gates(const Params& p, int h, int dir, const float* gd, float* tot, float (&b)[16], float& bl) {
  const int tid = threadIdx.x, d = tid & 63, cq = tid >> 6;
  const float* up = dir ? p.in[11] : p.in[9];
  const float* gb = dir ? p.in[12] : p.in[10];
  float u[16];
#pragma unroll
  for (int m = 0; m < 16; ++m) u[m] = up[m * 256 + h * 64 + d];
  const float bias = gb[h * 64 + d];
#pragma unroll
  for (int i = 0; i < 16; ++i) {
    const int c = cq * 16 + i;
    float z = bias;
#pragma unroll
    for (int m4 = 0; m4 < 4; ++m4) {
      const float4 g4 = *(const float4*)(gd + c * 32 + dir * 16 + m4 * 4);
      z += g4.x * u[m4 * 4] + g4.y * u[m4 * 4 + 1] + g4.z * u[m4 * 4 + 2] + g4.w * u[m4 * 4 + 3];
    }
    b[i] = logsig(z) * (1.f / 16.f);
  }
  float run = 0.f;
  if (dir == 0) {
#pragma unroll
    for (int i = 0; i < 16; ++i) { run += b[i]; b[i] = run; }
  } else {
#pragma unroll
    for (int i = 15; i >= 0; --i) { run += b[i]; b[i] = run; }
  }
  tot[cq * 64 + d] = run;
  __syncthreads();
  const float t0 = tot[d], t1 = tot[64 + d], t2 = tot[128 + d], t3 = tot[192 + d];
  float off;
  if (dir == 0) off = (cq > 0 ? t0 : 0.f) + (cq > 1 ? t1 : 0.f) + (cq > 2 ? t2 : 0.f);
  else off = (cq < 3 ? t3 : 0.f) + (cq < 2 ? t2 : 0.f) + (cq < 1 ? t1 : 0.f);
#pragma unroll
  for (int i = 0; i < 16; ++i) b[i] += off;
  bl = (t0 + t1) + (t2 + t3);
}

DEV void phase_gla_a(const Params& p, char* smem) {
  GlaSmemM* s = (GlaSmemM*)smem;
  const bf16_t* proj = (const bf16_t*)(p.ws + O_H);
  float* kv = (float*)(p.ws + O_KV);
  float* dec = (float*)(p.ws + O_DEC);
  const int tid = threadIdx.x, lane = tid & 63, wv = tid >> 6;
  for (int item = blockIdx.x; item < 768 * 4; item += gridDim.x) {
    const int gch = item >> 2, h = item & 3, t0 = gch * 64;
    __syncthreads();
    gla_load_vtg(proj, t0, h, s);
    float kf[16];
    {
      const int d = tid & 63, cq = tid >> 6;
#pragma unroll
      for (int i = 0; i < 16; ++i) kf[i] = bf2f(proj[(size_t)(t0 + cq * 16 + i) * GLA_LD + 256 + h * 64 + d]);
    }
    __syncthreads();
    for (int dir = 0; dir < 2; ++dir) {
      float bb[16], bl;
      gla_gates(p, h, dir, s->gd, s->tot, bb, bl);
      {
        const int d = tid & 63, cq = tid >> 6;
        unsigned w[8];
#pragma unroll
        for (int i = 0; i < 8; ++i)
          w[i] = pack2(kf[2 * i] * __expf(bl - bb[2 * i]), kf[2 * i + 1] * __expf(bl - bb[2 * i + 1]));
        bf16_t* dst = s->R1 + d * GL + cq * 16;
        *(u32x4*)(dst) = (u32x4){w[0], w[1], w[2], w[3]};
        *(u32x4*)(dst + 8) = (u32x4){w[4], w[5], w[6], w[7]};
        if (cq == 0) s->blast[d] = bl;
      }
      __syncthreads();
      f32x16 acc[2];
#pragma unroll
      for (int j = 0; j < 2; ++j)
#pragma unroll
        for (int r = 0; r < 16; ++r) acc[j][r] = 0.f;
#pragma unroll
      for (int db = 0; db < 2; ++db) mma_k64(acc[db], s->VT + wv * 32 * GL, s->R1 + db * 32 * GL, lane);
      const size_t kvi = (size_t)item * 2 + dir;
      float* ob = kv + kvi * 8192;
#pragma unroll
      for (int db = 0; db < 2; ++db)
#pragma unroll
        for (int r = 0; r < 16; ++r) {
          const int e = wv * 32 + mfma_row(r, lane), d = db * 32 + (lane & 31);
          ob[e * 64 + d] = acc[db][r];
        }
      if (tid < 64) dec[kvi * 64 + tid] = __expf(s->blast[tid]);
      __syncthreads();
    }
  }
}

DEV void phase_gla_b(const Params& p) {
  float* kv = (float*)(p.ws + O_KV);
  const float* dec = (const float*)(p.ws + O_DEC);
  const int tid = threadIdx.x;
  for (int unit = blockIdx.x; unit < 96 * 32; unit += gridDim.x) {
    const int sid = unit >> 5, part = unit & 31;
    const int sq = sid >> 3, h = (sid >> 1) & 3, dir = sid & 1;
    int c0, nch;
    if (sq < 4) { c0 = 256 + sq * 128; nch = 128; }
    else { c0 = (sq - 4) * 32; nch = 32; }
    const int e = part * 256 + tid;
    float S = 0.f;
    for (int n0 = 0; n0 < nch; n0 += 8) {
      float tmp[8], dc[8];
#pragma unroll
      for (int u = 0; u < 8; ++u) {
        const int n = n0 + u;
        const int ci = dir ? (c0 + nch - 1 - n) : (c0 + n);
        const size_t idx = ((size_t)ci * 4 + h) * 2 + dir;
        tmp[u] = kv[idx * 8192 + e];
        dc[u] = dec[idx * 64 + (e & 63)];
      }
#pragma unroll
      for (int u = 0; u < 8; ++u) {
        const int n = n0 + u;
        const int ci = dir ? (c0 + nch - 1 - n) : (c0 + n);
        const size_t idx = ((size_t)ci * 4 + h) * 2 + dir;
        kv[idx * 8192 + e] = S;
        S = dc[u] * S + tmp[u];
      }
    }
  }
}

DEV void phase_gla_c(const Params& p, char* smem) {
  GlaSmemM* s = (GlaSmemM*)smem;
  const bf16_t* proj = (const bf16_t*)(p.ws + O_H);
  const float* kv = (const float*)(p.ws + O_KV);
  bf16_t* mixed = (bf16_t*)(p.ws + O_MIXG);
  const int tid = threadIdx.x, lane = tid & 63, wv = tid >> 6;
  const int cg_ = tid >> 4, eg = tid & 15;
  float* Ob = (float*)s->R1;
  static_assert(64 * OBS * 4 <= (128 + 64 + 64) * GL * 2, "output staging does not fit");
  for (int item = blockIdx.x; item < 768 * 4; item += gridDim.x) {
    const int gch = item >> 2, h = item & 3, t0 = gch * 64;
    __syncthreads();
    gla_load_vtg(proj, t0, h, s);
    float qf[16], kf[16];
    {
      const int d = tid & 63, cq = tid >> 6;
#pragma unroll
      for (int i = 0; i < 16; ++i) {
        const bf16_t* row = proj + (size_t)(t0 + cq * 16 + i) * GLA_LD + h * 64 + d;
        qf[i] = bf2f(row[0]) * 0.125f;
        kf[i] = bf2f(row[256]);
      }
    }
    __syncthreads();
    const int cb = wv & 1, eb0 = (wv >> 1) * 2;
    f32x16 acc[2];
#pragma unroll
    for (int j = 0; j < 2; ++j)
#pragma unroll
      for (int r = 0; r < 16; ++r) acc[j][r] = 0.f;
    for (int dir = 0; dir < 2; ++dir) {
      {
        float bb[16], bl;
        gla_gates(p, h, dir, s->gd, s->tot, bb, bl);
        const int d = tid & 63, cq = tid >> 6;
        const float bref = 0.5f * bl;
#pragma unroll
        for (int i = 0; i < 16; ++i) {
          const int c = cq * 16 + i;
          const float b = bb[i];
          const float q = qf[i];
          const float k = kf[i];
          s->R1[c * GL + d] = f2bf(q * __expf(b - bref));
          s->R1[(64 + c) * GL + d] = f2bf(k * __expf(bref - b));
          s->QB[c * GL + d] = f2bf(q * __expf(b));
        }
      }
      __syncthreads();
      {
        const int sb = wv >> 1, cbs = wv & 1;
        f32x16 sc;
#pragma unroll
        for (int r = 0; r < 16; ++r) sc[r] = 0.f;
        mma_k64(sc, s->R1 + (64 + sb * 32) * GL, s->R1 + cbs * 32 * GL, lane);
        const int c = cbs * 32 + (lane & 31);
#pragma unroll
        for (int g = 0; g < 4; ++g) {
          float v[4];
#pragma unroll
          for (int i = 0; i < 4; ++i) {
            const int sr = sb * 32 + 8 * g + 4 * (lane >> 5) + i;
            const bool keep = dir ? (sr >= c) : (sr <= c);
            v[i] = keep ? sc[4 * g + i] : 0.f;
          }
          uint2 w;
          w.x = pack2(v[0], v[1]);
          w.y = pack2(v[2], v[3]);
          *(uint2*)(s->P + c * GL + sb * 32 + 8 * g + 4 * (lane >> 5)) = w;
        }
      }
      const float* Sp = kv + ((size_t)item * 2 + dir) * 8192 + tid * 4;
      f32x4v sv[8];
#pragma unroll
      for (int i = 0; i < 8; ++i) sv[i] = *(const f32x4v*)(Sp + i * 1024);
      __syncthreads();
#pragma unroll
      for (int i = 0; i < 8; ++i) {
        const int el = (tid + 256 * i) * 4, e = el >> 6, d = el & 63;
        uint2 w;
        w.x = pack2(sv[i].x, sv[i].y);
        w.y = pack2(sv[i].z, sv[i].w);
        *(uint2*)(s->R1 + e * GL + d) = w;
      }
#pragma unroll
      for (int j = 0; j < 2; ++j) mma_k64(acc[j], s->P + cb * 32 * GL, s->VT + (eb0 + j) * 32 * GL, lane);
      __syncthreads();
#pragma unroll
      for (int j = 0; j < 2; ++j) mma_k64(acc[j], s->QB + cb * 32 * GL, s->R1 + (eb0 + j) * 32 * GL, lane);
      __syncthreads();
    }
#pragma unroll
    for (int j = 0; j < 2; ++j)
#pragma unroll
      for (int r = 0; r < 16; ++r) {
        const int c = cb * 32 + mfma_row(r, lane), e = (eb0 + j) * 32 + (lane & 31);
        Ob[c * OBS + e] = acc[j][r];
      }
    __syncthreads();
    float ng[8];
#pragma unroll
    for (int j = 0; j < 8; ++j) ng[j] = p.in[13][h * 128 + eg * 8 + j];
#pragma unroll
    for (int i = 0; i < 4; ++i) {
      const int cr = cg_ * 4 + i;
      const float4 o0 = *(const float4*)(Ob + cr * OBS + eg * 8), o1 = *(const float4*)(Ob + cr * OBS + eg * 8 + 4);
      const float o[8] = {o0.x, o0.y, o0.z, o0.w, o1.x, o1.y, o1.z, o1.w};
      float ss = 0.f;
#pragma unroll
      for (int j = 0; j < 8; ++j) ss += o[j] * o[j];
      ss = row16_sum(ss);
      const float rs = rsqrtf(ss * (1.f / 128.f) + 1e-5f);
      const int t = t0 + cr;
      float g[8];
      unpack8(*(const uint4*)(proj + (size_t)t * GLA_LD + 1024 + h * 128 + eg * 8), g);
      uint4 u;
      u.x = pack2(o[0] * rs * ng[0] * silu(g[0]), o[1] * rs * ng[1] * silu(g[1]));
      u.y = pack2(o[2] * rs * ng[2] * silu(g[2]), o[3] * rs * ng[3] * silu(g[3]));
      u.z = pack2(o[4] * rs * ng[4] * silu(g[4]), o[5] * rs * ng[5] * silu(g[5]));
      u.w = pack2(o[6] * rs * ng[6] * silu(g[6]), o[7] * rs * ng[7] * silu(g[7]));
      *(uint4*)(mixed + (size_t)t * 512 + h * 128 + eg * 8) = u;
    }
  }
}

DEV void phase_rw_act(const Params& p) {
  const bf16_t* proj = (const bf16_t*)(p.ws + O_H);
  bf16_t* awda = (bf16_t*)(p.ws + O_XB);
  bf16_t* ag = (bf16_t*)(p.ws + O_ACTG);
  const int total = NTOK * 160;
  const int stride = gridDim.x * 256;
  for (int base = blockIdx.x * 256 + threadIdx.x; base < total; base += 8 * stride) {
    unsigned x[8], pv[8], nx[8];
#pragma unroll
    for (int u = 0; u < 8; ++u) {
      int idx = base + u * stride;
      if (idx >= total) idx = base;
      const int t = idx / 160, cp = idx - t * 160;
      int tb, T;
      seq_of_token(t, tb, T);
      const bf16_t* ptr = proj + (size_t)t * RW_LD + 1536 + cp * 2;
      x[u] = *(const unsigned*)ptr;
      pv[u] = *(const unsigned*)(ptr + (t > tb ? -RW_LD : 0));
      nx[u] = *(const unsigned*)(ptr + (t < tb + T - 1 ? RW_LD : 0));
    }
#pragma unroll
    for (int u = 0; u < 8; ++u) {
      const int idx = base + u * stride;
      if (idx < total) {
        const int t = idx / 160, cp = idx - t * 160;
        int tb, T;
        seq_of_token(t, tb, T);
        const bool hp = t > tb, hn = t < tb + T - 1;
        const int rc = 1536 + cp * 2;
        float v[2];
#pragma unroll
        for (int e = 0; e < 2; ++e) {
          const float xx = e ? __uint_as_float(x[u] & 0xffff0000u) : __uint_as_float(x[u] << 16);
          const float pp = hp ? (e ? __uint_as_float(pv[u] & 0xffff0000u) : __uint_as_float(pv[u] << 16)) : 0.f;
          const float nn = hn ? (e ? __uint_as_float(nx[u] & 0xffff0000u) : __uint_as_float(nx[u] << 16)) : 0.f;
          v[e] = xx + p.in[14][rc + e] * (pp - xx) + p.in[15][rc + e] * (nn - xx);
        }
        const int col = cp * 2;
        if (col < 128) *(unsigned*)(awda + (size_t)t * 192 + col) = pack2(tanh_fast(v[0]), tanh_fast(v[1]));
        else if (col < 192) *(unsigned*)(awda + (size_t)t * 192 + col) = pack2(v[0], v[1]);
        else *(unsigned*)(ag + (size_t)t * 128 + (col - 192)) = pack2(sigm(v[0]), sigm(v[1]));
      }
    }
  }
}

DEV void phase_rw_lowrank(const Params& p, char* smem) {
  const bf16_t* awda = (const bf16_t*)(p.ws + O_XB);
  bf16_t* der = (bf16_t*)(p.ws + O_DER);
  int rt, ct12;
  for (int it = 0; tile_map(it, 12, rt, ct12); ++it) {
    const int which = ct12 >> 2, ct = ct12 & 3;
    const int r0 = rt * TM, c0 = ct * 128;
    const bf16_t* wt = (const bf16_t*)(p.ws + (which == 0 ? W_A_UPF : which == 1 ? W_A_UPB : W_A_AUP));
    const float* bias = which == 0 ? p.in[16] : which == 1 ? p.in[18] : p.in[20];
    bf16_t* out = der + (size_t)which * SLAB;
    gemm_tile(awda + (size_t)r0 * 192 + which * 64, 192, nullptr, 0, 64, wt + (size_t)c0 * 64, 64, 64, smem,
              [&](int ru, int rl, int c, float v0, float v1) {
                bf16_t* o = out + (size_t)(r0 + ru) * 512 + c0;
                const unsigned off = (unsigned)(rl * 512 + c);
                const float z0 = bias[c0 + c] + v0, z1 = bias[c0 + c + 32] + v1;
                if (which < 2) { o[off] = f2bf(-0.6065306597f * sigm(z0)); o[off + 32] = f2bf(-0.6065306597f * sigm(z1)); }
                else { o[off] = f2bf(sigm(z0)); o[off + 32] = f2bf(sigm(z1)); }
              });
  }
}

constexpr int SST = 388;
template <int RPL>
struct StepV { f32x4v w, nk, ka, k, r; float v[RPL]; float kar; };
template <int RPL>
DEV void step_load(StepV<RPL>& x, const float* sb, int jl, int rowbase) {
  x.w = *(const f32x4v*)(sb + jl * 4);
  x.nk = *(const f32x4v*)(sb + 64 + jl * 4);
  x.ka = *(const f32x4v*)(sb + 128 + jl * 4);
  x.k = *(const f32x4v*)(sb + 192 + jl * 4);
  x.r = *(const f32x4v*)(sb + 256 + jl * 4);
#pragma unroll
  for (int r = 0; r < RPL; ++r) x.v[r] = sb[320 + rowbase + r];
  x.kar = sb[384];
}

template <int RPL>
DEV void rwkv_scan(const Params& p, int tb, int T, int head, int dir, int split, float* st) {
  const int tid = threadIdx.x, lane = tid & 63, wv = tid >> 6;
  const int jl = lane & 15, ig = lane >> 4;
  const int hc = head * 64 + lane;
  float* ybuf = st + 2 * 16 * SST;
  const bf16_t* proj = (const bf16_t*)(p.ws + O_H);
  const bf16_t* ldp = (const bf16_t*)(p.ws + O_DER) + (size_t)dir * SLAB;
  const bf16_t* ap = (const bf16_t*)(p.ws + O_DER) + 2 * SLAB;
  bf16_t* yout = (bf16_t*)(p.ws + O_XB) + (size_t)dir * SLAB;
  const float* scal = (const float*)(p.ws + O_BONUS);
  const float mpr = p.in[14][hc], mnr = p.in[15][hc];
  const float mpk = p.in[14][512 + hc], mnk = p.in[15][512 + hc];
  const float mpv = p.in[14][1024 + hc], mnv = p.in[15][1024 + hc];
  const float kkw = p.in[23][hc], kaw = p.in[24][hc];
  const int rowl = wv * 4 * RPL + ig * RPL;
  const int rowbase = split * 16 * RPL + rowl;
  const int nch = T >> 4;
  const int ywoff = (jl == 0) ? rowl : (2 * 16 * 16 * RPL + rowl);
  f32x2 S01[RPL], S23[RPL];
#pragma unroll
  for (int r = 0; r < RPL; ++r) { S01[r] = (f32x2){0.f, 0.f}; S23[r] = (f32x2){0.f, 0.f}; }
  bf16_t rawA[4][11];
  float2 scA[4];

#define RW_LOAD(RAW, SC, CH)                                                            \
  _Pragma("unroll") for (int q = 0; q < 4; ++q) {                                       \
    const int tt_ = (CH) * 16 + wv * 4 + q;                                             \
    const int t_ = dir ? (T - 1 - tt_) : tt_;                                           \
    const bf16_t* row_ = proj + (size_t)(tb + t_) * RW_LD + hc;                         \
    const int op_ = t_ > 0 ? -RW_LD : 0, on_ = t_ < T - 1 ? RW_LD : 0;                  \
    _Pragma("unroll") for (int w = 0; w < 3; ++w) {                                     \
      RAW[q][w * 3 + 0] = row_[w * 512];                                                \
      RAW[q][w * 3 + 1] = row_[w * 512 + op_];                                          \
      RAW[q][w * 3 + 2] = row_[w * 512 + on_];                                          \
    }                                                                                   \
    RAW[q][9] = ldp[(size_t)(tb + t_) * 512 + hc];                                      \
    RAW[q][10] = ap[(size_t)(tb + t_) * 512 + hc];                                      \
    SC[q] = *(const float2*)(scal + ((size_t)(tb + t_) * 8 + head) * 4);                \
  }
#define RW_STAGE(RAW, SC, CH, BUF)                                                      \
  _Pragma("unroll") for (int q = 0; q < 4; ++q) {                                       \
    const int s_ = wv * 4 + q;                                                          \
    const int tt_ = (CH) * 16 + s_;                                                     \
    const int t_ = dir ? (T - 1 - tt_) : tt_;                                           \
    const bool hp_ = t_ > 0, hn_ = t_ < T - 1;                                          \
    float x_ = bf2f(RAW[q][0]);                                                         \
    const float r_ = x_ + mpr * ((hp_ ? bf2f(RAW[q][1]) : 0.f) - x_) + mnr * ((hn_ ? bf2f(RAW[q][2]) : 0.f) - x_);  \
    x_ = bf2f(RAW[q][3]);                                                               \
    const float kr_ = x_ + mpk * ((hp_ ? bf2f(RAW[q][4]) : 0.f) - x_) + mnk * ((hn_ ? bf2f(RAW[q][5]) : 0.f) - x_); \
    x_ = bf2f(RAW[q][6]);                                                               \
    const float v_ = x_ + mpv * ((hp_ ? bf2f(RAW[q][7]) : 0.f) - x_) + mnv * ((hn_ ? bf2f(RAW[q][8]) : 0.f) - x_);  \
    const float a_ = bf2f(RAW[q][10]);                                                  \
    const float kk_ = kr_ * kkw * SC[q].x;                                              \
    const float k2_ = kr_ * (1.f + (a_ - 1.f) * kaw);                                   \
    float* sb_ = st + (BUF) * (16 * SST) + s_ * SST;                                    \
    sb_[lane] = __expf(bf2f(RAW[q][9]));                                                \
    sb_[64 + lane] = -kk_;                                                              \
    sb_[128 + lane] = kk_ * a_;                                                         \
    sb_[192 + lane] = k2_;                                                              \
    sb_[256 + lane] = r_;                                                               \
    sb_[320 + lane] = v_;                                                               \
    if (lane == 0) sb_[384] = SC[q].y;                                                  \
  }
#define RW_MAIN(CH)                                                                     \
  {                                                                                     \
    const int buf = (CH) & 1;                                                           \
    const float* sbase = st + buf * (16 * SST);                                         \
    float* yb = ybuf + buf * (16 * 16 * RPL);                                           \
    StepV<RPL> cur, nxt;                                                                \
    step_load<RPL>(cur, sbase, jl, rowbase);                                            \
    _Pragma("unroll 4") for (int s = 0; s < 16; ++s) {                                  \
      step_load<RPL>(nxt, sbase + ((s + 1) & 15) * SST, jl, rowbase);                   \
      const f32x2 w01 = {cur.w.x, cur.w.y}, w23 = {cur.w.z, cur.w.w};                   \
      const f32x2 n01 = {cur.nk.x, cur.nk.y}, n23 = {cur.nk.z, cur.nk.w};               \
      const f32x2 a01 = {cur.ka.x, cur.ka.y}, a23 = {cur.ka.z, cur.ka.w};               \
      const f32x2 k01 = {cur.k.x, cur.k.y}, k23 = {cur.k.z, cur.k.w};                   \
      const f32x2 r01 = {cur.r.x, cur.r.y}, r23 = {cur.r.z, cur.r.w};                   \
      _Pragma("unroll") for (int r = 0; r < RPL; ++r) {                                 \
        f32x2 pz2 = S01[r] * n01;                                                       \
        pz2 = S23[r] * n23 + pz2;                                                       \
        float sa = pz2.x + pz2.y;                                                       \
        const f32x2 vv = {cur.v[r], cur.v[r]};                                          \
        f32x2 b01 = S01[r] * w01;                                                       \
        f32x2 b23 = S23[r] * w23;                                                       \
        b01 = vv * k01 + b01;                                                           \
        b23 = vv * k23 + b23;                                                           \
        f32x2 y2 = b01 * r01;                                                           \
        y2 = b23 * r23 + y2;                                                            \
        float yb_ = y2.x + y2.y;                                                        \
        row16_sum2(sa, yb_);                                                            \
        const f32x2 sa2 = {sa, sa};                                                     \
        S01[r] = sa2 * a01 + b01;                                                       \
        S23[r] = sa2 * a23 + b23;                                                       \
        const float y = yb_ + sa * cur.kar;                                             \
        yb[s * (16 * RPL) + ywoff + r] = y;                                             \
      }                                                                                 \
      cur = nxt;                                                                        \
    }                                                                                   \
  }
#define RW_FLUSH(CH)                                                                    \
  {                                                                                     \
    const float* yb = ybuf + ((CH) & 1) * (16 * 16 * RPL);                              \
    const int s = tid >> 4, rl = (tid & 15) * RPL;                                      \
    const int tt = (CH) * 16 + s;                                                       \
    const int t = dir ? (T - 1 - tt) : tt;                                              \
    bf16_t* yo = yout + (size_t)(tb + t) * 512 + head * 64 + split * 16 * RPL + rl;     \
    if (RPL == 1) yo[0] = f2bf(yb[s * 16 + rl]);                                        \
    else if (RPL == 2) *(unsigned*)yo = pack2(yb[s * 32 + rl], yb[s * 32 + rl + 1]);    \
    else { uint2 u; u.x = pack2(yb[s * 64 + rl], yb[s * 64 + rl + 1]); u.y = pack2(yb[s * 64 + rl + 2], yb[s * 64 + rl + 3]); *(uint2*)yo = u; } \
  }

  RW_LOAD(rawA, scA, 0);
  RW_STAGE(rawA, scA, 0, 0);
  __syncthreads();
  for (int ch = 0; ch < nch; ++ch) {
    if (ch + 1 < nch) { RW_LOAD(rawA, scA, ch + 1); }
    RW_MAIN(ch);
    if (ch + 1 < nch) { RW_STAGE(rawA, scA, ch + 1, (ch + 1) & 1); }
    __syncthreads();
    RW_FLUSH(ch);
  }
#undef RW_MAIN
#undef RW_FLUSH
#undef RW_LOAD
#undef RW_STAGE
}

DEV void phase_rw_pre(const Params& p) {
  const bf16_t* proj = (const bf16_t*)(p.ws + O_H);
  const bf16_t* ap = (const bf16_t*)(p.ws + O_DER) + 2 * SLAB;
  float* scal = (float*)(p.ws + O_BONUS);
  const int lane = threadIdx.x & 63;
  const int gw = blockIdx.x * 4 + (threadIdx.x >> 6), nw = gridDim.x * 4;
  for (int t = gw; t < NTOK; t += nw) {
    int tb, T;
    seq_of_token(t, tb, T);
    const bool hp = t > tb, hn = t < tb + T - 1;
    const int op = hp ? -RW_LD : 0, on = hn ? RW_LD : 0;
    const bf16_t* row = proj + (size_t)t * RW_LD + lane;
    bf16_t raw[8][7];
#pragma unroll
    for (int h = 0; h < 8; ++h) {
      raw[h][0] = row[h * 64];
      raw[h][1] = row[h * 64 + op];
      raw[h][2] = row[h * 64 + on];
      raw[h][3] = row[512 + h * 64];
      raw[h][4] = row[512 + h * 64 + op];
      raw[h][5] = row[512 + h * 64 + on];
      raw[h][6] = ap[(size_t)t * 512 + h * 64 + lane];
    }
#pragma unroll
    for (int h = 0; h < 8; ++h) {
      const int hc = h * 64 + lane;
      float x = bf2f(raw[h][0]);
      const float r = x + p.in[14][hc] * ((hp ? bf2f(raw[h][1]) : 0.f) - x) + p.in[15][hc] * ((hn ? bf2f(raw[h][2]) : 0.f) - x);
      x = bf2f(raw[h][3]);
      const float kr = x + p.in[14][512 + hc] * ((hp ? bf2f(raw[h][4]) : 0.f) - x) + p.in[15][512 + hc] * ((hn ? bf2f(raw[h][5]) : 0.f) - x);
      const float a = bf2f(raw[h][6]);
      const float kkr = kr * p.in[23][hc];
      const float inv = rsqrtf(fmaxf(wave_sum_dpp(kkr * kkr), 1e-24f));
      const float kk = kkr * inv;
      const float k2 = kr * (1.f + (a - 1.f) * p.in[24][hc]);
      const float kar = wave_sum_dpp(kk * a * r);
      const float bo = wave_sum_dpp(r * k2 * p.in[25][hc]);
      if (lane == 0) *(float4*)(scal + ((size_t)t * 8 + h) * 4) = make_float4(inv, kar, bo, 0.f);
    }
  }
}

DEV void phase_rw_scan(const Params& p, char* smem) {
  float* st = (float*)smem;
  for (int item = blockIdx.x; item < 512; item += gridDim.x) {
    __syncthreads();
    if (item < 256) {
      const int scan = item >> 2, split = item & 3;
      const int sq = scan >> 4, head = (scan >> 1) & 7, dir = scan & 1;
      __builtin_amdgcn_s_setprio(3);
      rwkv_scan<1>(p, NPROMPT + sq * 8192, 8192, head, dir, split, st);
      __builtin_amdgcn_s_setprio(0);
    } else {
      const int it = item - 256;
      const int scan = it >> 1, split = it & 1;
      const int sq = scan >> 4, head = (scan >> 1) & 7, dir = scan & 1;
      rwkv_scan<2>(p, sq * 2048, 2048, head, dir, split, st);
    }
  }
}

DEV void phase_rw_post(const Params& p) {
  const bf16_t* proj = (const bf16_t*)(p.ws + O_H);
  bf16_t* yf = (bf16_t*)(p.ws + O_XB);
  const bf16_t* yb = yf + SLAB;
  const bf16_t* gate = (const bf16_t*)(p.ws + O_DER) + 2 * SLAB;
  const float* scal = (const float*)(p.ws + O_BONUS);
  const int lane = threadIdx.x & 63;
  const int gw = blockIdx.x * 4 + (threadIdx.x >> 6), nw = gridDim.x * 4;
  for (int t = gw; t < NTOK; t += nw) {
    int tb, T;
    seq_of_token(t, tb, T);
    const bool hp = t > tb, hn = t < tb + T - 1;
    const int op = hp ? -RW_LD : 0, on = hn ? RW_LD : 0;
    const bf16_t* vrow = proj + (size_t)t * RW_LD + 1024 + lane;
    bf16_t raw[8][6];
    float bo[8];
#pragma unroll
    for (int h = 0; h < 8; ++h) {
      const size_t o = (size_t)t * 512 + h * 64 + lane;
      raw[h][0] = yf[o];
      raw[h][1] = yb[o];
      raw[h][2] = vrow[h * 64];
      raw[h][3] = vrow[h * 64 + op];
      raw[h][4] = vrow[h * 64 + on];
      raw[h][5] = gate[o];
      bo[h] = scal[((size_t)t * 8 + h) * 4 + 2];
    }
    bf16_t res[8];
#pragma unroll
    for (int h = 0; h < 8; ++h) {
      const int hc = h * 64 + lane;
      const float y = bf2f(raw[h][0]) + bf2f(raw[h][1]);
      const float mu = wave_sum_dpp(y) * (1.f / 64.f);
      const float dy = y - mu;
      const float var = wave_sum_dpp(dy * dy) * (1.f / 64.f);
      const float yn = dy * rsqrtf(var + 64e-5f) * p.in[26][hc] + p.in[27][hc];
      const float x = bf2f(raw[h][2]);
      const float v = x + p.in[14][1024 + hc] * ((hp ? bf2f(raw[h][3]) : 0.f) - x) + p.in[15][1024 + hc] * ((hn ? bf2f(raw[h][4]) : 0.f) - x);
      res[h] = f2bf((yn + bo[h] * v) * bf2f(raw[h][5]));
    }
#pragma unroll
    for (int h = 0; h < 8; ++h) yf[(size_t)t * 512 + h * 64 + lane] = res[h];
  }
}

DEV int seq_of_rowtile(int rt) { return rt < 64 ? (rt >> 3) : 8 + ((rt - 64) >> 5); }

DEV void phase_ca_qkv(const Params& p, char* smem) {
  const bf16_t* xb = (const bf16_t*)(p.ws + O_XB);
  bf16_t* qb = (bf16_t*)(p.ws + O_H);
  const bf16_t* memb = (const bf16_t*)(p.ws + O_MEMB);
  bf16_t* kb = (bf16_t*)(p.ws + O_KB);
  bf16_t* vt = (bf16_t*)(p.ws + O_VT);
  const bf16_t* wq = (const bf16_t*)(p.ws + W_B_Q);
  const bf16_t* wkv = (const bf16_t*)(p.ws + W_B_KV);
  {
    int rt, ct;
    for (int it = 0; tile_map(it, 8, rt, ct); ++it) {
      const int r0 = rt * TM, c0 = ct * 128;
      gemm_tile(xb + (size_t)r0 * DM, DM, nullptr, 0, DM, wq + (size_t)c0 * DM, DM, DM, smem,
                [&](int ru, int rl, int c, float v0, float v1) {
                  bf16_t* o = qb + (size_t)(r0 + ru) * DM + c0;
                  const unsigned off = (unsigned)(rl * DM + c);
                  o[off] = f2bf(v0); o[off + 32] = f2bf(v1);
                });
    }
  }
  {
    for (int t2 = blockIdx.x; t2 < 12 * 16; t2 += gridDim.x) {
      const int rt = t2 >> 4, ct = t2 & 15;
      const int r0 = rt * TM, c0 = ct * 128;
      if (ct < 8) {
        bf16_t* o = kb + (size_t)r0 * DM + c0;
        gemm_tile(memb + (size_t)r0 * DM, DM, nullptr, 0, DM, wkv + (size_t)c0 * DM, DM, DM, smem,
                  [&](int ru, int rl, int c, float v0, float v1) {
                    const unsigned off = (unsigned)(rl * DM + c);
                    (o + ru * DM)[off] = f2bf(v0);
                    (o + ru * DM)[off + 32] = f2bf(v1);
                  });
      } else {
        bf16_t* o = vt + ((size_t)rt * 1024 + (c0 - 1024)) * 256;
        gemm_tile(memb + (size_t)r0 * DM, DM, nullptr, 0, DM, wkv + (size_t)c0 * DM, DM, DM, smem,
                  [&](int ru, int rl, int c, float v0, float v1) {
                    const unsigned off = (unsigned)(c * 256 + rl);
                    (o + ru)[off] = f2bf(v0);
                    (o + ru)[off + 32 * 256] = f2bf(v1);
                  });
      }
    }
  }
}
DEV void phase_ca_scores(const Params& p, char* smem) {
  const bf16_t* qb = (const bf16_t*)(p.ws + O_H);
  const bf16_t* kb = (const bf16_t*)(p.ws + O_KB);
  float* sc = (float*)(p.ws + O_SCORES);
  int rt, ct8;
  for (int it = 0; tile_map(it, 8, rt, ct8); ++it) {
    const int h = ct8 >> 1, nt = ct8 & 1;
    const int b = seq_of_rowtile(rt), r0 = rt * TM;
    gemm_tile(qb + (size_t)r0 * DM + h * 256, DM, nullptr, 0, 256,
              kb + (size_t)(b * 256 + nt * 128) * DM + h * 256, DM, 256, smem,
              [&](int ru, int rl, int c, float v0, float v1) {
                float* o = sc + (size_t)(r0 + ru) * DM + h * 256 + nt * 128;
                const unsigned off = (unsigned)(rl * DM + c);
                o[off] = v0 * 0.0625f; o[off + 32] = v1 * 0.0625f;
              });
  }
}
DEV void phase_ca_softmax(const Params& p) {
  const float* sc = (const float*)(p.ws + O_SCORES);
  bf16_t* pb = (bf16_t*)(p.ws + O_H);
  const int lane = threadIdx.x & 63;
  const int gw = blockIdx.x * 4 + (threadIdx.x >> 6), nw = gridDim.x * 4;
  const int total = NTOK * 4;
  for (int it = gw; it < total; it += 4 * nw) {
    float4 v[4];
#pragma unroll
    for (int u = 0; u < 4; ++u) {
      const int i2 = it + u * nw;
      v[u] = *(const float4*)(sc + (size_t)(i2 < total ? i2 : it) * 256 + lane * 4);
    }
#pragma unroll
    for (int u = 0; u < 4; ++u) {
      const int i2 = it + u * nw;
      float mx = fmaxf(fmaxf(v[u].x, v[u].y), fmaxf(v[u].z, v[u].w));
      mx = fmaxf(mx, dppf<0x128>(mx)); mx = fmaxf(mx, dppf<0x124>(mx)); mx = fmaxf(mx, dppf<0x122>(mx)); mx = fmaxf(mx, dppf<0x121>(mx));
      {
        const int xi = __builtin_bit_cast(int, mx);
        const float m0 = __builtin_bit_cast(float, __builtin_amdgcn_readlane(xi, 0));
        const float m1 = __builtin_bit_cast(float, __builtin_amdgcn_readlane(xi, 16));
        const float m2 = __builtin_bit_cast(float, __builtin_amdgcn_readlane(xi, 32));
        const float m3 = __builtin_bit_cast(float, __builtin_amdgcn_readlane(xi, 48));
        mx = fmaxf(fmaxf(m0, m1), fmaxf(m2, m3));
      }
      const float e0 = __expf(v[u].x - mx), e1 = __expf(v[u].y - mx), e2 = __expf(v[u].z - mx), e3 = __expf(v[u].w - mx);
      const float inv = 1.f / wave_sum_dpp(e0 + e1 + e2 + e3);
      if (i2 < total) {
        uint2 w;
        w.x = pack2(e0 * inv, e1 * inv);
        w.y = pack2(e2 * inv, e3 * inv);
        *(uint2*)(pb + (size_t)i2 * 256 + lane * 4) = w;
      }
    }
  }
}
DEV void phase_ca_pv(const Params& p, char* smem) {
  const bf16_t* pb = (const bf16_t*)(p.ws + O_H);
  const bf16_t* vt = (const bf16_t*)(p.ws + O_VT);
  bf16_t* attn = (bf16_t*)(p.ws + O_XB);
  int rt, ct8;
  for (int it = 0; tile_map(it, 8, rt, ct8); ++it) {
    const int h = ct8 >> 1, nt = ct8 & 1;
    const int b = seq_of_rowtile(rt), r0 = rt * TM;
    gemm_tile(pb + (size_t)r0 * DM + h * 256, DM, nullptr, 0, 256,
              vt + ((size_t)b * 1024 + h * 256 + nt * 128) * 256, 256, 256, smem,
              [&](int ru, int rl, int c, float v0, float v1) {
                bf16_t* o = attn + (size_t)(r0 + ru) * DM + h * 256 + nt * 128;
                const unsigned off = (unsigned)(rl * DM + c);
                o[off] = f2bf(v0); o[off + 32] = f2bf(v1);
              });
  }
}

DEV void phase_convert_x(const Params& p) {
  bf16_t* xb = (bf16_t*)(p.ws + O_XB);
  const size_t n4 = (size_t)NTOK * DM / 4;
  const size_t np4 = (size_t)NPROMPT * DM / 4;
  const size_t stride = (size_t)gridDim.x * 256;
  for (size_t i = (size_t)blockIdx.x * 256 + threadIdx.x; i < n4; i += 8 * stride) {
    float4 v[8];
#pragma unroll
    for (int u = 0; u < 8; ++u) {
      size_t j = i + u * stride;
      if (j >= n4) j = i;
      v[u] = j < np4 ? ((const float4*)p.in[0])[j] : ((const float4*)p.in[1])[j - np4];
    }
#pragma unroll
    for (int u = 0; u < 8; ++u) {
      const size_t j = i + u * stride;
      if (j < n4) {
        uint2 w;
        w.x = pack2(v[u].x, v[u].y);
        w.y = pack2(v[u].z, v[u].w);
        ((uint2*)xb)[j] = w;
      }
    }
  }
}

constexpr int NPHASE = 25;
constexpr int SMEM_BYTES = 64 * 1024;

DEV void run_phase(const Params& p, int ph, char* smem) {
  char* ws = p.ws;
    switch (ph) {
      case 0:
        wconv(p.in[4], 2 * DFF, DM, 2 * DFF, 1, 0, (bf16_t*)(ws + W_A_FFN_IN), smem);
        wconv(p.in[5], DM, DFF, DM, 0, 0, (bf16_t*)(ws + W_A_FFN_OUT), smem);
        wconv(p.in[8], 3424, DM, 1568, 0, 0, (bf16_t*)(ws + W_A_MIX_IN), smem);
        wconv(p.in[8], 3424, DM, 1856, 0, 1568, (bf16_t*)(ws + W_A_MIX_IN) + (size_t)1664 * DM, smem);
        wconv(p.in[17], 512, 64, 512, 0, 0, (bf16_t*)(ws + W_A_UPF), smem);
        wconv(p.in[19], 512, 64, 512, 0, 0, (bf16_t*)(ws + W_A_UPB), smem);
        wconv(p.in[21], 512, 64, 512, 0, 0, (bf16_t*)(ws + W_A_AUP), smem);
        wconv(p.in[22], 512, 128, 512, 0, 0, (bf16_t*)(ws + W_A_GUP), smem);
        phase_convert_x(p);
        break;
      case 1: phase_ffn_in(p, (const bf16_t*)(ws + W_A_FFN_IN), smem); break;
      case 2: phase_gemm_res(p, (const bf16_t*)(ws + O_H), DFF, nullptr, 0, DFF, DFF, (const bf16_t*)(ws + W_A_FFN_OUT), 0.5f, true, smem); break;
      case 3: phase_ln(p, p.in[6], p.in[7], true, false); break;
      case 4: phase_gemm_bf16((const bf16_t*)(ws + O_XB), DM, (const bf16_t*)(ws + W_A_MIX_IN), DM, 1568, (bf16_t*)(ws + O_H), GLA_LD, smem); break;
      case 5: phase_gla_a(p, smem); break;
      case 6: phase_gla_b(p); break;
      case 7: phase_gla_c(p, smem); break;
      case 8: phase_gemm_bf16((const bf16_t*)(ws + O_XB), DM, (const bf16_t*)(ws + W_A_MIX_IN) + (size_t)1664 * DM, DM, 1856, (bf16_t*)(ws + O_H), RW_LD, smem); break;
      case 9: phase_rw_act(p); break;
      case 10: phase_rw_lowrank(p, smem); break;
      case 11: phase_rw_pre(p); break;
      case 12: phase_rw_scan(p, smem); break;
      case 13: phase_gemm_bf16((const bf16_t*)(ws + O_ACTG), 128, (const bf16_t*)(ws + W_A_GUP), 128, 512, (bf16_t*)(ws + O_DER) + 2 * SLAB, 512, smem); break;
      case 14:
        phase_rw_post(p);
        wconv(p.in[28], DM, DM, DM, 0, 0, (bf16_t*)(ws + W_B_MIX_OUT), smem);
        wconv(p.in[33], DM, DM, DM, 0, 0, (bf16_t*)(ws + W_B_Q), smem);
        wconv(p.in[34], 2 * DM, DM, 2 * DM, 0, 0, (bf16_t*)(ws + W_B_KV), smem);
        wconv(p.in[35], DM, DM, DM, 0, 0, (bf16_t*)(ws + W_B_O), smem);
        wconv(p.in[38], 2 * DFF, DM, 2 * DFF, 1, 0, (bf16_t*)(ws + W_B_FFN_IN), smem);
        wconv(p.in[39], DM, DFF, DM, 0, 0, (bf16_t*)(ws + W_B_FFN_OUT), smem);
        break;
      case 15: phase_gemm_res(p, (const bf16_t*)(ws + O_MIXG), 512, (const bf16_t*)(ws + O_XB), 512, 512, DM, (const bf16_t*)(ws + W_B_MIX_OUT), 1.0f, false, smem); break;
      case 16: phase_ln(p, p.in[29], p.in[30], true, true); break;
      case 17: phase_ca_qkv(p, smem); break;
      case 18: phase_ca_scores(p, smem); break;
      case 19: phase_ca_softmax(p); break;
      case 20: phase_ca_pv(p, smem); break;
      case 21: phase_gemm_res(p, (const bf16_t*)(ws + O_XB), DM, nullptr, 0, DM, DM, (const bf16_t*)(ws + W_B_O), 1.0f, false, smem); break;
      case 22: phase_ln(p, p.in[36], p.in[37], true, false); break;
      case 23: phase_ffn_in(p, (const bf16_t*)(ws + W_B_FFN_IN), smem); break;
      case 24: phase_gemm_res(p, (const bf16_t*)(ws + O_H), DFF, nullptr, 0, DFF, DFF, (const bf16_t*)(ws + W_B_FFN_OUT), 0.5f, false, smem); break;
      case 25: phase_ln(p, p.in[40], p.in[41], false, false); break;
      default: break;
    }
}

constexpr size_t O_BAR = 463 * MiB + 768 * 1024;
#define XB_TMO      128
#define XB_XCNT(j)  (256  + 64 * (j))
#define XB_XSUB(j)  (1280 + 64 * (j))
#define XB_XGEN(j)  (2304 + 64 * (j))
#define XB_TOP      3328
#define XB_TOPGEN   3392
#define XCD_BAR_WORDS 3456
#define XB_SPIN_CAP (1u << 18)
#define LAS __attribute__((address_space(3)))

__device__ __forceinline__ unsigned xb_ld(unsigned* p)              { return __hip_atomic_load(p, __ATOMIC_RELAXED, __HIP_MEMORY_SCOPE_AGENT); }
__device__ __forceinline__ unsigned xb_add(unsigned* p, unsigned v) { return __hip_atomic_fetch_add(p, v, __ATOMIC_RELAXED, __HIP_MEMORY_SCOPE_AGENT); }
__device__ __forceinline__ unsigned xb_xcc_id() { return (unsigned)__builtin_amdgcn_s_getreg((3 << 11) | 20) & 0xFu; }
#define XB_SPIN(cond, bar) do { unsigned _sp = 0; while (cond) { __builtin_amdgcn_s_sleep(1); \
    if ((++_sp & 255u) == 0u) { if (xb_ld(&(bar)[XB_TMO])) break; if (_sp > XB_SPIN_CAP) { atomicAdd(&(bar)[XB_TMO], 1u); break; } } } } while (0)

struct XcdBarrier {
    unsigned* bar; unsigned x;
    volatile LAS unsigned* st;
};

__device__ __forceinline__ XcdBarrier xcd_barrier_post(unsigned* bar, volatile LAS unsigned* st) {
    XcdBarrier b; b.bar = bar; b.x = xb_xcc_id(); b.st = st;
    if (threadIdx.x == 0) (void)xb_add(&bar[XB_XCNT(b.x)], 1u);
    return b;
}
__device__ __forceinline__ void xcd_barrier_complete(unsigned* bar, unsigned x, unsigned& nloc, unsigned& nx) {
    const unsigned G = gridDim.x * gridDim.y * gridDim.z;
    unsigned sum, cnt, mine, sp = 0u;
    for (;;) {
        sum = 0u; cnt = 0u; mine = 0u;
#pragma unroll
        for (unsigned j = 0; j < 16; ++j) { const unsigned c = xb_ld(&bar[XB_XCNT(j)]); sum += c; cnt += (c > 0u) ? 1u : 0u; mine = (j == x) ? c : mine; }
        if (sum == G) break;
        __builtin_amdgcn_s_sleep(1);
        if ((++sp & 255u) == 0u) { if (xb_ld(&bar[XB_TMO])) break; if (sp > XB_SPIN_CAP) { atomicAdd(&bar[XB_TMO], 1u); break; } }
    }
    nloc = mine > 0u ? mine : 1u; nx = cnt > 0u ? cnt : 1u;
}

__device__ __forceinline__ void xcd_barrier(const XcdBarrier& b) {
    asm volatile("s_waitcnt vmcnt(0)" ::: "memory");
    __syncthreads();
    if (threadIdx.x == 0) {
        unsigned* bar = b.bar;
        __builtin_amdgcn_s_waitcnt(0);
        unsigned nloc = b.st[0], nx = b.st[1];
        if (nloc == 0u) { xcd_barrier_complete(bar, b.x, nloc, nx); b.st[0] = nloc; b.st[1] = nx; }
        const unsigned old = xb_add(&bar[XB_XSUB(b.x)], 1u);
        const unsigned gen = old / nloc;
        if (old + 1u == (gen + 1u) * nloc) {
            __builtin_amdgcn_fence(__ATOMIC_RELEASE, "agent");
            asm volatile("s_waitcnt vmcnt(0)" ::: "memory");
            const unsigned og = xb_add(&bar[XB_TOP], 1u);
            const unsigned tg = og / nx;
            if (og + 1u == (tg + 1u) * nx) xb_add(&bar[XB_TOPGEN], 1u);
            else XB_SPIN(xb_ld(&bar[XB_TOPGEN]) == tg, bar);
            __builtin_amdgcn_fence(__ATOMIC_ACQUIRE, "agent");
            xb_add(&bar[XB_XGEN(b.x)], 1u);
            asm volatile("s_waitcnt vmcnt(0)" ::: "memory");
        } else {
            XB_SPIN(xb_ld(&bar[XB_XGEN(b.x)]) == gen, bar);
            __builtin_amdgcn_fence(__ATOMIC_ACQUIRE, "agent");
            asm volatile("s_waitcnt vmcnt(0)" ::: "memory");
        }
    }
    __syncthreads();
}

#define PHASE_STEP(N) if (ph_lo <= N && N < ph_hi) { for (int rep = 0; rep <= (int)((dup >> N) & 1u); ++rep) { run_phase(p, N, smem); if (N + 1 < ph_hi) { if (ph_lo < 0) grid.sync(); else { XcdBarrier xb_; xb_.bar = (unsigned*)(p.ws + O_BAR); xb_.st = (volatile LAS unsigned*)&xb_words; xb_.x = xb_.st[2]; xcd_barrier(xb_); } } } }
__global__ void __launch_bounds__(256, 2) mega(Params p, int ph_lo, int ph_hi, unsigned dup) {
  __shared__ __attribute__((aligned(16))) char smem[SMEM_BYTES];
  cg::grid_group grid = cg::this_grid();
  __shared__ uint4 xb_words;
  if (threadIdx.x == 0) xb_words = make_uint4(0u, 0u, 0u, 0u);
  __syncthreads();
  if (ph_hi - ph_lo > 1) {
    XcdBarrier xb = xcd_barrier_post((unsigned*)(p.ws + O_BAR), (volatile LAS unsigned*)&xb_words);
    if (threadIdx.x == 0) xb_words.z = xb.x;
    __syncthreads();
  }
  PHASE_STEP(0)
  PHASE_STEP(1)
  PHASE_STEP(2)
  PHASE_STEP(3)
  PHASE_STEP(4)
  PHASE_STEP(5)
  PHASE_STEP(6)
  PHASE_STEP(7)
  PHASE_STEP(8)
  PHASE_STEP(9)
  PHASE_STEP(10)
  PHASE_STEP(11)
  PHASE_STEP(12)
  PHASE_STEP(13)
  PHASE_STEP(14)
  PHASE_STEP(15)
  PHASE_STEP(16)
  PHASE_STEP(17)
  PHASE_STEP(18)
  PHASE_STEP(19)
  PHASE_STEP(20)
  PHASE_STEP(21)
  PHASE_STEP(22)
  PHASE_STEP(23)
  PHASE_STEP(24)
  PHASE_STEP(25)
}

#ifdef PHASE_TEST
template <int PH> __global__ void __launch_bounds__(256, 2) mega_t(Params p) {
  __shared__ __attribute__((aligned(16))) char smem[SMEM_BYTES];
  run_phase(p, PH, smem);
}
template __global__ void mega_t<0>(Params);
template __global__ void mega_t<1>(Params);
template __global__ void mega_t<2>(Params);
template __global__ void mega_t<3>(Params);
template __global__ void mega_t<4>(Params);
template __global__ void mega_t<5>(Params);
template __global__ void mega_t<6>(Params);
template __global__ void mega_t<7>(Params);
template __global__ void mega_t<8>(Params);
template __global__ void mega_t<9>(Params);
template __global__ void mega_t<10>(Params);
template __global__ void mega_t<11>(Params);
template __global__ void mega_t<12>(Params);
template __global__ void mega_t<13>(Params);
template __global__ void mega_t<14>(Params);
template __global__ void mega_t<15>(Params);
template __global__ void mega_t<16>(Params);
template __global__ void mega_t<17>(Params);
template __global__ void mega_t<18>(Params);
template __global__ void mega_t<19>(Params);
template __global__ void mega_t<20>(Params);
template __global__ void mega_t<21>(Params);
template __global__ void mega_t<22>(Params);
template __global__ void mega_t<23>(Params);
template __global__ void mega_t<24>(Params);
template __global__ void mega_t<25>(Params);
#endif

extern "C" void kernel_launch(void* const* d_in, const int* in_sizes, int n_in, void* d_out, int out_size,
                              void* d_ws, size_t ws_size, hipStream_t stream) {
  if (ws_size < WS_NEED || n_in < 42) {
    fprintf(stderr, "kernel_launch: workspace too small (%zu) or inputs missing (%d)\n", ws_size, n_in);
    return;
  }
  static int grid_blocks = 0;
  if (!grid_blocks) {
    int dev = 0, cus = 0, per_cu = 0;
    hipGetDevice(&dev);
    hipDeviceGetAttribute(&cus, hipDeviceAttributeMultiprocessorCount, dev);
    hipOccupancyMaxActiveBlocksPerMultiprocessor(&per_cu, mega, 256, 0);
    if (per_cu > 2) per_cu = 2;
    if (per_cu < 1) per_cu = 1;
    grid_blocks = cus * per_cu;
  }
  Params p{};
  for (int i = 0; i < 42; ++i) p.in[i] = (const float*)d_in[i];
  p.out = (float*)d_out;
  p.ws = (char*)d_ws;
  const int nph = NPHASE + 1;
#if MULTI_LAUNCH
  for (int ph = 0; ph < nph; ++ph) {
    hipLaunchKernelGGL(mega, dim3(grid_blocks), dim3(256), 0, stream, p, ph, ph + 1, 0u);
  }
#else
#ifndef PROBE_DUP
#define PROBE_DUP 0u
#endif
  hipMemsetAsync((char*)d_ws + O_BAR, 0, XCD_BAR_WORDS * 4, stream);
  int lo = 0, hi = nph;
  unsigned dup = PROBE_DUP;
  void* args[] = {&p, &lo, &hi, &dup};
  hipError_t e = hipLaunchCooperativeKernel((void*)mega, dim3(grid_blocks), dim3(256), args, 0, stream);
  if (e != hipSuccess) fprintf(stderr, "cooperative launch failed: %s (grid %d)\n", hipGetErrorString(e), grid_blocks);
#endif
}
```

```cpp
#include <hip/hip_runtime.h>
#include <hip/hip_bf16.h>
#include <hip/hip_cooperative_groups.h>
#include <cstdio>
namespace cg = cooperative_groups;

#ifndef MULTI_LAUNCH
#define MULTI_LAUNCH 0
#endif

typedef unsigned short bf16_t;
using bf16x8 = __attribute__((ext_vector_type(8))) short;
using f32x16 = __attribute__((ext_vector_type(16))) float;
using u32x4 = __attribute__((ext_vector_type(4))) unsigned;
using f32x2 = __attribute__((ext_vector_type(2))) float;
using f32x4v = __attribute__((ext_vector_type(4))) float;

#define DEV __device__ __forceinline__

constexpr int NTOK = 49152;
constexpr int NPROMPT = 16384;
constexpr int DM = 1024;
constexpr int DFF = 2816;
constexpr int GLA_LD = 1568;
constexpr int RW_LD = 1856;
constexpr float ALPHA = 1.189207115002721f;
constexpr size_t MiB = 1ull << 20;
constexpr size_t SLAB = (size_t)NTOK * 512;

constexpr size_t W_A_FFN_IN = 0, W_A_FFN_OUT = 11 * MiB, W_A_MIX_IN = 17 * MiB, W_A_UPF = 24 * MiB,
                 W_A_UPB = 24 * MiB + 65536, W_A_AUP = 24 * MiB + 2 * 65536, W_A_GUP = 24 * MiB + 3 * 65536;
constexpr size_t W_B_MIX_OUT = 0, W_B_Q = 2 * MiB, W_B_KV = 4 * MiB, W_B_O = 8 * MiB, W_B_FFN_IN = 10 * MiB, W_B_FFN_OUT = 21 * MiB;
constexpr size_t O_XB = 27 * MiB;
constexpr size_t O_H = 123 * MiB;
constexpr size_t O_KV = 270 * MiB;
constexpr size_t O_DEC = 462 * MiB;
constexpr size_t O_DER = 297 * MiB;
constexpr size_t O_ACTG = 441 * MiB;
constexpr size_t O_BONUS = 453 * MiB;
constexpr size_t O_MIXG = 464 * MiB;
constexpr size_t O_MEMB = 219 * MiB, O_KB = 225 * MiB, O_VT = 231 * MiB, O_SCORES = 237 * MiB;
constexpr size_t WS_NEED = 512 * MiB;

struct Params {
  const float* in[42];
  float* out;
  char* ws;
};

DEV bf16_t f2bf(float f) { return __builtin_bit_cast(bf16_t, (__bf16)f); }
DEV float bf2f(bf16_t b) { return __uint_as_float(((unsigned)b) << 16); }
typedef __bf16 nbf2_t __attribute__((ext_vector_type(2)));
typedef float nf2_t __attribute__((ext_vector_type(2)));
DEV unsigned pack2(float a, float b) {
  const nf2_t v = {a, b};
  return __builtin_bit_cast(unsigned, __builtin_convertvector(v, nbf2_t));
}
DEV float sigm(float x) { return __builtin_amdgcn_rcpf(1.f + __expf(-x)); }
DEV float tanh_fast(float x) { return 1.f - 2.f * __builtin_amdgcn_rcpf(1.f + __expf(2.f * x)); }
DEV float silu(float x) { return x * sigm(x); }
DEV float logsig(float x) { return fminf(x, 0.f) - __logf(1.f + __expf(-fabsf(x))); }
DEV float wave_sum(float v) {
#pragma unroll
  for (int o = 32; o > 0; o >>= 1) v += __shfl_xor(v, o);
  return v;
}
DEV float wave_max(float v) {
#pragma unroll
  for (int o = 32; o > 0; o >>= 1) v = fmaxf(v, __shfl_xor(v, o));
  return v;
}
template <int CTRL> DEV float dppf(float x) {
  return __builtin_bit_cast(float, __builtin_amdgcn_mov_dpp(__builtin_bit_cast(int, x), CTRL, 0xf, 0xf, true));
}
DEV float row16_sum(float x) {
  x += dppf<0x128>(x);
  x += dppf<0x124>(x);
  x += dppf<0x122>(x);
  x += dppf<0x121>(x);
  return x;
}
DEV void row16_sum2(float& a, float& b) {
  asm volatile("s_nop 1\n\tv_add_f32_dpp %0, %0, %0 row_ror:8 row_mask:0xf bank_mask:0xf\n\tv_add_f32_dpp %1, %1, %1 row_ror:8 row_mask:0xf bank_mask:0xf\n\t"
               "s_nop 1\n\tv_add_f32_dpp %0, %0, %0 row_ror:4 row_mask:0xf bank_mask:0xf\n\tv_add_f32_dpp %1, %1, %1 row_ror:4 row_mask:0xf bank_mask:0xf\n\t"
               "s_nop 1\n\tv_add_f32_dpp %0, %0, %0 row_ror:2 row_mask:0xf bank_mask:0xf\n\tv_add_f32_dpp %1, %1, %1 row_ror:2 row_mask:0xf bank_mask:0xf\n\t"
               "s_nop 1\n\tv_add_f32_dpp %0, %0, %0 row_ror:1 row_mask:0xf bank_mask:0xf\n\tv_add_f32_dpp %1, %1, %1 row_ror:1 row_mask:0xf bank_mask:0xf\n\t"
               "s_nop 0"
               : "+v"(a), "+v"(b));
}
DEV float wave_sum_dpp(float x) {
  x = row16_sum(x);
  const int xi = __builtin_bit_cast(int, x);
  const float s0 = __builtin_bit_cast(float, __builtin_amdgcn_readlane(xi, 0));
  const float s1 = __builtin_bit_cast(float, __builtin_amdgcn_readlane(xi, 16));
  const float s2 = __builtin_bit_cast(float, __builtin_amdgcn_readlane(xi, 32));
  const float s3 = __builtin_bit_cast(float, __builtin_amdgcn_readlane(xi, 48));
  return (s0 + s1) + (s2 + s3);
}
DEV void seq_of_token(int t, int& tb, int& T) {
  if (t < NPROMPT) { tb = t & ~2047; T = 2048; }
  else { int u = t - NPROMPT; tb = NPROMPT + (u & ~8191); T = 8192; }
}
DEV const float* xin_row(const Params& p, int row) {
  return row < NPROMPT ? p.in[0] + (size_t)row * DM : p.in[1] + (size_t)(row - NPROMPT) * DM;
}
DEV void unpack8(uint4 u, float* v) {
  v[0] = __uint_as_float(u.x << 16); v[1] = __uint_as_float(u.x & 0xffff0000u);
  v[2] = __uint_as_float(u.y << 16); v[3] = __uint_as_float(u.y & 0xffff0000u);
  v[4] = __uint_as_float(u.z << 16); v[5] = __uint_as_float(u.z & 0xffff0000u);
  v[6] = __uint_as_float(u.w << 16); v[7] = __uint_as_float(u.w & 0xffff0000u);
}

DEV void unpack8p(uint4 u, f32x2* v) {
  v[0] = (f32x2){__uint_as_float(u.x << 16), __uint_as_float(u.x & 0xffff0000u)};
  v[1] = (f32x2){__uint_as_float(u.y << 16), __uint_as_float(u.y & 0xffff0000u)};
  v[2] = (f32x2){__uint_as_float(u.z << 16), __uint_as_float(u.z & 0xffff0000u)};
  v[3] = (f32x2){__uint_as_float(u.w << 16), __uint_as_float(u.w & 0xffff0000u)};
}

constexpr int LDT = 72;

constexpr int TM = 256;
constexpr int NRT = NTOK / TM;
struct GRegs { u32x4 a0, a1, a2, a3, b0, b1; };
DEV void gemm_gload(GRegs& g, const bf16_t* A0, int lda0, const bf16_t* A1, int lda1, int ksplit,
                    const bf16_t* Bt, int ldb, int k0, int tid) {
  const bf16_t* Ab; int lda, kk;
  if (k0 < ksplit) { Ab = A0; lda = lda0; kk = k0; }
  else { Ab = A1; lda = lda1; kk = k0 - ksplit; }
  const int row = tid >> 2, kc = (tid & 3) * 8;
  const bf16_t* pa = Ab + (size_t)row * lda + kk + kc;
  const bf16_t* pb = Bt + (size_t)row * ldb + k0 + kc;
  g.a0 = *(const u32x4*)(pa);
  g.a1 = *(const u32x4*)(pa + (size_t)64 * lda);
  g.a2 = *(const u32x4*)(pa + (size_t)128 * lda);
  g.a3 = *(const u32x4*)(pa + (size_t)192 * lda);
  g.b0 = *(const u32x4*)(pb);
  g.b1 = *(const u32x4*)(pb + (size_t)64 * ldb);
}
DEV void gemm_lds_write(const GRegs& g, bf16_t* wa, bf16_t* wb) {
  *(u32x4*)(wa) = g.a0; *(u32x4*)(wa + 64 * 32) = g.a1; *(u32x4*)(wa + 128 * 32) = g.a2; *(u32x4*)(wa + 192 * 32) = g.a3;
  *(u32x4*)(wb) = g.b0; *(u32x4*)(wb + 64 * 32) = g.b1;
}

constexpr int GSA = 256 * 32;
constexpr int GST = (256 + 128) * 32;
template <bool RES, class Epi>
DEV void gemm_tile_x(const bf16_t* A0, int lda0, const bf16_t* A1, int lda1, int ksplit,
                     const bf16_t* Bt, int ldb, int K, char* smem, const float* resb, Epi epi) {
  bf16_t* sbase = (bf16_t*)smem;
  const int tid = threadIdx.x, lane = tid & 63, wv = tid >> 6;
  const int wm = wv >> 1, wn = wv & 1;
  f32x16 acc[4][2];
#pragma unroll
  for (int i = 0; i < 4; ++i)
#pragma unroll
    for (int j = 0; j < 2; ++j)
#pragma unroll
      for (int r = 0; r < 16; ++r) acc[i][j][r] = 0.f;
  GRegs g, g1;
  const int nk = K >> 5;
  const int woff = (tid >> 2) * 32 + (((tid & 3) ^ ((tid >> 4) & 3)) << 3);
  const int swz = (lane >> 2) & 3, hh = lane >> 5;
  const int raoff = (wm * 128 + (lane & 31)) * 32;
  const int rboff = GSA + (wn * 64 + (lane & 31)) * 32;
  const int ko0 = ((0 + hh) ^ swz) << 3, ko1 = ((2 + hh) ^ swz) << 3;

  __syncthreads();
  gemm_gload(g, A0, lda0, A1, lda1, ksplit, Bt, ldb, 0, tid);
  if (nk > 1) gemm_gload(g1, A0, lda0, A1, lda1, ksplit, Bt, ldb, 32, tid);
  gemm_lds_write(g, sbase + woff, sbase + GSA + woff);
  if (nk > 2) gemm_gload(g, A0, lda0, A1, lda1, ksplit, Bt, ldb, 64, tid);
  __syncthreads();
#define GEMM_COMPUTE(ST)                                                                                  \
  _Pragma("unroll") for (int ks = 0; ks < 2; ++ks) {                                                      \
    const int ko = ks ? ko1 : ko0;                                                                        \
    bf16x8 a[4], b[2];                                                                                    \
    _Pragma("unroll") for (int mi = 0; mi < 4; ++mi) a[mi] = *(const bf16x8*)((ST) + raoff + mi * 32 * 32 + ko); \
    _Pragma("unroll") for (int ni = 0; ni < 2; ++ni) b[ni] = *(const bf16x8*)((ST) + rboff + ni * 32 * 32 + ko); \
    _Pragma("unroll") for (int mi = 0; mi < 4; ++mi)                                                      \
      _Pragma("unroll") for (int ni = 0; ni < 2; ++ni)                                                    \
        acc[mi][ni] = __builtin_amdgcn_mfma_f32_32x32x16_bf16(a[mi], b[ni], acc[mi][ni], 0, 0, 0);        \
  }
  for (int kt = 0; kt < nk; kt += 2) {
    GEMM_COMPUTE(sbase);
    if (kt + 1 < nk) gemm_lds_write(g1, sbase + GST + woff, sbase + GST + GSA + woff);
    if (kt + 3 < nk) gemm_gload(g1, A0, lda0, A1, lda1, ksplit, Bt, ldb, (kt + 3) * 32, tid);
    __syncthreads();
    if (kt + 1 < nk) {
      GEMM_COMPUTE(sbase + GST);
      if (kt + 2 < nk) gemm_lds_write(g, sbase + woff, sbase + GSA + woff);
      if (kt + 4 < nk) gemm_gload(g, A0, lda0, A1, lda1, ksplit, Bt, ldb, (kt + 4) * 32, tid);
      __syncthreads();
    }
  }
#undef GEMM_COMPUTE
  const int rl = wm * 128 + 4 * (lane >> 5);
  const int col = wn * 64 + (lane & 31);
  const unsigned resoff = (unsigned)(rl * DM + col);
#pragma unroll
  for (int mi = 0; mi < 4; ++mi) {
#pragma unroll
    for (int rh = 0; rh < 2; ++rh) {
      float x0[8], x1[8];
      if (RES) {
#pragma unroll
        for (int r8 = 0; r8 < 8; ++r8) {
          const int r = rh * 8 + r8;
          const int ru = mi * 32 + (r & 3) + 8 * (r >> 2);
          const float* rp = resb + ru * DM;
          x0[r8] = rp[resoff];
          x1[r8] = rp[resoff + 32];
        }
      }
#pragma unroll
      for (int r8 = 0; r8 < 8; ++r8) {
        const int r = rh * 8 + r8;
        const int ru = mi * 32 + (r & 3) + 8 * (r >> 2);
        if (RES) epi(ru, rl, col, acc[mi][0][r], acc[mi][1][r], x0[r8], x1[r8]);
        else epi(ru, rl, col, acc[mi][0][r], acc[mi][1][r], 0.f, 0.f);
        if ((r8 & 3) == 3) __builtin_amdgcn_sched_barrier(0);
      }
    }
  }
}
template <class Epi>
DEV void gemm_tile(const bf16_t* A0, int lda0, const bf16_t* A1, int lda1, int ksplit,
                   const bf16_t* Bt, int ldb, int K, char* smem, Epi epi) {
  gemm_tile_x<false>(A0, lda0, A1, lda1, ksplit, Bt, ldb, K, smem, nullptr,
                     [&](int ru, int rl, int c, float v0, float v1, float, float) { epi(ru, rl, c, v0, v1); });
}

DEV void wconv(const float* src, int ld, int K, int N, int mode, int coloff, bf16_t* dst, char* smem) {
  float* tile = (float*)smem;
  const int tid = threadIdx.x;
  const int nkt = K >> 6, nnt = N >> 5, nn4 = (nnt + 3) >> 2;
  for (int tl = blockIdx.x; tl < nkt * nn4; tl += gridDim.x) {
    const int kt = tl % nkt, n4 = tl / nkt;
    __syncthreads();
    {
      const int n = tid & 31, kk = tid >> 5;
      float v[4][8];
#pragma unroll
      for (int u = 0; u < 4; ++u) {
        int nt = n4 * 4 + u;
        if (nt >= nnt) nt = nnt - 1;
        const int cb = mode ? ((nt & 1) * DFF + (nt >> 1) * 32) : (coloff + nt * 32);
#pragma unroll
        for (int i = 0; i < 8; ++i) v[u][i] = src[(size_t)(kt * 64 + kk + 8 * i) * ld + cb + n];
      }
#pragma unroll
      for (int u = 0; u < 4; ++u)
#pragma unroll
        for (int i = 0; i < 8; ++i) tile[u * (64 * 33) + (kk + 8 * i) * 33 + n] = v[u][i];
    }
    __syncthreads();
    {
      const int k2 = tid & 31, nn = tid >> 5;
#pragma unroll
      for (int u = 0; u < 4; ++u) {
        const int nt = n4 * 4 + u;
        if (nt < nnt) {
#pragma unroll
          for (int i = 0; i < 4; ++i) {
            const int n = nn + 8 * i;
            const unsigned w = pack2(tile[u * (64 * 33) + (2 * k2) * 33 + n], tile[u * (64 * 33) + (2 * k2 + 1) * 33 + n]);
            *(unsigned*)(dst + (size_t)(nt * 32 + n) * K + kt * 64 + 2 * k2) = w;
          }
        }
      }
    }
  }
  __syncthreads();
}

DEV void ln_load(const float* src, float4 (&v)[4], int lane) {
#pragma unroll
  for (int i = 0; i < 4; ++i) v[i] = *(const float4*)(src + (i * 64 + lane) * 4);
}
DEV void ln_finish(float4 (&v)[4], float* dstf, bf16_t* dstb, const float* g, const float* b, int lane) {
  float s = 0.f;
#pragma unroll
  for (int i = 0; i < 4; ++i) s += v[i].x + v[i].y + v[i].z + v[i].w;
  const float mu = wave_sum_dpp(s) * (1.f / 1024.f);
  float q = 0.f;
#pragma unroll
  for (int i = 0; i < 4; ++i) {
    v[i].x -= mu; v[i].y -= mu; v[i].z -= mu; v[i].w -= mu;
    q += v[i].x * v[i].x + v[i].y * v[i].y + v[i].z * v[i].z + v[i].w * v[i].w;
  }
  const float rs = rsqrtf(wave_sum_dpp(q) * (1.f / 1024.f) + 1e-5f);
#pragma unroll
  for (int i = 0; i < 4; ++i) {
    const int c = (i * 64 + lane) * 4;
    const float4 gg = *(const float4*)(g + c), bb = *(const float4*)(b + c);
    float4 o;
    o.x = v[i].x * rs * gg.x + bb.x; o.y = v[i].y * rs * gg.y + bb.y;
    o.z = v[i].z * rs * gg.z + bb.z; o.w = v[i].w * rs * gg.w + bb.w;
    if (dstf) *(float4*)(dstf + c) = o;
    if (dstb) { uint2 u; u.x = pack2(o.x, o.y); u.y = pack2(o.z, o.w); *(uint2*)(dstb + c) = u; }
  }
}

DEV void phase_ln(const Params& p, const float* g, const float* b, bool write_xb, bool do_mem) {
  const int lane = threadIdx.x & 63;
  const int gw = blockIdx.x * 4 + (threadIdx.x >> 6), nw = gridDim.x * 4;
  bf16_t* xb = (bf16_t*)(p.ws + O_XB);
  for (int r = gw; r < NTOK; r += 2 * nw) {
    const int r2 = r + nw;
    float4 v0[4], v1[4];
    float* row0 = p.out + (size_t)r * DM;
    float* row1 = p.out + (size_t)(r2 < NTOK ? r2 : r) * DM;
    ln_load(row0, v0, lane);
    ln_load(row1, v1, lane);
    ln_finish(v0, row0, write_xb ? xb + (size_t)r * DM : nullptr, g, b, lane);
    if (r2 < NTOK) ln_finish(v1, row1, write_xb ? xb + (size_t)r2 * DM : nullptr, g, b, lane);
  }
  if (do_mem) {
    for (int m = gw; m < 3072; m += nw) {
      const float* src = m < 2048 ? p.in[2] + (size_t)m * DM : p.in[3] + (size_t)(m - 2048) * DM;
      float4 v0[4];
      ln_load(src, v0, lane);
      ln_finish(v0, nullptr, (bf16_t*)(p.ws + O_MEMB) + (size_t)m * DM, p.in[31], p.in[32], lane);
    }
  }
}

DEV bool tile_map(int it, int nct, int& rt, int& ct) {
  const int bpx = gridDim.x >> 3, xcd = blockIdx.x & 7, j = blockIdx.x >> 3;
  const int q = j + it * bpx;
  if (q >= 24 * nct) return false;
  const int band = q / (8 * nct), qq = q - band * 8 * nct;
  rt = xcd * 24 + band * 8 + (qq & 7);
  ct = qq >> 3;
  return true;
}

DEV void phase_ffn_in(const Params& p, const bf16_t* wt, char* smem) {
  const bf16_t* xb = (const bf16_t*)(p.ws + O_XB);
  bf16_t* h = (bf16_t*)(p.ws + O_H);
  const int nct = 44;
  int rt, ct;
  for (int it = 0; tile_map(it, nct, rt, ct); ++it) {
    bf16_t* hb = h + (size_t)rt * TM * DFF + ct * 64;
    gemm_tile(xb + (size_t)rt * TM * DM, DM, nullptr, 0, DM, wt + (size_t)ct * 128 * DM, DM, DM, smem,
              [&](int ru, int rl, int c, float v0, float v1) {
                (hb + ru * DFF)[(unsigned)(rl * DFF + (c >> 6) * 32 + (c & 31))] = f2bf(silu(v0) * v1);
              });
  }
}
DEV void phase_gemm_res(const Params& p, const bf16_t* A0, int lda0, const bf16_t* A1, int lda1, int ksplit, int K,
                        const bf16_t* wt, float scale, bool res_is_input, char* smem) {
  const int nct = 8;
  int rt, ct;
  for (int it = 0; tile_map(it, nct, rt, ct); ++it) {
    const int r0 = rt * TM, c0 = ct * 128;
    const bf16_t* a1 = A1 ? A1 + (size_t)r0 * lda1 : nullptr;
    const float* resb = (res_is_input ? xin_row(p, r0) : p.out + (size_t)r0 * DM) + c0;
    float* outb = p.out + (size_t)r0 * DM + c0;
    gemm_tile_x<true>(A0 + (size_t)r0 * lda0, lda0, a1, lda1, ksplit, wt + (size_t)c0 * K, K, K, smem, resb,
              [&](int ru, int rl, int c, float v0, float v1, float x0, float x1) {
                float* op = outb + ru * DM;
                const unsigned off = (unsigned)(rl * DM + c);
                op[off] = ALPHA * x0 + scale * v0;
                op[off + 32] = ALPHA * x1 + scale * v1;
              });
  }
}
DEV void phase_gemm_bf16(const bf16_t* A, int lda, const bf16_t* wt, int K, int N, bf16_t* out, int ldo, char* smem) {
  const int nct = (N + 127) >> 7;
  int rt, ct;
  for (int it = 0; tile_map(it, nct, rt, ct); ++it) {
    const int r0 = rt * TM, c0 = ct * 128;
    gemm_tile(A + (size_t)r0 * lda, lda, nullptr, 0, K, wt + (size_t)c0 * K, K, K, smem,
              [&](int ru, int rl, int c, float v0, float v1) {
                bf16_t* o = out + (size_t)(r0 + ru) * ldo + c0;
                const unsigned off = (unsigned)(rl * ldo + c);
                const int cc = c0 + c;
                if (cc < N) o[off] = f2bf(v0);
                if (cc + 32 < N) o[off + 32] = f2bf(v1);
              });
  }
}

constexpr int GL = 72;
struct GlaSmemM {
  bf16_t VT[128 * GL];
  bf16_t R1[128 * GL];
  bf16_t QB[64 * GL];
  bf16_t P[64 * GL];
  float gd[64 * 32];
  float tot[256];
  float blast[64];
};
static_assert(sizeof(GlaSmemM) <= 65536, "GlaSmemM too big");
constexpr int OBS = 132;

DEV int mfma_row(int r, int lane) { return (r & 3) + 8 * (r >> 2) + 4 * (lane >> 5); }
DEV void mma_k64(f32x16& acc, const bf16_t* sA, const bf16_t* sB, int lane) {
  const int o = (lane & 31) * GL + (lane >> 5) * 8;
#pragma unroll
  for (int ks = 0; ks < 4; ++ks) {
    const bf16x8 a = *(const bf16x8*)(sA + o + ks * 16);
    const bf16x8 b = *(const bf16x8*)(sB + o + ks * 16);
    acc = __builtin_amdgcn_mfma_f32_32x32x16_bf16(a, b, acc, 0, 0, 0);
  }
}
DEV void gla_load_vtg(const bf16_t* proj, int t0, int h, GlaSmemM* s) {
  const int tid = threadIdx.x;
#pragma unroll
  for (int i = 0; i < 4; ++i) {
    const int id = tid + 256 * i, c = id & 63, ec = id >> 6;
    const uint4 u = *(const uint4*)(proj + (size_t)(t0 + c) * GLA_LD + 512 + h * 128 + ec * 8);
    const unsigned w[4] = {u.x, u.y, u.z, u.w};
#pragma unroll
    for (int j = 0; j < 4; ++j) {
      s->VT[(ec * 8 + 2 * j) * GL + c] = (bf16_t)(w[j] & 0xffffu);
      s->VT[(ec * 8 + 2 * j + 1) * GL + c] = (bf16_t)(w[j] >> 16);
    }
  }
  {
    const int c = tid >> 2, part = tid & 3;
    const uint4 u = *(const uint4*)(proj + (size_t)(t0 + c) * GLA_LD + 1536 + part * 8);
    float v[8];
    unpack8(u, v);
#pragma unroll
    for (int j = 0; j < 8; ++j) s->gd[c * 32 + part * 8 + j] = v[j];
  }
}
DEV void gla_gates(const Params& p, int h, int dir, const float* gd, float* tot, float (&b)[16], float& bl) {
  const int tid = threadIdx.x, d = tid & 63, cq = tid >> 6;
  const float* up = dir ? p.in[11] : p.in[9];
  const float* gb = dir ? p.in[12] : p.in[10];
  float u[16];
#pragma unroll
  for (int m = 0; m < 16; ++m) u[m] = up[m * 256 + h * 64 + d];
  const float bias = gb[h * 64 + d];
#pragma unroll
  for (int i = 0; i < 16; ++i) {
    const int c = cq * 16 + i;
    float z = bias;
#pragma unroll
    for (int m4 = 0; m4 < 4; ++m4) {
      const float4 g4 = *(const float4*)(gd + c * 32 + dir * 16 + m4 * 4);
      z += g4.x * u[m4 * 4] + g4.y * u[m4 * 4 + 1] + g4.z * u[m4 * 4 + 2] + g4.w * u[m4 * 4 + 3];
    }
    b[i] = logsig(z) * (1.f / 16.f);
  }
  float run = 0.f;
  if (dir == 0) {
#pragma unroll
    for (int i = 0; i < 16; ++i) { run += b[i]; b[i] = run; }
  } else {
#pragma unroll
    for (int i = 15; i >= 0; --i) { run += b[i]; b[i] = run; }
  }
  tot[cq * 64 + d] = run;
  __syncthreads();
  const float t0 = tot[d], t1 = tot[64 + d], t2 = tot[128 + d], t3 = tot[192 + d];
  float off;
  if (dir == 0) off = (cq > 0 ? t0 : 0.f) + (cq > 1 ? t1 : 0.f) + (cq > 2 ? t2 : 0.f);
  else off = (cq < 3 ? t3 : 0.f) + (cq < 2 ? t2 : 0.f) + (cq < 1 ? t1 : 0.f);
#pragma unroll
  for (int i = 0; i < 16; ++i) b[i] += off;
  bl = (t0 + t1) + (t2 + t3);
}

DEV void phase_gla_a(const Params& p, char* smem) {
  GlaSmemM* s = (GlaSmemM*)smem;
  const bf16_t* proj = (const bf16_t*)(p.ws + O_H);
  float* kv = (float*)(p.ws + O_KV);
  float* dec = (float*)(p.ws + O_DEC);
  const int tid = threadIdx.x, lane = tid & 63, wv = tid >> 6;
  for (int item = blockIdx.x; item < 768 * 4; item += gridDim.x) {
    const int gch = item >> 2, h = item & 3, t0 = gch * 64;
    __syncthreads();
    gla_load_vtg(proj, t0, h, s);
    float kf[16];
    {
      const int d = tid & 63, cq = tid >> 6;
#pragma unroll
      for (int i = 0; i < 16; ++i) kf[i] = bf2f(proj[(size_t)(t0 + cq * 16 + i) * GLA_LD + 256 + h * 64 + d]);
    }
    __syncthreads();
    for (int dir = 0; dir < 2; ++dir) {
      float bb[16], bl;
      gla_gates(p, h, dir, s->gd, s->tot, bb, bl);
      {
        const int d = tid & 63, cq = tid >> 6;
        unsigned w[8];
#pragma unroll
        for (int i = 0; i < 8; ++i)
          w[i] = pack2(kf[2 * i] * __expf(bl - bb[2 * i]), kf[2 * i + 1] * __expf(bl - bb[2 * i + 1]));
        bf16_t* dst = s->R1 + d * GL + cq * 16;
        *(u32x4*)(dst) = (u32x4){w[0], w[1], w[2], w[3]};
        *(u32x4*)(dst + 8) = (u32x4){w[4], w[5], w[6], w[7]};
        if (cq == 0) s->blast[d] = bl;
      }
      __syncthreads();
      f32x16 acc[2];
#pragma unroll
      for (int j = 0; j < 2; ++j)
#pragma unroll
        for (int r = 0; r < 16; ++r) acc[j][r] = 0.f;
#pragma unroll
      for (int db = 0; db < 2; ++db) mma_k64(acc[db], s->VT + wv * 32 * GL, s->R1 + db * 32 * GL, lane);
      const size_t kvi = (size_t)item * 2 + dir;
      float* ob = kv + kvi * 8192;
#pragma unroll
      for (int db = 0; db < 2; ++db)
#pragma unroll
        for (int r = 0; r < 16; ++r) {
          const int e = wv * 32 + mfma_row(r, lane), d = db * 32 + (lane & 31);
          ob[e * 64 + d] = acc[db][r];
        }
      if (tid < 64) dec[kvi * 64 + tid] = __expf(s->blast[tid]);
      __syncthreads();
    }
  }
}

DEV void phase_gla_b(const Params& p) {
  float* kv = (float*)(p.ws + O_KV);
  const float* dec = (const float*)(p.ws + O_DEC);
  const int tid = threadIdx.x;
  for (int unit = blockIdx.x; unit < 96 * 32; unit += gridDim.x) {
    const int sid = unit >> 5, part = unit & 31;
    const int sq = sid >> 3, h = (sid >> 1) & 3, dir = sid & 1;
    int c0, nch;
    if (sq < 4) { c0 = 256 + sq * 128; nch = 128; }
    else { c0 = (sq - 4) * 32; nch = 32; }
    const int e = part * 256 + tid;
    float S = 0.f;
    for (int n0 = 0; n0 < nch; n0 += 8) {
      float tmp[8], dc[8];
#pragma unroll
      for (int u = 0; u < 8; ++u) {
        const int n = n0 + u;
        const int ci = dir ? (c0 + nch - 1 - n) : (c0 + n);
        const size_t idx = ((size_t)ci * 4 + h) * 2 + dir;
        tmp[u] = kv[idx * 8192 + e];
        dc[u] = dec[idx * 64 + (e & 63)];
      }
#pragma unroll
      for (int u = 0; u < 8; ++u) {
        const int n = n0 + u;
        const int ci = dir ? (c0 + nch - 1 - n) : (c0 + n);
        const size_t idx = ((size_t)ci * 4 + h) * 2 + dir;
        kv[idx * 8192 + e] = S;
        S = dc[u] * S + tmp[u];
      }
    }
  }
}

DEV void phase_gla_c(const Params& p, char* smem) {
  GlaSmemM* s = (GlaSmemM*)smem;
  const bf16_t* proj = (const bf16_t*)(p.ws + O_H);
  const float* kv = (const float*)(p.ws + O_KV);
  bf16_t* mixed = (bf16_t*)(p.ws + O_MIXG);
  const int tid = threadIdx.x, lane = tid & 63, wv = tid >> 6;
  const int cg_ = tid >> 4, eg = tid & 15;
  float* Ob = (float*)s->R1;
  static_assert(64 * OBS * 4 <= (128 + 64 + 64) * GL * 2, "output staging does not fit");
  for (int item = blockIdx.x; item < 768 * 4; item += gridDim.x) {
    const int gch = item >> 2, h = item & 3, t0 = gch * 64;
    __syncthreads();
    gla_load_vtg(proj, t0, h, s);
    float qf[16], kf[16];
    {
      const int d = tid & 63, cq = tid >> 6;
#pragma unroll
      for (int i = 0; i < 16; ++i) {
        const bf16_t* row = proj + (size_t)(t0 + cq * 16 + i) * GLA_LD + h * 64 + d;
        qf[i] = bf2f(row[0]) * 0.125f;
        kf[i] = bf2f(row[256]);
      }
    }
    __syncthreads();
    const int cb = wv & 1, eb0 = (wv >> 1) * 2;
    f32x16 acc[2];
#pragma unroll
    for (int j = 0; j < 2; ++j)
#pragma unroll
      for (int r = 0; r < 16; ++r) acc[j][r] = 0.f;
    for (int dir = 0; dir < 2; ++dir) {
      {
        float bb[16], bl;
        gla_gates(p, h, dir, s->gd, s->tot, bb, bl);
        const int d = tid & 63, cq = tid >> 6;
        const float bref = 0.5f * bl;
#pragma unroll
        for (int i = 0; i < 16; ++i) {
          const int c = cq * 16 + i;
          const float b = bb[i];
          const float q = qf[i];
          const float k = kf[i];
          s->R1[c * GL + d] = f2bf(q * __expf(b - bref));
          s->R1[(64 + c) * GL + d] = f2bf(k * __expf(bref - b));
          s->QB[c * GL + d] = f2bf(q * __expf(b));
        }
      }
      __syncthreads();
      {
        const int sb = wv >> 1, cbs = wv & 1;
        f32x16 sc;
#pragma unroll
        for (int r = 0; r < 16; ++r) sc[r] = 0.f;
        mma_k64(sc, s->R1 + (64 + sb * 32) * GL, s->R1 + cbs * 32 * GL, lane);
        const int c = cbs * 32 + (lane & 31);
#pragma unroll
        for (int g = 0; g < 4; ++g) {
          float v[4];
#pragma unroll
          for (int i = 0; i < 4; ++i) {
            const int sr = sb * 32 + 8 * g + 4 * (lane >> 5) + i;
            const bool keep = dir ? (sr >= c) : (sr <= c);
            v[i] = keep ? sc[4 * g + i] : 0.f;
          }
          uint2 w;
          w.x = pack2(v[0], v[1]);
          w.y = pack2(v[2], v[3]);
          *(uint2*)(s->P + c * GL + sb * 32 + 8 * g + 4 * (lane >> 5)) = w;
        }
      }
      const float* Sp = kv + ((size_t)item * 2 + dir) * 8192 + tid * 4;
      f32x4v sv[8];
#pragma unroll
      for (int i = 0; i < 8; ++i) sv[i] = *(const f32x4v*)(Sp + i * 1024);
      __syncthreads();
#pragma unroll
      for (int i = 0; i < 8; ++i) {
        const int el = (tid + 256 * i) * 4, e = el >> 6, d = el & 63;
        uint2 w;
        w.x = pack2(sv[i].x, sv[i].y);
        w.y = pack2(sv[i].z, sv[i].w);
        *(uint2*)(s->R1 + e * GL + d) = w;
      }
#pragma unroll
      for (int j = 0; j < 2; ++j) mma_k64(acc[j], s->P + cb * 32 * GL, s->VT + (eb0 + j) * 32 * GL, lane);
      __syncthreads();
#pragma unroll
      for (int j = 0; j < 2; ++j) mma_k64(acc[j], s->QB + cb * 32 * GL, s->R1 + (eb0 + j) * 32 * GL, lane);
      __syncthreads();
    }
#pragma unroll
    for (int j = 0; j < 2; ++j)
#pragma unroll
      for (int r = 0; r < 16; ++r) {
        const int c = cb * 32 + mfma_row(r, lane), e = (eb0 + j) * 32 + (lane & 31);
        Ob[c * OBS + e] = acc[j][r];
      }
    __syncthreads();
    float ng[8];
#pragma unroll
    for (int j = 0; j < 8; ++j) ng[j] = p.in[13][h * 128 + eg * 8 + j];
#pragma unroll
    for (int i = 0; i < 4; ++i) {
      const int cr = cg_ * 4 + i;
      const float4 o0 = *(const float4*)(Ob + cr * OBS + eg * 8), o1 = *(const float4*)(Ob + cr * OBS + eg * 8 + 4);
      const float o[8] = {o0.x, o0.y, o0.z, o0.w, o1.x, o1.y, o1.z, o1.w};
      float ss = 0.f;
#pragma unroll
      for (int j = 0; j < 8; ++j) ss += o[j] * o[j];
      ss = row16_sum(ss);
      const float rs = rsqrtf(ss * (1.f / 128.f) + 1e-5f);
      const int t = t0 + cr;
      float g[8];
      unpack8(*(const uint4*)(proj + (size_t)t * GLA_LD + 1024 + h * 128 + eg * 8), g);
      uint4 u;
      u.x = pack2(o[0] * rs * ng[0] * silu(g[0]), o[1] * rs * ng[1] * silu(g[1]));
      u.y = pack2(o[2] * rs * ng[2] * silu(g[2]), o[3] * rs * ng[3] * silu(g[3]));
      u.z = pack2(o[4] * rs * ng[4] * silu(g[4]), o[5] * rs * ng[5] * silu(g[5]));
      u.w = pack2(o[6] * rs * ng[6] * silu(g[6]), o[7] * rs * ng[7] * silu(g[7]));
      *(uint4*)(mixed + (size_t)t * 512 + h * 128 + eg * 8) = u;
    }
  }
}

DEV void phase_rw_act(const Params& p) {
  const bf16_t* proj = (const bf16_t*)(p.ws + O_H);
  bf16_t* awda = (bf16_t*)(p.ws + O_XB);
  bf16_t* ag = (bf16_t*)(p.ws + O_ACTG);
  const int total = NTOK * 160;
  const int stride = gridDim.x * 256;
  for (int base = blockIdx.x * 256 + threadIdx.x; base < total; base += 8 * stride) {
    unsigned x[8], pv[8], nx[8];
#pragma unroll
    for (int u = 0; u < 8; ++u) {
      int idx = base + u * stride;
      if (idx >= total) idx = base;
      const int t = idx / 160, cp = idx - t * 160;
      int tb, T;
      seq_of_token(t, tb, T);
      const bf16_t* ptr = proj + (size_t)t * RW_LD + 1536 + cp * 2;
      x[u] = *(const unsigned*)ptr;
      pv[u] = *(const unsigned*)(ptr + (t > tb ? -RW_LD : 0));
      nx[u] = *(const unsigned*)(ptr + (t < tb + T - 1 ? RW_LD : 0));
    }
#pragma unroll
    for (int u = 0; u < 8; ++u) {
      const int idx = base + u * stride;
      if (idx < total) {
        const int t = idx / 160, cp = idx - t * 160;
        int tb, T;
        seq_of_token(t, tb, T);
        const bool hp = t > tb, hn = t < tb + T - 1;
        const int rc = 1536 + cp * 2;
        float v[2];
#pragma unroll
        for (int e = 0; e < 2; ++e) {
          const float xx = e ? __uint_as_float(x[u] & 0xffff0000u) : __uint_as_float(x[u] << 16);
          const float pp = hp ? (e ? __uint_as_float(pv[u] & 0xffff0000u) : __uint_as_float(pv[u] << 16)) : 0.f;
          const float nn = hn ? (e ? __uint_as_float(nx[u] & 0xffff0000u) : __uint_as_float(nx[u] << 16)) : 0.f;
          v[e] = xx + p.in[14][rc + e] * (pp - xx) + p.in[15][rc + e] * (nn - xx);
        }
        const int col = cp * 2;
        if (col < 128) *(unsigned*)(awda + (size_t)t * 192 + col) = pack2(tanh_fast(v[0]), tanh_fast(v[1]));
        else if (col < 192) *(unsigned*)(awda + (size_t)t * 192 + col) = pack2(v[0], v[1]);
        else *(unsigned*)(ag + (size_t)t * 128 + (col - 192)) = pack2(sigm(v[0]), sigm(v[1]));
      }
    }
  }
}

DEV void phase_rw_lowrank(const Params& p, char* smem) {
  const bf16_t* awda = (const bf16_t*)(p.ws + O_XB);
  bf16_t* der = (bf16_t*)(p.ws + O_DER);
  int rt, ct12;
  for (int it = 0; tile_map(it, 12, rt, ct12); ++it) {
    const int which = ct12 >> 2, ct = ct12 & 3;
    const int r0 = rt * TM, c0 = ct * 128;
    const bf16_t* wt = (const bf16_t*)(p.ws + (which == 0 ? W_A_UPF : which == 1 ? W_A_UPB : W_A_AUP));
    const float* bias = which == 0 ? p.in[16] : which == 1 ? p.in[18] : p.in[20];
    bf16_t* out = der + (size_t)which * SLAB;
    gemm_tile(awda + (size_t)r0 * 192 + which * 64, 192, nullptr, 0, 64, wt + (size_t)c0 * 64, 64, 64, smem,
              [&](int ru, int rl, int c, float v0, float v1) {
                bf16_t* o = out + (size_t)(r0 + ru) * 512 + c0;
                const unsigned off = (unsigned)(rl * 512 + c);
                const float z0 = bias[c0 + c] + v0, z1 = bias[c0 + c + 32] + v1;
                if (which < 2) { o[off] = f2bf(-0.6065306597f * sigm(z0)); o[off + 32] = f2bf(-0.6065306597f * sigm(z1)); }
                else { o[off] = f2bf(sigm(z0)); o[off + 32] = f2bf(sigm(z1)); }
              });
  }
}

constexpr int SST = 388;
template <int RPL>
struct StepV { f32x4v w, nk, ka, k, r; float v[RPL]; float kar; };
template <int RPL>
DEV void step_load(StepV<RPL>& x, const float* sb, int jl, int rowbase) {
  x.w = *(const f32x4v*)(sb + jl * 4);
  x.nk = *(const f32x4v*)(sb + 64 + jl * 4);
  x.ka = *(const f32x4v*)(sb + 128 + jl * 4);
  x.k = *(const f32x4v*)(sb + 192 + jl * 4);
  x.r = *(const f32x4v*)(sb + 256 + jl * 4);
#pragma unroll
  for (int r = 0; r < RPL; ++r) x.v[r] = sb[320 + rowbase + r];
  x.kar = sb[384];
}

template <int RPL>
DEV void rwkv_scan(const Params& p, int tb, int T, int head, int dir, int split, float* st) {
  const int tid = threadIdx.x, lane = tid & 63, wv = tid >> 6;
  const int jl = lane & 15, ig = lane >> 4;
  const int hc = head * 64 + lane;
  float* ybuf = st + 2 * 16 * SST;
  const bf16_t* proj = (const bf16_t*)(p.ws + O_H);
  const bf16_t* ldp = (const bf16_t*)(p.ws + O_DER) + (size_t)dir * SLAB;
  const bf16_t* ap = (const bf16_t*)(p.ws + O_DER) + 2 * SLAB;
  bf16_t* yout = (bf16_t*)(p.ws + O_XB) + (size_t)dir * SLAB;
  const float* scal = (const float*)(p.ws + O_BONUS);
  const float mpr = p.in[14][hc], mnr = p.in[15][hc];
  const float mpk = p.in[14][512 + hc], mnk = p.in[15][512 + hc];
  const float mpv = p.in[14][1024 + hc], mnv = p.in[15][1024 + hc];
  const float kkw = p.in[23][hc], kaw = p.in[24][hc];
  const int rowl = wv * 4 * RPL + ig * RPL;
  const int rowbase = split * 16 * RPL + rowl;
  const int nch = T >> 4;
  const int ywoff = (jl == 0) ? rowl : (2 * 16 * 16 * RPL + rowl);
  f32x2 S01[RPL], S23[RPL];
#pragma unroll
  for (int r = 0; r < RPL; ++r) { S01[r] = (f32x2){0.f, 0.f}; S23[r] = (f32x2){0.f, 0.f}; }
  bf16_t rawA[4][11];
  float2 scA[4];

#define RW_LOAD(RAW, SC, CH)                                                            \
  _Pragma("unroll") for (int q = 0; q < 4; ++q) {                                       \
    const int tt_ = (CH) * 16 + wv * 4 + q;                                             \
    const int t_ = dir ? (T - 1 - tt_) : tt_;                                           \
    const bf16_t* row_ = proj + (size_t)(tb + t_) * RW_LD + hc;                         \
    const int op_ = t_ > 0 ? -RW_LD : 0, on_ = t_ < T - 1 ? RW_LD : 0;                  \
    _Pragma("unroll") for (int w = 0; w < 3; ++w) {                                     \
      RAW[q][w * 3 + 0] = row_[w * 512];                                                \
      RAW[q][w * 3 + 1] = row_[w * 512 + op_];                                          \
      RAW[q][w * 3 + 2] = row_[w * 512 + on_];                                          \
    }                                                                                   \
    RAW[q][9] = ldp[(size_t)(tb + t_) * 512 + hc];                                      \
    RAW[q][10] = ap[(size_t)(tb + t_) * 512 + hc];                                      \
    SC[q] = *(const float2*)(scal + ((size_t)(tb + t_) * 8 + head) * 4);                \
  }
#define RW_STAGE(RAW, SC, CH, BUF)                                                      \
  _Pragma("unroll") for (int q = 0; q < 4; ++q) {                                       \
    const int s_ = wv * 4 + q;                                                          \
    const int tt_ = (CH) * 16 + s_;                                                     \
    const int t_ = dir ? (T - 1 - tt_) : tt_;                                           \
    const bool hp_ = t_ > 0, hn_ = t_ < T - 1;                                          \
    float x_ = bf2f(RAW[q][0]);                                                         \
    const float r_ = x_ + mpr * ((hp_ ? bf2f(RAW[q][1]) : 0.f) - x_) + mnr * ((hn_ ? bf2f(RAW[q][2]) : 0.f) - x_);  \
    x_ = bf2f(RAW[q][3]);                                                               \
    const float kr_ = x_ + mpk * ((hp_ ? bf2f(RAW[q][4]) : 0.f) - x_) + mnk * ((hn_ ? bf2f(RAW[q][5]) : 0.f) - x_); \
    x_ = bf2f(RAW[q][6]);                                                               \
    const float v_ = x_ + mpv * ((hp_ ? bf2f(RAW[q][7]) : 0.f) - x_) + mnv * ((hn_ ? bf2f(RAW[q][8]) : 0.f) - x_);  \
    const float a_ = bf2f(RAW[q][10]);                                                  \
    const float kk_ = kr_ * kkw * SC[q].x;                                              \
    const float k2_ = kr_ * (1.f + (a_ - 1.f) * kaw);                                   \
    float* sb_ = st + (BUF) * (16 * SST) + s_ * SST;                                    \
    sb_[lane] = __expf(bf2f(RAW[q][9]));                                                \
    sb_[64 + lane] = -kk_;                                                              \
    sb_[128 + lane] = kk_ * a_;                                                         \
    sb_[192 + lane] = k2_;                                                              \
    sb_[256 + lane] = r_;                                                               \
    sb_[320 + lane] = v_;                                                               \
    if (lane == 0) sb_[384] = SC[q].y;                                                  \
  }
#define RW_MAIN(CH)                                                                     \
  {                                                                                     \
    const int buf = (CH) & 1;                                                           \
    const float* sbase = st + buf * (16 * SST);                                         \
    float* yb = ybuf + buf * (16 * 16 * RPL);                                           \
    StepV<RPL> cur, nxt;                                                                \
    step_load<RPL>(cur, sbase, jl, rowbase);                                            \
    _Pragma("unroll 8") for (int s = 0; s < 16; ++s) {                                  \
      step_load<RPL>(nxt, sbase + ((s + 1) & 15) * SST, jl, rowbase);                   \
      const f32x2 w01 = {cur.w.x, cur.w.y}, w23 = {cur.w.z, cur.w.w};                   \
      const f32x2 n01 = {cur.nk.x, cur.nk.y}, n23 = {cur.nk.z, cur.nk.w};               \
      const f32x2 a01 = {cur.ka.x, cur.ka.y}, a23 = {cur.ka.z, cur.ka.w};               \
      const f32x2 k01 = {cur.k.x, cur.k.y}, k23 = {cur.k.z, cur.k.w};                   \
      const f32x2 r01 = {cur.r.x, cur.r.y}, r23 = {cur.r.z, cur.r.w};                   \
      _Pragma("unroll") for (int r = 0; r < RPL; ++r) {                                 \
        f32x2 pz2 = S01[r] * n01;                                                       \
        pz2 = S23[r] * n23 + pz2;                                                       \
        float sa = pz2.x + pz2.y;                                                       \
        const f32x2 vv = {cur.v[r], cur.v[r]};                                          \
        f32x2 b01 = S01[r] * w01;                                                       \
        f32x2 b23 = S23[r] * w23;                                                       \
        b01 = vv * k01 + b01;                                                           \
        b23 = vv * k23 + b23;                                                           \
        f32x2 y2 = b01 * r01;                                                           \
        y2 = b23 * r23 + y2;                                                            \
        float yb_ = y2.x + y2.y;                                                        \
        row16_sum2(sa, yb_);                                                            \
        const f32x2 sa2 = {sa, sa};                                                     \
        S01[r] = sa2 * a01 + b01;                                                       \
        S23[r] = sa2 * a23 + b23;                                                       \
        const float y = yb_ + sa * cur.kar;                                             \
        yb[s * (16 * RPL) + ywoff + r] = y;                                             \
      }                                                                                 \
      cur = nxt;                                                                        \
    }                                                                                   \
  }
#define RW_FLUSH(CH)                                                                    \
  {                                                                                     \
    const float* yb = ybuf + ((CH) & 1) * (16 * 16 * RPL);                              \
    const int s = tid >> 4, rl = (tid & 15) * RPL;                                      \
    const int tt = (CH) * 16 + s;                                                       \
    const int t = dir ? (T - 1 - tt) : tt;                                              \
    bf16_t* yo = yout + (size_t)(tb + t) * 512 + head * 64 + split * 16 * RPL + rl;     \
    if (RPL == 1) yo[0] = f2bf(yb[s * 16 + rl]);                                        \
    else if (RPL == 2) *(unsigned*)yo = pack2(yb[s * 32 + rl], yb[s * 32 + rl + 1]);    \
    else { uint2 u; u.x = pack2(yb[s * 64 + rl], yb[s * 64 + rl + 1]); u.y = pack2(yb[s * 64 + rl + 2], yb[s * 64 + rl + 3]); *(uint2*)yo = u; } \
  }

  RW_LOAD(rawA, scA, 0);
  RW_STAGE(rawA, scA, 0, 0);
  __syncthreads();
  for (int ch = 0; ch < nch; ++ch) {
    if (ch + 1 < nch) { RW_LOAD(rawA, scA, ch + 1); }
    RW_MAIN(ch);
    if (ch + 1 < nch) { RW_STAGE(rawA, scA, ch + 1, (ch + 1) & 1); }
    __syncthreads();
    RW_FLUSH(ch);
  }
#undef RW_MAIN
#undef RW_FLUSH
#undef RW_LOAD
#undef RW_STAGE
}

DEV void phase_rw_pre(const Params& p) {
  const bf16_t* proj = (const bf16_t*)(p.ws + O_H);
  const bf16_t* ap = (const bf16_t*)(p.ws + O_DER) + 2 * SLAB;
  float* scal = (float*)(p.ws + O_BONUS);
  const int lane = threadIdx.x & 63;
  const int gw = blockIdx.x * 4 + (threadIdx.x >> 6), nw = gridDim.x * 4;
  for (int t = gw; t < NTOK; t += nw) {
    int tb, T;
    seq_of_token(t, tb, T);
    const bool hp = t > tb, hn = t < tb + T - 1;
    const int op = hp ? -RW_LD : 0, on = hn ? RW_LD : 0;
    const bf16_t* row = proj + (size_t)t * RW_LD + lane;
    bf16_t raw[8][7];
#pragma unroll
    for (int h = 0; h < 8; ++h) {
      raw[h][0] = row[h * 64];
      raw[h][1] = row[h * 64 + op];
      raw[h][2] = row[h * 64 + on];
      raw[h][3] = row[512 + h * 64];
      raw[h][4] = row[512 + h * 64 + op];
      raw[h][5] = row[512 + h * 64 + on];
      raw[h][6] = ap[(size_t)t * 512 + h * 64 + lane];
    }
#pragma unroll
    for (int h = 0; h < 8; ++h) {
      const int hc = h * 64 + lane;
      float x = bf2f(raw[h][0]);
      const float r = x + p.in[14][hc] * ((hp ? bf2f(raw[h][1]) : 0.f) - x) + p.in[15][hc] * ((hn ? bf2f(raw[h][2]) : 0.f) - x);
      x = bf2f(raw[h][3]);
      const float kr = x + p.in[14][512 + hc] * ((hp ? bf2f(raw[h][4]) : 0.f) - x) + p.in[15][512 + hc] * ((hn ? bf2f(raw[h][5]) : 0.f) - x);
      const float a = bf2f(raw[h][6]);
      const float kkr = kr * p.in[23][hc];
      const float inv = rsqrtf(fmaxf(wave_sum_dpp(kkr * kkr), 1e-24f));
      const float kk = kkr * inv;
      const float k2 = kr * (1.f + (a - 1.f) * p.in[24][hc]);
      const float kar = wave_sum_dpp(kk * a * r);
      const float bo = wave_sum_dpp(r * k2 * p.in[25][hc]);
      if (lane == 0) *(float4*)(scal + ((size_t)t * 8 + h) * 4) = make_float4(inv, kar, bo, 0.f);
    }
  }
}

DEV void phase_rw_scan(const Params& p, char* smem) {
  float* st = (float*)smem;
  for (int item = blockIdx.x; item < 512; item += gridDim.x) {
    __syncthreads();
    if (item < 256) {
      const int scan = item >> 2, split = item & 3;
      const int sq = scan >> 4, head = (scan >> 1) & 7, dir = scan & 1;
      __builtin_amdgcn_s_setprio(3);
      rwkv_scan<1>(p, NPROMPT + sq * 8192, 8192, head, dir, split, st);
      __builtin_amdgcn_s_setprio(0);
    } else {
      const int it = item - 256;
      const int scan = it >> 1, split = it & 1;
      const int sq = scan >> 4, head = (scan >> 1) & 7, dir = scan & 1;
      rwkv_scan<2>(p, sq * 2048, 2048, head, dir, split, st);
    }
  }
}

DEV void phase_rw_post(const Params& p) {
  const bf16_t* proj = (const bf16_t*)(p.ws + O_H);
  bf16_t* yf = (bf16_t*)(p.ws + O_XB);
  const bf16_t* yb = yf + SLAB;
  const bf16_t* gate = (const bf16_t*)(p.ws + O_DER) + 2 * SLAB;
  const float* scal = (const float*)(p.ws + O_BONUS);
  const int lane = threadIdx.x & 63;
  const int gw = blockIdx.x * 4 + (threadIdx.x >> 6), nw = gridDim.x * 4;
  for (int t = gw; t < NTOK; t += nw) {
    int tb, T;
    seq_of_token(t, tb, T);
    const bool hp = t > tb, hn = t < tb + T - 1;
    const int op = hp ? -RW_LD : 0, on = hn ? RW_LD : 0;
    const bf16_t* vrow = proj + (size_t)t * RW_LD + 1024 + lane;
    bf16_t raw[8][6];
    float bo[8];
#pragma unroll
    for (int h = 0; h < 8; ++h) {
      const size_t o = (size_t)t * 512 + h * 64 + lane;
      raw[h][0] = yf[o];
      raw[h][1] = yb[o];
      raw[h][2] = vrow[h * 64];
      raw[h][3] = vrow[h * 64 + op];
      raw[h][4] = vrow[h * 64 + on];
      raw[h][5] = gate[o];
      bo[h] = scal[((size_t)t * 8 + h) * 4 + 2];
    }
    bf16_t res[8];
#pragma unroll
    for (int h = 0; h < 8; ++h) {
      const int hc = h * 64 + lane;
      const float y = bf2f(raw[h][0]) + bf2f(raw[h][1]);
      const float mu = wave_sum_dpp(y) * (1.f / 64.f);
      const float dy = y - mu;
      const float var = wave_sum_dpp(dy * dy) * (1.f / 64.f);
      const float yn = dy * rsqrtf(var + 64e-5f) * p.in[26][hc] + p.in[27][hc];
      const float x = bf2f(raw[h][2]);
      const float v = x + p.in[14][1024 + hc] * ((hp ? bf2f(raw[h][3]) : 0.f) - x) + p.in[15][1024 + hc] * ((hn ? bf2f(raw[h][4]) : 0.f) - x);
      res[h] = f2bf((yn + bo[h] * v) * bf2f(raw[h][5]));
    }
#pragma unroll
    for (int h = 0; h < 8; ++h) yf[(size_t)t * 512 + h * 64 + lane] = res[h];
  }
}

DEV int seq_of_rowtile(int rt) { return rt < 64 ? (rt >> 3) : 8 + ((rt - 64) >> 5); }

DEV void phase_ca_qkv(const Params& p, char* smem) {
  const bf16_t* xb = (const bf16_t*)(p.ws + O_XB);
  bf16_t* qb = (bf16_t*)(p.ws + O_H);
  const bf16_t* memb = (const bf16_t*)(p.ws + O_MEMB);
  bf16_t* kb = (bf16_t*)(p.ws + O_KB);
  bf16_t* vt = (bf16_t*)(p.ws + O_VT);
  const bf16_t* wq = (const bf16_t*)(p.ws + W_B_Q);
  const bf16_t* wkv = (const bf16_t*)(p.ws + W_B_KV);
  {
    int rt, ct;
    for (int it = 0; tile_map(it, 8, rt, ct); ++it) {
      const int r0 = rt * TM, c0 = ct * 128;
      gemm_tile(xb + (size_t)r0 * DM, DM, nullptr, 0, DM, wq + (size_t)c0 * DM, DM, DM, smem,
                [&](int ru, int rl, int c, float v0, float v1) {
                  bf16_t* o = qb + (size_t)(r0 + ru) * DM + c0;
                  const unsigned off = (unsigned)(rl * DM + c);
                  o[off] = f2bf(v0); o[off + 32] = f2bf(v1);
                });
    }
  }
  {
    for (int t2 = blockIdx.x; t2 < 12 * 16; t2 += gridDim.x) {
      const int rt = t2 >> 4, ct = t2 & 15;
      const int r0 = rt * TM, c0 = ct * 128;
      if (ct < 8) {
        bf16_t* o = kb + (size_t)r0 * DM + c0;
        gemm_tile(memb + (size_t)r0 * DM, DM, nullptr, 0, DM, wkv + (size_t)c0 * DM, DM, DM, smem,
                  [&](int ru, int rl, int c, float v0, float v1) {
                    const unsigned off = (unsigned)(rl * DM + c);
                    (o + ru * DM)[off] = f2bf(v0);
                    (o + ru * DM)[off + 32] = f2bf(v1);
                  });
      } else {
        bf16_t* o = vt + ((size_t)rt * 1024 + (c0 - 1024)) * 256;
        gemm_tile(memb + (size_t)r0 * DM, DM, nullptr, 0, DM, wkv + (size_t)c0 * DM, DM, DM, smem,
                  [&](int ru, int rl, int c, float v0, float v1) {
                    const unsigned off = (unsigned)(c * 256 + rl);
                    (o + ru)[off] = f2bf(v0);
                    (o + ru)[off + 32 * 256] = f2bf(v1);
                  });
      }
    }
  }
}
DEV void phase_ca_scores(const Params& p, char* smem) {
  const bf16_t* qb = (const bf16_t*)(p.ws + O_H);
  const bf16_t* kb = (const bf16_t*)(p.ws + O_KB);
  float* sc = (float*)(p.ws + O_SCORES);
  int rt, ct8;
  for (int it = 0; tile_map(it, 8, rt, ct8); ++it) {
    const int h = ct8 >> 1, nt = ct8 & 1;
    const int b = seq_of_rowtile(rt), r0 = rt * TM;
    gemm_tile(qb + (size_t)r0 * DM + h * 256, DM, nullptr, 0, 256,
              kb + (size_t)(b * 256 + nt * 128) * DM + h * 256, DM, 256, smem,
              [&](int ru, int rl, int c, float v0, float v1) {
                float* o = sc + (size_t)(r0 + ru) * DM + h * 256 + nt * 128;
                const unsigned off = (unsigned)(rl * DM + c);
                o[off] = v0 * 0.0625f; o[off + 32] = v1 * 0.0625f;
              });
  }
}
DEV void phase_ca_softmax(const Params& p) {
  const float* sc = (const float*)(p.ws + O_SCORES);
  bf16_t* pb = (bf16_t*)(p.ws + O_H);
  const int lane = threadIdx.x & 63;
  const int gw = blockIdx.x * 4 + (threadIdx.x >> 6), nw = gridDim.x * 4;
  const int total = NTOK * 4;
  for (int it = gw; it < total; it += 4 * nw) {
    float4 v[4];
#pragma unroll
    for (int u = 0; u < 4; ++u) {
      const int i2 = it + u * nw;
      v[u] = *(const float4*)(sc + (size_t)(i2 < total ? i2 : it) * 256 + lane * 4);
    }
#pragma unroll
    for (int u = 0; u < 4; ++u) {
      const int i2 = it + u * nw;
      float mx = fmaxf(fmaxf(v[u].x, v[u].y), fmaxf(v[u].z, v[u].w));
      mx = fmaxf(mx, dppf<0x128>(mx)); mx = fmaxf(mx, dppf<0x124>(mx)); mx = fmaxf(mx, dppf<0x122>(mx)); mx = fmaxf(mx, dppf<0x121>(mx));
      {
        const int xi = __builtin_bit_cast(int, mx);
        const float m0 = __builtin_bit_cast(float, __builtin_amdgcn_readlane(xi, 0));
        const float m1 = __builtin_bit_cast(float, __builtin_amdgcn_readlane(xi, 16));
        const float m2 = __builtin_bit_cast(float, __builtin_amdgcn_readlane(xi, 32));
        const float m3 = __builtin_bit_cast(float, __builtin_amdgcn_readlane(xi, 48));
        mx = fmaxf(fmaxf(m0, m1), fmaxf(m2, m3));
      }
      const float e0 = __expf(v[u].x - mx), e1 = __expf(v[u].y - mx), e2 = __expf(v[u].z - mx), e3 = __expf(v[u].w - mx);
      const float inv = 1.f / wave_sum_dpp(e0 + e1 + e2 + e3);
      if (i2 < total) {
        uint2 w;
        w.x = pack2(e0 * inv, e1 * inv);
        w.y = pack2(e2 * inv, e3 * inv);
        *(uint2*)(pb + (size_t)i2 * 256 + lane * 4) = w;
      }
    }
  }
}
DEV void phase_ca_pv(const Params& p, char* smem) {
  const bf16_t* pb = (const bf16_t*)(p.ws + O_H);
  const bf16_t* vt = (const bf16_t*)(p.ws + O_VT);
  bf16_t* attn = (bf16_t*)(p.ws + O_XB);
  int rt, ct8;
  for (int it = 0; tile_map(it, 8, rt, ct8); ++it) {
    const int h = ct8 >> 1, nt = ct8 & 1;
    const int b = seq_of_rowtile(rt), r0 = rt * TM;
    gemm_tile(pb + (size_t)r0 * DM + h * 256, DM, nullptr, 0, 256,
              vt + ((size_t)b * 1024 + h * 256 + nt * 128) * 256, 256, 256, smem,
              [&](int ru, int rl, int c, float v0, float v1) {
                bf16_t* o = attn + (size_t)(r0 + ru) * DM + h * 256 + nt * 128;
                const unsigned off = (unsigned)(rl * DM + c);
                o[off] = f2bf(v0); o[off + 32] = f2bf(v1);
              });
  }
}

DEV void phase_convert_x(const Params& p) {
  bf16_t* xb = (bf16_t*)(p.ws + O_XB);
  const size_t n4 = (size_t)NTOK * DM / 4;
  const size_t np4 = (size_t)NPROMPT * DM / 4;
  const size_t stride = (size_t)gridDim.x * 256;
  for (size_t i = (size_t)blockIdx.x * 256 + threadIdx.x; i < n4; i += 8 * stride) {
    float4 v[8];
#pragma unroll
    for (int u = 0; u < 8; ++u) {
      size_t j = i + u * stride;
      if (j >= n4) j = i;
      v[u] = j < np4 ? ((const float4*)p.in[0])[j] : ((const float4*)p.in[1])[j - np4];
    }
#pragma unroll
    for (int u = 0; u < 8; ++u) {
      const size_t j = i + u * stride;
      if (j < n4) {
        uint2 w;
        w.x = pack2(v[u].x, v[u].y);
        w.y = pack2(v[u].z, v[u].w);
        ((uint2*)xb)[j] = w;
      }
    }
  }
}

constexpr int NPHASE = 25;
constexpr int SMEM_BYTES = 64 * 1024;

DEV void run_phase(const Params& p, int ph, char* smem) {
  char* ws = p.ws;
    switch (ph) {
      case 0:
        wconv(p.in[4], 2 * DFF, DM, 2 * DFF, 1, 0, (bf16_t*)(ws + W_A_FFN_IN), smem);
        wconv(p.in[5], DM, DFF, DM, 0, 0, (bf16_t*)(ws + W_A_FFN_OUT), smem);
        wconv(p.in[8], 3424, DM, 1568, 0, 0, (bf16_t*)(ws + W_A_MIX_IN), smem);
        wconv(p.in[8], 3424, DM, 1856, 0, 1568, (bf16_t*)(ws + W_A_MIX_IN) + (size_t)1664 * DM, smem);
        wconv(p.in[17], 512, 64, 512, 0, 0, (bf16_t*)(ws + W_A_UPF), smem);
        wconv(p.in[19], 512, 64, 512, 0, 0, (bf16_t*)(ws + W_A_UPB), smem);
        wconv(p.in[21], 512, 64, 512, 0, 0, (bf16_t*)(ws + W_A_AUP), smem);
        wconv(p.in[22], 512, 128, 512, 0, 0, (bf16_t*)(ws + W_A_GUP), smem);
        phase_convert_x(p);
        break;
      case 1: phase_ffn_in(p, (const bf16_t*)(ws + W_A_FFN_IN), smem); break;
      case 2: phase_gemm_res(p, (const bf16_t*)(ws + O_H), DFF, nullptr, 0, DFF, DFF, (const bf16_t*)(ws + W_A_FFN_OUT), 0.5f, true, smem); break;
      case 3: phase_ln(p, p.in[6], p.in[7], true, false); break;
      case 4: phase_gemm_bf16((const bf16_t*)(ws + O_XB), DM, (const bf16_t*)(ws + W_A_MIX_IN), DM, 1568, (bf16_t*)(ws + O_H), GLA_LD, smem); break;
      case 5: phase_gla_a(p, smem); break;
      case 6: phase_gla_b(p); break;
      case 7: phase_gla_c(p, smem); break;
      case 8: phase_gemm_bf16((const bf16_t*)(ws + O_XB), DM, (const bf16_t*)(ws + W_A_MIX_IN) + (size_t)1664 * DM, DM, 1856, (bf16_t*)(ws + O_H), RW_LD, smem); break;
      case 9: phase_rw_act(p); break;
      case 10: phase_rw_lowrank(p, smem); break;
      case 11: phase_rw_pre(p); break;
      case 12: phase_rw_scan(p, smem); break;
      case 13: phase_gemm_bf16((const bf16_t*)(ws + O_ACTG), 128, (const bf16_t*)(ws + W_A_GUP), 128, 512, (bf16_t*)(ws + O_DER) + 2 * SLAB, 512, smem); break;
      case 14:
        phase_rw_post(p);
        wconv(p.in[28], DM, DM, DM, 0, 0, (bf16_t*)(ws + W_B_MIX_OUT), smem);
        wconv(p.in[33], DM, DM, DM, 0, 0, (bf16_t*)(ws + W_B_Q), smem);
        wconv(p.in[34], 2 * DM, DM, 2 * DM, 0, 0, (bf16_t*)(ws + W_B_KV), smem);
        wconv(p.in[35], DM, DM, DM, 0, 0, (bf16_t*)(ws + W_B_O), smem);
        wconv(p.in[38], 2 * DFF, DM, 2 * DFF, 1, 0, (bf16_t*)(ws + W_B_FFN_IN), smem);
        wconv(p.in[39], DM, DFF, DM, 0, 0, (bf16_t*)(ws + W_B_FFN_OUT), smem);
        break;
      case 15: phase_gemm_res(p, (const bf16_t*)(ws + O_MIXG), 512, (const bf16_t*)(ws + O_XB), 512, 512, DM, (const bf16_t*)(ws + W_B_MIX_OUT), 1.0f, false, smem); break;
      case 16: phase_ln(p, p.in[29], p.in[30], true, true); break;
      case 17: phase_ca_qkv(p, smem); break;
      case 18: phase_ca_scores(p, smem); break;
      case 19: phase_ca_softmax(p); break;
      case 20: phase_ca_pv(p, smem); break;
      case 21: phase_gemm_res(p, (const bf16_t*)(ws + O_XB), DM, nullptr, 0, DM, DM, (const bf16_t*)(ws + W_B_O), 1.0f, false, smem); break;
      case 22: phase_ln(p, p.in[36], p.in[37], true, false); break;
      case 23: phase_ffn_in(p, (const bf16_t*)(ws + W_B_FFN_IN), smem); break;
      case 24: phase_gemm_res(p, (const bf16_t*)(ws + O_H), DFF, nullptr, 0, DFF, DFF, (const bf16_t*)(ws + W_B_FFN_OUT), 0.5f, false, smem); break;
      case 25: phase_ln(p, p.in[40], p.in[41], false, false); break;
      default: break;
    }
}

constexpr size_t O_BAR = 463 * MiB + 768 * 1024;
#define XB_TMO      128
#define XB_XCNT(j)  (256  + 64 * (j))
#define XB_XSUB(j)  (1280 + 64 * (j))
#define XB_XGEN(j)  (2304 + 64 * (j))
#define XB_TOP      3328
#define XB_TOPGEN   3392
#define XCD_BAR_WORDS 3456
#define XB_SPIN_CAP (1u << 18)
#define LAS __attribute__((address_space(3)))

__device__ __forceinline__ unsigned xb_ld(unsigned* p)              { return __hip_atomic_load(p, __ATOMIC_RELAXED, __HIP_MEMORY_SCOPE_AGENT); }
__device__ __forceinline__ unsigned xb_add(unsigned* p, unsigned v) { return __hip_atomic_fetch_add(p, v, __ATOMIC_RELAXED, __HIP_MEMORY_SCOPE_AGENT); }
__device__ __forceinline__ unsigned xb_xcc_id() { return (unsigned)__builtin_amdgcn_s_getreg((3 << 11) | 20) & 0xFu; }
#define XB_SPIN(cond, bar) do { unsigned _sp = 0; while (cond) { __builtin_amdgcn_s_sleep(1); \
    if ((++_sp & 255u) == 0u) { if (xb_ld(&(bar)[XB_TMO])) break; if (_sp > XB_SPIN_CAP) { atomicAdd(&(bar)[XB_TMO], 1u); break; } } } } while (0)

struct XcdBarrier {
    unsigned* bar; unsigned x;
    volatile LAS unsigned* st;
};

__device__ __forceinline__ XcdBarrier xcd_barrier_post(unsigned* bar, volatile LAS unsigned* st) {
    XcdBarrier b; b.bar = bar; b.x = xb_xcc_id(); b.st = st;
    if (threadIdx.x == 0) (void)xb_add(&bar[XB_XCNT(b.x)], 1u);
    return b;
}
__device__ __forceinline__ void xcd_barrier_complete(unsigned* bar, unsigned x, unsigned& nloc, unsigned& nx) {
    const unsigned G = gridDim.x * gridDim.y * gridDim.z;
    unsigned sum, cnt, mine, sp = 0u;
    for (;;) {
        sum = 0u; cnt = 0u; mine = 0u;
#pragma unroll
        for (unsigned j = 0; j < 16; ++j) { const unsigned c = xb_ld(&bar[XB_XCNT(j)]); sum += c; cnt += (c > 0u) ? 1u : 0u; mine = (j == x) ? c : mine; }
        if (sum == G) break;
        __builtin_amdgcn_s_sleep(1);
        if ((++sp & 255u) == 0u) { if (xb_ld(&bar[XB_TMO])) break; if (sp > XB_SPIN_CAP) { atomicAdd(&bar[XB_TMO], 1u); break; } }
    }
    nloc = mine > 0u ? mine : 1u; nx = cnt > 0u ? cnt : 1u;
}

__device__ __forceinline__ void xcd_barrier(const XcdBarrier& b) {
    asm volatile("s_waitcnt vmcnt(0)" ::: "memory");
    __syncthreads();
    if (threadIdx.x == 0) {
        unsigned* bar = b.bar;
        __builtin_amdgcn_s_waitcnt(0);
        unsigned nloc = b.st[0], nx = b.st[1];
        if (nloc == 0u) { xcd_barrier_complete(bar, b.x, nloc, nx); b.st[0] = nloc; b.st[1] = nx; }
        const unsigned old = xb_add(&bar[XB_XSUB(b.x)], 1u);
        const unsigned gen = old / nloc;
        if (old + 1u == (gen + 1u) * nloc) {
            __builtin_amdgcn_fence(__ATOMIC_RELEASE, "agent");
            asm volatile("s_waitcnt vmcnt(0)" ::: "memory");
            const unsigned og = xb_add(&bar[XB_TOP], 1u);
            const unsigned tg = og / nx;
            if (og + 1u == (tg + 1u) * nx) xb_add(&bar[XB_TOPGEN], 1u);
            else XB_SPIN(xb_ld(&bar[XB_TOPGEN]) == tg, bar);
            __builtin_amdgcn_fence(__ATOMIC_ACQUIRE, "agent");
            xb_add(&bar[XB_XGEN(b.x)], 1u);
            asm volatile("s_waitcnt vmcnt(0)" ::: "memory");
        } else {
            XB_SPIN(xb_ld(&bar[XB_XGEN(b.x)]) == gen, bar);
            __builtin_amdgcn_fence(__ATOMIC_ACQUIRE, "agent");
            asm volatile("s_waitcnt vmcnt(0)" ::: "memory");
        }
    }
    __syncthreads();
}

#define PHASE_STEP(N) if (ph_lo <= N && N < ph_hi) { for (int rep = 0; rep <= (int)((dup >> N) & 1u); ++rep) { run_phase(p, N, smem); if (N + 1 < ph_hi) { if (ph_lo < 0) grid.sync(); else { XcdBarrier xb_; xb_.bar = (unsigned*)(p.ws + O_BAR); xb_.st = (volatile LAS unsigned*)&xb_words; xb_.x = xb_.st[2]; xcd_barrier(xb_); } } } }
__global__ void __launch_bounds__(256, 2) mega(Params p, int ph_lo, int ph_hi, unsigned dup) {
  __shared__ __attribute__((aligned(16))) char smem[SMEM_BYTES];
  cg::grid_group grid = cg::this_grid();
  __shared__ uint4 xb_words;
  if (threadIdx.x == 0) xb_words = make_uint4(0u, 0u, 0u, 0u);
  __syncthreads();
  if (ph_hi - ph_lo > 1) {
    XcdBarrier xb = xcd_barrier_post((unsigned*)(p.ws + O_BAR), (volatile LAS unsigned*)&xb_words);
    if (threadIdx.x == 0) xb_words.z = xb.x;
    __syncthreads();
  }
  PHASE_STEP(0)
  PHASE_STEP(1)
  PHASE_STEP(2)
  PHASE_STEP(3)
  PHASE_STEP(4)
  PHASE_STEP(5)
  PHASE_STEP(6)
  PHASE_STEP(7)
  PHASE_STEP(8)
  PHASE_STEP(9)
  PHASE_STEP(10)
  PHASE_STEP(11)
  PHASE_STEP(12)
  PHASE_STEP(13)
  PHASE_STEP(14)
  PHASE_STEP(15)
  PHASE_STEP(16)
  PHASE_STEP(17)
  PHASE_STEP(18)
  PHASE_STEP(19)
  PHASE_STEP(20)
  PHASE_STEP(21)
  PHASE_STEP(22)
  PHASE_STEP(23)
  PHASE_STEP(24)
  PHASE_STEP(25)
}

#ifdef PHASE_TEST
template <int PH> __global__ void __launch_bounds__(256, 2) mega_t(Params p) {
  __shared__ __attribute__((aligned(16))) char smem[SMEM_BYTES];
  run_phase(p, PH, smem);
}
template __global__ void mega_t<0>(Params);
template __global__ void mega_t<1>(Params);
template __global__ void mega_t<2>(Params);
template __global__ void mega_t<3>(Params);
template __global__ void mega_t<4>(Params);
template __global__ void mega_t<5>(Params);
template __global__ void mega_t<6>(Params);
template __global__ void mega_t<7>(Params);
template __global__ void mega_t<8>(Params);
template __global__ void mega_t<9>(Params);
template __global__ void mega_t<10>(Params);
template __global__ void mega_t<11>(Params);
template __global__ void mega_t<12>(Params);
template __global__ void mega_t<13>(Params);
template __global__ void mega_t<14>(Params);
template __global__ void mega_t<15>(Params);
template __global__ void mega_t<16>(Params);
template __global__ void mega_t<17>(Params);
template __global__ void mega_t<18>(Params);
template __global__ void mega_t<19>(Params);
template __global__ void mega_t<20>(Params);
template __global__ void mega_t<21>(Params);
template __global__ void mega_t<22>(Params);
template __global__ void mega_t<23>(Params);
template __global__ void mega_t<24>(Params);
template __global__ void mega_t<25>(Params);
#endif

extern "C" void kernel_launch(void* const* d_in, const int* in_sizes, int n_in, void* d_out, int out_size,
                              void* d_ws, size_t ws_size, hipStream_t stream) {
  if (ws_size < WS_NEED || n_in < 42) {
    fprintf(stderr, "kernel_launch: workspace too small (%zu) or inputs missing (%d)\n", ws_size, n_in);
    return;
  }
  static int grid_blocks = 0;
  if (!grid_blocks) {
    int dev = 0, cus = 0, per_cu = 0;
    hipGetDevice(&dev);
    hipDeviceGetAttribute(&cus, hipDeviceAttributeMultiprocessorCount, dev);
    hipOccupancyMaxActiveBlocksPerMultiprocessor(&per_cu, mega, 256, 0);
    if (per_cu > 2) per_cu = 2;
    if (per_cu < 1) per_cu = 1;
    grid_blocks = cus * per_cu;
  }
  Params p{};
  for (int i = 0; i < 42; ++i) p.in[i] = (const float*)d_in[i];
  p.out = (float*)d_out;
  p.ws = (char*)d_ws;
  const int nph = NPHASE + 1;
#if MULTI_LAUNCH
  for (int ph = 0; ph < nph; ++ph) {
    hipLaunchKernelGGL(mega, dim3(grid_blocks), dim3(256), 0, stream, p, ph, ph + 1, 0u);
  }
#else
#ifndef PROBE_DUP
#define PROBE_DUP 0u
#endif
  hipMemsetAsync((char*)d_ws + O_BAR, 0, XCD_BAR_WORDS * 4, stream);
  int lo = 0, hi = nph;
  unsigned dup = PROBE_DUP;
  void* args[] = {&p, &lo, &hi, &dup};
  hipError_t e = hipLaunchCooperativeKernel((void*)mega, dim3(grid_blocks), dim3(256), args, 0, stream);
  if (e != hipSuccess) fprintf(stderr, "cooperative launch failed: %s (grid %d)\n", hipGetErrorString(e), grid_blocks);
#endif
}
```

```cpp
#include <hip/hip_runtime.h>
#include <hip/hip_bf16.h>
#include <hip/hip_cooperative_groups.h>
#include <cstdio>
namespace cg = cooperative_groups;

#ifndef MULTI_LAUNCH
#define MULTI_LAUNCH 0
#endif

typedef unsigned short bf16_t;
using bf16x8 = __attribute__((ext_vector_type(8))) short;
using f32x16 = __attribute__((ext_vector_type(16))) float;
using u32x4 = __attribute__((ext_vector_type(4))) unsigned;
using f32x2 = __attribute__((ext_vector_type(2))) float;
using f32x4v = __attribute__((ext_vector_type(4))) float;

#define DEV __device__ __forceinline__

constexpr int NTOK = 49152;
constexpr int NPROMPT = 16384;
constexpr int DM = 1024;
constexpr int DFF = 2816;
constexpr int GLA_LD = 1568;
constexpr int RW_LD = 1856;
constexpr float ALPHA = 1.189207115002721f;
constexpr size_t MiB = 1ull << 20;
constexpr size_t SLAB = (size_t)NTOK * 512;

constexpr size_t W_A_FFN_IN = 0, W_A_FFN_OUT = 11 * MiB, W_A_MIX_IN = 17 * MiB, W_A_UPF = 24 * MiB,
                 W_A_UPB = 24 * MiB + 65536, W_A_AUP = 24 * MiB + 2 * 65536, W_A_GUP = 24 * MiB + 3 * 65536;
constexpr size_t W_B_MIX_OUT = 0, W_B_Q = 2 * MiB, W_B_KV = 4 * MiB, W_B_O = 8 * MiB, W_B_FFN_IN = 10 * MiB, W_B_FFN_OUT = 21 * MiB;
constexpr size_t O_XB = 27 * MiB;
constexpr size_t O_H = 123 * MiB;
constexpr size_t O_KV = 270 * MiB;
constexpr size_t O_DEC = 462 * MiB;
constexpr size_t O_DER = 297 * MiB;
constexpr size_t O_ACTG = 441 * MiB;
constexpr size_t O_BONUS = 453 * MiB;
constexpr size_t O_MIXG = 464 * MiB;
constexpr size_t O_MEMB = 219 * MiB, O_KB = 225 * MiB, O_VT = 231 * MiB, O_SCORES = 237 * MiB;
constexpr size_t WS_NEED = 512 * MiB;

struct Params {
  const float* in[42];
  float* out;
  char* ws;
};

DEV bf16_t f2bf(float f) { return __builtin_bit_cast(bf16_t, (__bf16)f); }
DEV float bf2f(bf16_t b) { return __uint_as_float(((unsigned)b) << 16); }
typedef __bf16 nbf2_t __attribute__((ext_vector_type(2)));
typedef float nf2_t __attribute__((ext_vector_type(2)));
DEV unsigned pack2(float a, float b) {
  const nf2_t v = {a, b};
  return __builtin_bit_cast(unsigned, __builtin_convertvector(v, nbf2_t));
}
DEV float sigm(float x) { return __builtin_amdgcn_rcpf(1.f + __expf(-x)); }
DEV float tanh_fast(float x) { return 1.f - 2.f * __builtin_amdgcn_rcpf(1.f + __expf(2.f * x)); }
DEV float silu(float x) { return x * sigm(x); }
DEV float logsig(float x) { return fminf(x, 0.f) - __logf(1.f + __expf(-fabsf(x))); }
DEV float wave_sum(float v) {
#pragma unroll
  for (int o = 32; o > 0; o >>= 1) v += __shfl_xor(v, o);
  return v;
}
DEV float wave_max(float v) {
#pragma unroll
  for (int o = 32; o > 0; o >>= 1) v = fmaxf(v, __shfl_xor(v, o));
  return v;
}
template <int CTRL> DEV float dppf(float x) {
  return __builtin_bit_cast(float, __builtin_amdgcn_mov_dpp(__builtin_bit_cast(int, x), CTRL, 0xf, 0xf, true));
}
DEV float row16_sum(float x) {
  x += dppf<0x128>(x);
  x += dppf<0x124>(x);
  x += dppf<0x122>(x);
  x += dppf<0x121>(x);
  return x;
}
DEV void row16_sum2(float& a, float& b) {
  asm volatile("s_nop 1\n\tv_add_f32_dpp %0, %0, %0 row_ror:8 row_mask:0xf bank_mask:0xf\n\tv_add_f32_dpp %1, %1, %1 row_ror:8 row_mask:0xf bank_mask:0xf\n\t"
               "s_nop 1\n\tv_add_f32_dpp %0, %0, %0 row_ror:4 row_mask:0xf bank_mask:0xf\n\tv_add_f32_dpp %1, %1, %1 row_ror:4 row_mask:0xf bank_mask:0xf\n\t"
               "s_nop 1\n\tv_add_f32_dpp %0, %0, %0 row_ror:2 row_mask:0xf bank_mask:0xf\n\tv_add_f32_dpp %1, %1, %1 row_ror:2 row_mask:0xf bank_mask:0xf\n\t"
               "s_nop 1\n\tv_add_f32_dpp %0, %0, %0 row_ror:1 row_mask:0xf bank_mask:0xf\n\tv_add_f32_dpp %1, %1, %1 row_ror:1 row_mask:0xf bank_mask:0xf\n\t"
               "s_nop 0"
               : "+v"(a), "+v"(b));
}
DEV float wave_sum_dpp(float x) {
  x = row16_sum(x);
  const int xi = __builtin_bit_cast(int, x);
  const float s0 = __builtin_bit_cast(float, __builtin_amdgcn_readlane(xi, 0));
  const float s1 = __builtin_bit_cast(float, __builtin_amdgcn_readlane(xi, 16));
  const float s2 = __builtin_bit_cast(float, __builtin_amdgcn_readlane(xi, 32));
  const float s3 = __builtin_bit_cast(float, __builtin_amdgcn_readlane(xi, 48));
  return (s0 + s1) + (s2 + s3);
}
DEV void seq_of_token(int t, int& tb, int& T) {
  if (t < NPROMPT) { tb = t & ~2047; T = 2048; }
  else { int u = t - NPROMPT; tb = NPROMPT + (u & ~8191); T = 8192; }
}
DEV const float* xin_row(const Params& p, int row) {
  return row < NPROMPT ? p.in[0] + (size_t)row * DM : p.in[1] + (size_t)(row - NPROMPT) * DM;
}
DEV void unpack8(uint4 u, float* v) {
  v[0] = __uint_as_float(u.x << 16); v[1] = __uint_as_float(u.x & 0xffff0000u);
  v[2] = __uint_as_float(u.y << 16); v[3] = __uint_as_float(u.y & 0xffff0000u);
  v[4] = __uint_as_float(u.z << 16); v[5] = __uint_as_float(u.z & 0xffff0000u);
  v[6] = __uint_as_float(u.w << 16); v[7] = __uint_as_float(u.w & 0xffff0000u);
}

DEV void unpack8p(uint4 u, f32x2* v) {
  v[0] = (f32x2){__uint_as_float(u.x << 16), __uint_as_float(u.x & 0xffff0000u)};
  v[1] = (f32x2){__uint_as_float(u.y << 16), __uint_as_float(u.y & 0xffff0000u)};
  v[2] = (f32x2){__uint_as_float(u.z << 16), __uint_as_float(u.z & 0xffff0000u)};
  v[3] = (f32x2){__uint_as_float(u.w << 16), __uint_as_float(u.w & 0xffff0000u)};
}

constexpr int LDT = 72;

constexpr int TM = 256;
constexpr int NRT = NTOK / TM;
struct GRegs { u32x4 a0, a1, a2, a3, b0, b1; };
DEV void gemm_gload(GRegs& g, const bf16_t* A0, int lda0, const bf16_t* A1, int lda1, int ksplit,
                    const bf16_t* Bt, int ldb, int k0, int tid) {
  const bf16_t* Ab; int lda, kk;
  if (k0 < ksplit) { Ab = A0; lda = lda0; kk = k0; }
  else { Ab = A1; lda = lda1; kk = k0 - ksplit; }
  const int row = tid >> 2, kc = (tid & 3) * 8;
  const bf16_t* pa = Ab + (size_t)row * lda + kk + kc;
  const bf16_t* pb = Bt + (size_t)row * ldb + k0 + kc;
  g.a0 = *(const u32x4*)(pa);
  g.a1 = *(const u32x4*)(pa + (size_t)64 * lda);
  g.a2 = *(const u32x4*)(pa + (size_t)128 * lda);
  g.a3 = *(const u32x4*)(pa + (size_t)192 * lda);
  g.b0 = *(const u32x4*)(pb);
  g.b1 = *(const u32x4*)(pb + (size_t)64 * ldb);
}
DEV void gemm_lds_write(const GRegs& g, bf16_t* wa, bf16_t* wb) {
  *(u32x4*)(wa) = g.a0; *(u32x4*)(wa + 64 * 32) = g.a1; *(u32x4*)(wa + 128 * 32) = g.a2; *(u32x4*)(wa + 192 * 32) = g.a3;
  *(u32x4*)(wb) = g.b0; *(u32x4*)(wb + 64 * 32) = g.b1;
}

constexpr int GSA = 256 * 32;
constexpr int GST = (256 + 128) * 32;
template <bool RES, class Epi>
DEV void gemm_tile_x(const bf16_t* A0, int lda0, const bf16_t* A1, int lda1, int ksplit,
                     const bf16_t* Bt, int ldb, int K, char* smem, const float* resb, Epi epi) {
  bf16_t* sbase = (bf16_t*)smem;
  const int tid = threadIdx.x, lane = tid & 63, wv = tid >> 6;
  const int wm = wv >> 1, wn = wv & 1;
  f32x16 acc[4][2];
#pragma unroll
  for (int i = 0; i < 4; ++i)
#pragma unroll
    for (int j = 0; j < 2; ++j)
#pragma unroll
      for (int r = 0; r < 16; ++r) acc[i][j][r] = 0.f;
  GRegs g, g1;
  const int nk = K >> 5;
  const int woff = (tid >> 2) * 32 + (((tid & 3) ^ ((tid >> 4) & 3)) << 3);
  const int swz = (lane >> 2) & 3, hh = lane >> 5;
  const int raoff = (wm * 128 + (lane & 31)) * 32;
  const int rboff = GSA + (wn * 64 + (lane & 31)) * 32;
  const int ko0 = ((0 + hh) ^ swz) << 3, ko1 = ((2 + hh) ^ swz) << 3;

  __syncthreads();
  gemm_gload(g, A0, lda0, A1, lda1, ksplit, Bt, ldb, 0, tid);
  if (nk > 1) gemm_gload(g1, A0, lda0, A1, lda1, ksplit, Bt, ldb, 32, tid);
  gemm_lds_write(g, sbase + woff, sbase + GSA + woff);
  if (nk > 2) gemm_gload(g, A0, lda0, A1, lda1, ksplit, Bt, ldb, 64, tid);
  __syncthreads();
#define GEMM_COMPUTE(ST)                                                                                  \
  _Pragma("unroll") for (int ks = 0; ks < 2; ++ks) {                                                      \
    const int ko = ks ? ko1 : ko0;                                                                        \
    bf16x8 a[4], b[2];                                                                                    \
    _Pragma("unroll") for (int mi = 0; mi < 4; ++mi) a[mi] = *(const bf16x8*)((ST) + raoff + mi * 32 * 32 + ko); \
    _Pragma("unroll") for (int ni = 0; ni < 2; ++ni) b[ni] = *(const bf16x8*)((ST) + rboff + ni * 32 * 32 + ko); \
    _Pragma("unroll") for (int mi = 0; mi < 4; ++mi)                                                      \
      _Pragma("unroll") for (int ni = 0; ni < 2; ++ni)                                                    \
        acc[mi][ni] = __builtin_amdgcn_mfma_f32_32x32x16_bf16(a[mi], b[ni], acc[mi][ni], 0, 0, 0);        \
  }
  for (int kt = 0; kt < nk; kt += 2) {
    GEMM_COMPUTE(sbase);
    if (kt + 1 < nk) gemm_lds_write(g1, sbase + GST + woff, sbase + GST + GSA + woff);
    if (kt + 3 < nk) gemm_gload(g1, A0, lda0, A1, lda1, ksplit, Bt, ldb, (kt + 3) * 32, tid);
    __syncthreads();
    if (kt + 1 < nk) {
      GEMM_COMPUTE(sbase + GST);
      if (kt + 2 < nk) gemm_lds_write(g, sbase + woff, sbase + GSA + woff);
      if (kt + 4 < nk) gemm_gload(g, A0, lda0, A1, lda1, ksplit, Bt, ldb, (kt + 4) * 32, tid);
      __syncthreads();
    }
  }
#undef GEMM_COMPUTE
  const int rl = wm * 128 + 4 * (lane >> 5);
  const int col = wn * 64 + (lane & 31);
  const unsigned resoff = (unsigned)(rl * DM + col);
#pragma unroll
  for (int mi = 0; mi < 4; ++mi) {
#pragma unroll
    for (int rh = 0; rh < 2; ++rh) {
      float x0[8], x1[8];
      if (RES) {
#pragma unroll
        for (int r8 = 0; r8 < 8; ++r8) {
          const int r = rh * 8 + r8;
          const int ru = mi * 32 + (r & 3) + 8 * (r >> 2);
          const float* rp = resb + ru * DM;
          x0[r8] = rp[resoff];
          x1[r8] = rp[resoff + 32];
        }
      }
#pragma unroll
      for (int r8 = 0; r8 < 8; ++r8) {
        const int r = rh * 8 + r8;
        const int ru = mi * 32 + (r & 3) + 8 * (r >> 2);
        if (RES) epi(ru, rl, col, acc[mi][0][r], acc[mi][1][r], x0[r8], x1[r8]);
        else epi(ru, rl, col, acc[mi][0][r], acc[mi][1][r], 0.f, 0.f);
        if ((r8 & 3) == 3) __builtin_amdgcn_sched_barrier(0);
      }
    }
  }
}
template <class Epi>
DEV void gemm_tile(const bf16_t* A0, int lda0, const bf16_t* A1, int lda1, int ksplit,
                   const bf16_t* Bt, int ldb, int K, char* smem, Epi epi) {
  gemm_tile_x<false>(A0, lda0, A1, lda1, ksplit, Bt, ldb, K, smem, nullptr,
                     [&](int ru, int rl, int c, float v0, float v1, float, float) { epi(ru, rl, c, v0, v1); });
}

DEV void wconv(const float* src, int ld, int K, int N, int mode, int coloff, bf16_t* dst, char* smem) {
  float* tile = (float*)smem;
  const int tid = threadIdx.x;
  const int nkt = K >> 6, nnt = N >> 5, nn4 = (nnt + 3) >> 2;
  for (int tl = blockIdx.x; tl < nkt * nn4; tl += gridDim.x) {
    const int kt = tl % nkt, n4 = tl / nkt;
    __syncthreads();
    {
      const int n = tid & 31, kk = tid >> 5;
      float v[4][8];
#pragma unroll
      for (int u = 0; u < 4; ++u) {
        int nt = n4 * 4 + u;
        if (nt >= nnt) nt = nnt - 1;
        const int cb = mode ? ((nt & 1) * DFF + (nt >> 1) * 32) : (coloff + nt * 32);
#pragma unroll
        for (int i = 0; i < 8; ++i) v[u][i] = src[(size_t)(kt * 64 + kk + 8 * i) * ld + cb + n];
      }
#pragma unroll
      for (int u = 0; u < 4; ++u)
#pragma unroll
        for (int i = 0; i < 8; ++i) tile[u * (64 * 33) + (kk + 8 * i) * 33 + n] = v[u][i];
    }
    __syncthreads();
    {
      const int k2 = tid & 31, nn = tid >> 5;
#pragma unroll
      for (int u = 0; u < 4; ++u) {
        const int nt = n4 * 4 + u;
        if (nt < nnt) {
#pragma unroll
          for (int i = 0; i < 4; ++i) {
            const int n = nn + 8 * i;
            const unsigned w = pack2(tile[u * (64 * 33) + (2 * k2) * 33 + n], tile[u * (64 * 33) + (2 * k2 + 1) * 33 + n]);
            *(unsigned*)(dst + (size_t)(nt * 32 + n) * K + kt * 64 + 2 * k2) = w;
          }
        }
      }
    }
  }
  __syncthreads();
}

DEV void ln_load(const float* src, float4 (&v)[4], int lane) {
#pragma unroll
  for (int i = 0; i < 4; ++i) v[i] = *(const float4*)(src + (i * 64 + lane) * 4);
}
DEV void ln_finish(float4 (&v)[4], float* dstf, bf16_t* dstb, const float* g, const float* b, int lane) {
  float s = 0.f;
#pragma unroll
  for (int i = 0; i < 4; ++i) s += v[i].x + v[i].y + v[i].z + v[i].w;
  const float mu = wave_sum_dpp(s) * (1.f / 1024.f);
  float q = 0.f;
#pragma unroll
  for (int i = 0; i < 4; ++i) {
    v[i].x -= mu; v[i].y -= mu; v[i].z -= mu; v[i].w -= mu;
    q += v[i].x * v[i].x + v[i].y * v[i].y + v[i].z * v[i].z + v[i].w * v[i].w;
  }
  const float rs = rsqrtf(wave_sum_dpp(q) * (1.f / 1024.f) + 1e-5f);
#pragma unroll
  for (int i = 0; i < 4; ++i) {
    const int c = (i * 64 + lane) * 4;
    const float4 gg = *(const float4*)(g + c), bb = *(const float4*)(b + c);
    float4 o;
    o.x = v[i].x * rs * gg.x + bb.x; o.y = v[i].y * rs * gg.y + bb.y;
    o.z = v[i].z * rs * gg.z + bb.z; o.w = v[i].w * rs * gg.w + bb.w;
    if (dstf) *(float4*)(dstf + c) = o;
    if (dstb) { uint2 u; u.x = pack2(o.x, o.y); u.y = pack2(o.z, o.w); *(uint2*)(dstb + c) = u; }
  }
}

DEV void phase_ln(const Params& p, const float* g, const float* b, bool write_xb, bool do_mem) {
  const int lane = threadIdx.x & 63;
  const int gw = blockIdx.x * 4 + (threadIdx.x >> 6), nw = gridDim.x * 4;
  bf16_t* xb = (bf16_t*)(p.ws + O_XB);
  for (int r = gw; r < NTOK; r += 2 * nw) {
    const int r2 = r + nw;
    float4 v0[4], v1[4];
    float* row0 = p.out + (size_t)r * DM;
    float* row1 = p.out + (size_t)(r2 < NTOK ? r2 : r) * DM;
    ln_load(row0, v0, lane);
    ln_load(row1, v1, lane);
    ln_finish(v0, row0, write_xb ? xb + (size_t)r * DM : nullptr, g, b, lane);
    if (r2 < NTOK) ln_finish(v1, row1, write_xb ? xb + (size_t)r2 * DM : nullptr, g, b, lane);
  }
  if (do_mem) {
    for (int m = gw; m < 3072; m += nw) {
      const float* src = m < 2048 ? p.in[2] + (size_t)m * DM : p.in[3] + (size_t)(m - 2048) * DM;
      float4 v0[4];
      ln_load(src, v0, lane);
      ln_finish(v0, nullptr, (bf16_t*)(p.ws + O_MEMB) + (size_t)m * DM, p.in[31], p.in[32], lane);
    }
  }
}

DEV bool tile_map(int it, int nct, int& rt, int& ct) {
  const int bpx = gridDim.x >> 3, xcd = blockIdx.x & 7, j = blockIdx.x >> 3;
  const int q = j + it * bpx;
  if (q >= 24 * nct) return false;
  const int band = q / (8 * nct), qq = q - band * 8 * nct;
  rt = xcd * 24 + band * 8 + (qq & 7);
  ct = qq >> 3;
  return true;
}

DEV void phase_ffn_in(const Params& p, const bf16_t* wt, char* smem) {
  const bf16_t* xb = (const bf16_t*)(p.ws + O_XB);
  bf16_t* h = (bf16_t*)(p.ws + O_H);
  const int nct = 44;
  int rt, ct;
  for (int it = 0; tile_map(it, nct, rt, ct); ++it) {
    bf16_t* hb = h + (size_t)rt * TM * DFF + ct * 64;
    gemm_tile(xb + (size_t)rt * TM * DM, DM, nullptr, 0, DM, wt + (size_t)ct * 128 * DM, DM, DM, smem,
              [&](int ru, int rl, int c, float v0, float v1) {
                (hb + ru * DFF)[(unsigned)(rl * DFF + (c >> 6) * 32 + (c & 31))] = f2bf(silu(v0) * v1);
              });
  }
}
DEV void phase_gemm_res(const Params& p, const bf16_t* A0, int lda0, const bf16_t* A1, int lda1, int ksplit, int K,
                        const bf16_t* wt, float scale, bool res_is_input, char* smem) {
  const int nct = 8;
  int rt, ct;
  for (int it = 0; tile_map(it, nct, rt, ct); ++it) {
    const int r0 = rt * TM, c0 = ct * 128;
    const bf16_t* a1 = A1 ? A1 + (size_t)r0 * lda1 : nullptr;
    const float* resb = (res_is_input ? xin_row(p, r0) : p.out + (size_t)r0 * DM) + c0;
    float* outb = p.out + (size_t)r0 * DM + c0;
    gemm_tile_x<true>(A0 + (size_t)r0 * lda0, lda0, a1, lda1, ksplit, wt + (size_t)c0 * K, K, K, smem, resb,
              [&](int ru, int rl, int c, float v0, float v1, float x0, float x1) {
                float* op = outb + ru * DM;
                const unsigned off = (unsigned)(rl * DM + c);
                op[off] = ALPHA * x0 + scale * v0;
                op[off + 32] = ALPHA * x1 + scale * v1;
              });
  }
}
DEV void phase_gemm_bf16(const bf16_t* A, int lda, const bf16_t* wt, int K, int N, bf16_t* out, int ldo, char* smem) {
  const int nct = (N + 127) >> 7;
  int rt, ct;
  for (int it = 0; tile_map(it, nct, rt, ct); ++it) {
    const int r0 = rt * TM, c0 = ct * 128;
    gemm_tile(A + (size_t)r0 * lda, lda, nullptr, 0, K, wt + (size_t)c0 * K, K, K, smem,
              [&](int ru, int rl, int c, float v0, float v1) {
                bf16_t* o = out + (size_t)(r0 + ru) * ldo + c0;
                const unsigned off = (unsigned)(rl * ldo + c);
                const int cc = c0 + c;
                if (cc < N) o[off] = f2bf(v0);
                if (cc + 32 < N) o[off + 32] = f2bf(v1);
              });
  }
}

constexpr int GL = 72;
struct GlaSmemM {
  bf16_t VT[128 * GL];
  bf16_t R1[128 * GL];
  bf16_t QB[64 * GL];
  bf16_t P[64 * GL];
  float gd[64 * 32];
  float tot[256];
  float blast[64];
};
static_assert(sizeof(GlaSmemM) <= 65536, "GlaSmemM too big");
constexpr int OBS = 132;

DEV int mfma_row(int r, int lane) { return (r & 3) + 8 * (r >> 2) + 4 * (lane >> 5); }
DEV void mma_k64(f32x16& acc, const bf16_t* sA, const bf16_t* sB, int lane) {
  const int o = (lane & 31) * GL + (lane >> 5) * 8;
#pragma unroll
  for (int ks = 0; ks < 4; ++ks) {
    const bf16x8 a = *(const bf16x8*)(sA + o + ks * 16);
    const bf16x8 b = *(const bf16x8*)(sB + o + ks * 16);
    acc = __builtin_amdgcn_mfma_f32_32x32x16_bf16(a, b, acc, 0, 0, 0);
  }
}
DEV void gla_load_vtg(const bf16_t* proj, int t0, int h, GlaSmemM* s) {
  const int tid = threadIdx.x;
#pragma unroll
  for (int i = 0; i < 4; ++i) {
    const int id = tid + 256 * i, c = id & 63, ec = id >> 6;
    const uint4 u = *(const uint4*)(proj + (size_t)(t0 + c) * GLA_LD + 512 + h * 128 + ec * 8);
    const unsigned w[4] = {u.x, u.y, u.z, u.w};
#pragma unroll
    for (int j = 0; j < 4; ++j) {
      s->VT[(ec * 8 + 2 * j) * GL + c] = (bf16_t)(w[j] & 0xffffu);
      s->VT[(ec * 8 + 2 * j + 1) * GL + c] = (bf16_t)(w[j] >> 16);
    }
  }
  {
    const int c = tid >> 2, part = tid & 3;
    const uint4 u = *(const uint4*)(proj + (size_t)(t0 + c) * GLA_LD + 1536 + part * 8);
    float v[8];
    unpack8(u, v);
#pragma unroll
    for (int j = 0; j < 8; ++j) s->gd[c * 32 + part * 8 + j] = v[j];
  }
}
DEV void gla_gates(const Params& p, int h, int dir, const float* gd, float* tot, float (&b)[16], float& bl) {
  const int tid = threadIdx.x, d = tid & 63, cq = tid >> 6;
  const float* up = dir ? p.in[11] : p.in[9];
  const float* gb = dir ? p.in[12] : p.in[10];
  float u[16];
#pragma unroll
  for (int m = 0; m < 16; ++m) u[m] = up[m * 256 + h * 64 + d];
  const float bias = gb[h * 64 + d];
#pragma unroll
  for (int i = 0; i < 16; ++i) {
    const int c = cq * 16 + i;
    float z = bias;
#pragma unroll
    for (int m4 = 0; m4 < 4; ++m4) {
      const float4 g4 = *(const float4*)(gd + c * 32 + dir * 16 + m4 * 4);
      z += g4.x * u[m4 * 4] + g4.y * u[m4 * 4 + 1] + g4.z * u[m4 * 4 + 2] + g4.w * u[m4 * 4 + 3];
    }
    b[i] = logsig(z) * (1.f / 16.f);
  }
  float run = 0.f;
  if (dir == 0) {
#pragma unroll
    for (int i = 0; i < 16; ++i) { run += b[i]; b[i] = run; }
  } else {
#pragma unroll
    for (int i = 15; i >= 0; --i) { run += b[i]; b[i] = run; }
  }
  tot[cq * 64 + d] = run;
  __syncthreads();
  const float t0 = tot[d], t1 = tot[64 + d], t2 = tot[128 + d], t3 = tot[192 + d];
  float off;
  if (dir == 0) off = (cq > 0 ? t0 : 0.f) + (cq > 1 ? t1 : 0.f) + (cq > 2 ? t2 : 0.f);
  else off = (cq < 3 ? t3 : 0.f) + (cq < 2 ? t2 : 0.f) + (cq < 1 ? t1 : 0.f);
#pragma unroll
  for (int i = 0; i < 16; ++i) b[i] += off;
  bl = (t0 + t1) + (t2 + t3);
}

DEV void phase_gla_a(const Params& p, char* smem) {
  GlaSmemM* s = (GlaSmemM*)smem;
  const bf16_t* proj = (const bf16_t*)(p.ws + O_H);
  float* kv = (float*)(p.ws + O_KV);
  float* dec = (float*)(p.ws + O_DEC);
  const int tid = threadIdx.x, lane = tid & 63, wv = tid >> 6;
  for (int item = blockIdx.x; item < 768 * 4; item += gridDim.x) {
    const int gch = item >> 2, h = item & 3, t0 = gch * 64;
    __syncthreads();
    gla_load_vtg(proj, t0, h, s);
    float kf[16];
    {
      const int d = tid & 63, cq = tid >> 6;
#pragma unroll
      for (int i = 0; i < 16; ++i) kf[i] = bf2f(proj[(size_t)(t0 + cq * 16 + i) * GLA_LD + 256 + h * 64 + d]);
    }
    __syncthreads();
    for (int dir = 0; dir < 2; ++dir) {
      float bb[16], bl;
      gla_gates(p, h, dir, s->gd, s->tot, bb, bl);
      {
        const int d = tid & 63, cq = tid >> 6;
        unsigned w[8];
#pragma unroll
        for (int i = 0; i < 8; ++i)
          w[i] = pack2(kf[2 * i] * __expf(bl - bb[2 * i]), kf[2 * i + 1] * __expf(bl - bb[2 * i + 1]));
        bf16_t* dst = s->R1 + d * GL + cq * 16;
        *(u32x4*)(dst) = (u32x4){w[0], w[1], w[2], w[3]};
        *(u32x4*)(dst + 8) = (u32x4){w[4], w[5], w[6], w[7]};
        if (cq == 0) s->blast[d] = bl;
      }
      __syncthreads();
      f32x16 acc[2];
#pragma unroll
      for (int j = 0; j < 2; ++j)
#pragma unroll
        for (int r = 0; r < 16; ++r) acc[j][r] = 0.f;
#pragma unroll
      for (int db = 0; db < 2; ++db) mma_k64(acc[db], s->VT + wv * 32 * GL, s->R1 + db * 32 * GL, lane);
      const size_t kvi = (size_t)item * 2 + dir;
      float* ob = kv + kvi * 8192;
#pragma unroll
      for (int db = 0; db < 2; ++db)
#pragma unroll
        for (int r = 0; r < 16; ++r) {
          const int e = wv * 32 + mfma_row(r, lane), d = db * 32 + (lane & 31);
          ob[e * 64 + d] = acc[db][r];
        }
      if (tid < 64) dec[kvi * 64 + tid] = __expf(s->blast[tid]);
      __syncthreads();
    }
  }
}

DEV void phase_gla_b(const Params& p) {
  float* kv = (float*)(p.ws + O_KV);
  const float* dec = (const float*)(p.ws + O_DEC);
  const int tid = threadIdx.x;
  for (int unit = blockIdx.x; unit < 96 * 32; unit += gridDim.x) {
    const int sid = unit >> 5, part = unit & 31;
    const int sq = sid >> 3, h = (sid >> 1) & 3, dir = sid & 1;
    int c0, nch;
    if (sq < 4) { c0 = 256 + sq * 128; nch = 128; }
    else { c0 = (sq - 4) * 32; nch = 32; }
    const int e = part * 256 + tid;
    float S = 0.f;
    for (int n0 = 0; n0 < nch; n0 += 8) {
      float tmp[8], dc[8];
#pragma unroll
      for (int u = 0; u < 8; ++u) {
        const int n = n0 + u;
        const int ci = dir ? (c0 + nch - 1 - n) : (c0 + n);
        const size_t idx = ((size_t)ci * 4 + h) * 2 + dir;
        tmp[u] = kv[idx * 8192 + e];
        dc[u] = dec[idx * 64 + (e & 63)];
      }
#pragma unroll
      for (int u = 0; u < 8; ++u) {
        const int n = n0 + u;
        const int ci = dir ? (c0 + nch - 1 - n) : (c0 + n);
        const size_t idx = ((size_t)ci * 4 + h) * 2 + dir;
        kv[idx * 8192 + e] = S;
        S = dc[u] * S + tmp[u];
      }
    }
  }
}

DEV void phase_gla_c(const Params& p, char* smem) {
  GlaSmemM* s = (GlaSmemM*)smem;
  const bf16_t* proj = (const bf16_t*)(p.ws + O_H);
  const float* kv = (const float*)(p.ws + O_KV);
  bf16_t* mixed = (bf16_t*)(p.ws + O_MIXG);
  const int tid = threadIdx.x, lane = tid & 63, wv = tid >> 6;
  const int cg_ = tid >> 4, eg = tid & 15;
  float* Ob = (float*)s->R1;
  static_assert(64 * OBS * 4 <= (128 + 64 + 64) * GL * 2, "output staging does not fit");
  for (int item = blockIdx.x; item < 768 * 4; item += gridDim.x) {
    const int gch = item >> 2, h = item & 3, t0 = gch * 64;
    __syncthreads();
    gla_load_vtg(proj, t0, h, s);
    float qf[16], kf[16];
    {
      const int d = tid & 63, cq = tid >> 6;
#pragma unroll
      for (int i = 0; i < 16; ++i) {
        const bf16_t* row = proj + (size_t)(t0 + cq * 16 + i) * GLA_LD + h * 64 + d;
        qf[i] = bf2f(row[0]) * 0.125f;
        kf[i] = bf2f(row[256]);
      }
    }
    __syncthreads();
    const int cb = wv & 1, eb0 = (wv >> 1) * 2;
    f32x16 acc[2];
#pragma unroll
    for (int j = 0; j < 2; ++j)
#pragma unroll
      for (int r = 0; r < 16; ++r) acc[j][r] = 0.f;
    for (int dir = 0; dir < 2; ++dir) {
      {
        float bb[16], bl;
        gla_gates(p, h, dir, s->gd, s->tot, bb, bl);
        const int d = tid & 63, cq = tid >> 6;
        const float bref = 0.5f * bl;
#pragma unroll
        for (int i = 0; i < 16; ++i) {
          const int c = cq * 16 + i;
          const float b = bb[i];
          const float q = qf[i];
          const float k = kf[i];
          s->R1[c * GL + d] = f2bf(q * __expf(b - bref));
          s->R1[(64 + c) * GL + d] = f2bf(k * __expf(bref - b));
          s->QB[c * GL + d] = f2bf(q * __expf(b));
        }
      }
      __syncthreads();
      {
        const int sb = wv >> 1, cbs = wv & 1;
        f32x16 sc;
#pragma unroll
        for (int r = 0; r < 16; ++r) sc[r] = 0.f;
        mma_k64(sc, s->R1 + (64 + sb * 32) * GL, s->R1 + cbs * 32 * GL, lane);
        const int c = cbs * 32 + (lane & 31);
#pragma unroll
        for (int g = 0; g < 4; ++g) {
          float v[4];
#pragma unroll
          for (int i = 0; i < 4; ++i) {
            const int sr = sb * 32 + 8 * g + 4 * (lane >> 5) + i;
            const bool keep = dir ? (sr >= c) : (sr <= c);
            v[i] = keep ? sc[4 * g + i] : 0.f;
          }
          uint2 w;
          w.x = pack2(v[0], v[1]);
          w.y = pack2(v[2], v[3]);
          *(uint2*)(s->P + c * GL + sb * 32 + 8 * g + 4 * (lane >> 5)) = w;
        }
      }
      const float* Sp = kv + ((size_t)item * 2 + dir) * 8192 + tid * 4;
      f32x4v sv[8];
#pragma unroll
      for (int i = 0; i < 8; ++i) sv[i] = *(const f32x4v*)(Sp + i * 1024);
      __syncthreads();
#pragma unroll
      for (int i = 0; i < 8; ++i) {
        const int el = (tid + 256 * i) * 4, e = el >> 6, d = el & 63;
        uint2 w;
        w.x = pack2(sv[i].x, sv[i].y);
        w.y = pack2(sv[i].z, sv[i].w);
        *(uint2*)(s->R1 + e * GL + d) = w;
      }
#pragma unroll
      for (int j = 0; j < 2; ++j) mma_k64(acc[j], s->P + cb * 32 * GL, s->VT + (eb0 + j) * 32 * GL, lane);
      __syncthreads();
#pragma unroll
      for (int j = 0; j < 2; ++j) mma_k64(acc[j], s->QB + cb * 32 * GL, s->R1 + (eb0 + j) * 32 * GL, lane);
      __syncthreads();
    }
#pragma unroll
    for (int j = 0; j < 2; ++j)
#pragma unroll
      for (int r = 0; r < 16; ++r) {
        const int c = cb * 32 + mfma_row(r, lane), e = (eb0 + j) * 32 + (lane & 31);
        Ob[c * OBS + e] = acc[j][r];
      }
    __syncthreads();
    float ng[8];
#pragma unroll
    for (int j = 0; j < 8; ++j) ng[j] = p.in[13][h * 128 + eg * 8 + j];
#pragma unroll
    for (int i = 0; i < 4; ++i) {
      const int cr = cg_ * 4 + i;
      const float4 o0 = *(const float4*)(Ob + cr * OBS + eg * 8), o1 = *(const float4*)(Ob + cr * OBS + eg * 8 + 4);
      const float o[8] = {o0.x, o0.y, o0.z, o0.w, o1.x, o1.y, o1.z, o1.w};
      float ss = 0.f;
#pragma unroll
      for (int j = 0; j < 8; ++j) ss += o[j] * o[j];
      ss = row16_sum(ss);
      const float rs = rsqrtf(ss * (1.f / 128.f) + 1e-5f);
      const int t = t0 + cr;
      float g[8];
      unpack8(*(const uint4*)(proj + (size_t)t * GLA_LD + 1024 + h * 128 + eg * 8), g);
      uint4 u;
      u.x = pack2(o[0] * rs * ng[0] * silu(g[0]), o[1] * rs * ng[1] * silu(g[1]));
      u.y = pack2(o[2] * rs * ng[2] * silu(g[2]), o[3] * rs * ng[3] * silu(g[3]));
      u.z = pack2(o[4] * rs * ng[4] * silu(g[4]), o[5] * rs * ng[5] * silu(g[5]));
      u.w = pack2(o[6] * rs * ng[6] * silu(g[6]), o[7] * rs * ng[7] * silu(g[7]));
      *(uint4*)(mixed + (size_t)t * 512 + h * 128 + eg * 8) = u;
    }
  }
}

DEV void phase_rw_act(const Params& p) {
  const bf16_t* proj = (const bf16_t*)(p.ws + O_H);
  bf16_t* awda = (bf16_t*)(p.ws + O_XB);
  bf16_t* ag = (bf16_t*)(p.ws + O_ACTG);
  const int total = NTOK * 160;
  const int stride = gridDim.x * 256;
  for (int base = blockIdx.x * 256 + threadIdx.x; base < total; base += 8 * stride) {
    unsigned x[8], pv[8], nx[8];
#pragma unroll
    for (int u = 0; u < 8; ++u) {
      int idx = base + u * stride;
      if (idx >= total) idx = base;
      const int t = idx / 160, cp = idx - t * 160;
      int tb, T;
      seq_of_token(t, tb, T);
      const bf16_t* ptr = proj + (size_t)t * RW_LD + 1536 + cp * 2;
      x[u] = *(const unsigned*)ptr;
      pv[u] = *(const unsigned*)(ptr + (t > tb ? -RW_LD : 0));
      nx[u] = *(const unsigned*)(ptr + (t < tb + T - 1 ? RW_LD : 0));
    }
#pragma unroll
    for (int u = 0; u < 8; ++u) {
      const int idx = base + u * stride;
      if (idx < total) {
        const int t = idx / 160, cp = idx - t * 160;
        int tb, T;
        seq_of_token(t, tb, T);
        const bool hp = t > tb, hn = t < tb + T - 1;
        const int rc = 1536 + cp * 2;
        float v[2];
#pragma unroll
        for (int e = 0; e < 2; ++e) {
          const float xx = e ? __uint_as_float(x[u] & 0xffff0000u) : __uint_as_float(x[u] << 16);
          const float pp = hp ? (e ? __uint_as_float(pv[u] & 0xffff0000u) : __uint_as_float(pv[u] << 16)) : 0.f;
          const float nn = hn ? (e ? __uint_as_float(nx[u] & 0xffff0000u) : __uint_as_float(nx[u] << 16)) : 0.f;
          v[e] = xx + p.in[14][rc + e] * (pp - xx) + p.in[15][rc + e] * (nn - xx);
        }
        const int col = cp * 2;
        if (col < 128) *(unsigned*)(awda + (size_t)t * 192 + col) = pack2(tanh_fast(v[0]), tanh_fast(v[1]));
        else if (col < 192) *(unsigned*)(awda + (size_t)t * 192 + col) = pack2(v[0], v[1]);
        else *(unsigned*)(ag + (size_t)t * 128 + (col - 192)) = pack2(sigm(v[0]), sigm(v[1]));
      }
    }
  }
}

DEV void phase_rw_lowrank(const Params& p, char* smem) {
  const bf16_t* awda = (const bf16_t*)(p.ws + O_XB);
  bf16_t* der = (bf16_t*)(p.ws + O_DER);
  int rt, ct12;
  for (int it = 0; tile_map(it, 12, rt, ct12); ++it) {
    const int which = ct12 >> 2, ct = ct12 & 3;
    const int r0 = rt * TM, c0 = ct * 128;
    const bf16_t* wt = (const bf16_t*)(p.ws + (which == 0 ? W_A_UPF : which == 1 ? W_A_UPB : W_A_AUP));
    const float* bias = which == 0 ? p.in[16] : which == 1 ? p.in[18] : p.in[20];
    bf16_t* out = der + (size_t)which * SLAB;
    gemm_tile(awda + (size_t)r0 * 192 + which * 64, 192, nullptr, 0, 64, wt + (size_t)c0 * 64, 64, 64, smem,
              [&](int ru, int rl, int c, float v0, float v1) {
                bf16_t* o = out + (size_t)(r0 + ru) * 512 + c0;
                const unsigned off = (unsigned)(rl * 512 + c);
                const float z0 = bias[c0 + c] + v0, z1 = bias[c0 + c + 32] + v1;
                if (which < 2) { o[off] = f2bf(-0.6065306597f * sigm(z0)); o[off + 32] = f2bf(-0.6065306597f * sigm(z1)); }
                else { o[off] = f2bf(sigm(z0)); o[off + 32] = f2bf(sigm(z1)); }
              });
  }
}

constexpr int SST = 388;
template <int RPL>
struct StepV { f32x4v w, nk, ka, k, r; float v[RPL]; float kar; };
template <int RPL>
DEV void step_load(StepV<RPL>& x, const float* sb, int jl, int rowbase) {
  x.w = *(const f32x4v*)(sb + jl * 4);
  x.nk = *(const f32x4v*)(sb + 64 + jl * 4);
  x.ka = *(const f32x4v*)(sb + 128 + jl * 4);
  x.k = *(const f32x4v*)(sb + 192 + jl * 4);
  x.r = *(const f32x4v*)(sb + 256 + jl * 4);
#pragma unroll
  for (int r = 0; r < RPL; ++r) x.v[r] = sb[320 + rowbase + r];
  x.kar = sb[384];
}

template <int RPL>
DEV void rwkv_scan(const Params& p, int tb, int T, int head, int dir, int split, float* st) {
  const int tid = threadIdx.x, lane = tid & 63, wv = tid >> 6;
  const int jl = lane & 15, ig = lane >> 4;
  const int hc = head * 64 + lane;
  float* ybuf = st + 2 * 16 * SST;
  const bf16_t* proj = (const bf16_t*)(p.ws + O_H);
  const bf16_t* ldp = (const bf16_t*)(p.ws + O_DER) + (size_t)dir * SLAB;
  const bf16_t* ap = (const bf16_t*)(p.ws + O_DER) + 2 * SLAB;
  bf16_t* yout = (bf16_t*)(p.ws + O_XB) + (size_t)dir * SLAB;
  const float* scal = (const float*)(p.ws + O_BONUS);
  const float mpr = p.in[14][hc], mnr = p.in[15][hc];
  const float mpk = p.in[14][512 + hc], mnk = p.in[15][512 + hc];
  const float mpv = p.in[14][1024 + hc], mnv = p.in[15][1024 + hc];
  const float kkw = p.in[23][hc], kaw = p.in[24][hc];
  const int rowl = wv * 4 * RPL + ig * RPL;
  const int rowbase = split * 16 * RPL + rowl;
  const int nch = T >> 4;
  const int ywoff = (jl == 0) ? rowl : (2 * 16 * 16 * RPL + rowl);
  f32x2 S01[RPL], S23[RPL];
#pragma unroll
  for (int r = 0; r < RPL; ++r) { S01[r] = (f32x2){0.f, 0.f}; S23[r] = (f32x2){0.f, 0.f}; }
  bf16_t rawA[4][11];
  float2 scA[4];

#define RW_LOAD(RAW, SC, CH)                                                            \
  _Pragma("unroll") for (int q = 0; q < 4; ++q) {                                       \
    const int tt_ = (CH) * 16 + wv * 4 + q;                                             \
    const int t_ = dir ? (T - 1 - tt_) : tt_;                                           \
    const bf16_t* row_ = proj + (size_t)(tb + t_) * RW_LD + hc;                         \
    const int op_ = t_ > 0 ? -RW_LD : 0, on_ = t_ < T - 1 ? RW_LD : 0;                  \
    _Pragma("unroll") for (int w = 0; w < 3; ++w) {                                     \
      RAW[q][w * 3 + 0] = row_[w * 512];                                                \
      RAW[q][w * 3 + 1] = row_[w * 512 + op_];                                          \
      RAW[q][w * 3 + 2] = row_[w * 512 + on_];                                          \
    }                                                                                   \
    RAW[q][9] = ldp[(size_t)(tb + t_) * 512 + hc];                                      \
    RAW[q][10] = ap[(size_t)(tb + t_) * 512 + hc];                                      \
    SC[q] = *(const float2*)(scal + ((size_t)(tb + t_) * 8 + head) * 4);                \
  }
#define RW_STAGE(RAW, SC, CH, BUF)                                                      \
  _Pragma("unroll") for (int q = 0; q < 4; ++q) {                                       \
    const int s_ = wv * 4 + q;                                                          \
    const int tt_ = (CH) * 16 + s_;                                                     \
    const int t_ = dir ? (T - 1 - tt_) : tt_;                                           \
    const bool hp_ = t_ > 0, hn_ = t_ < T - 1;                                          \
    float x_ = bf2f(RAW[q][0]);                                                         \
    const float r_ = x_ + mpr * ((hp_ ? bf2f(RAW[q][1]) : 0.f) - x_) + mnr * ((hn_ ? bf2f(RAW[q][2]) : 0.f) - x_);  \
    x_ = bf2f(RAW[q][3]);                                                               \
    const float kr_ = x_ + mpk * ((hp_ ? bf2f(RAW[q][4]) : 0.f) - x_) + mnk * ((hn_ ? bf2f(RAW[q][5]) : 0.f) - x_); \
    x_ = bf2f(RAW[q][6]);                                                               \
    const float v_ = x_ + mpv * ((hp_ ? bf2f(RAW[q][7]) : 0.f) - x_) + mnv * ((hn_ ? bf2f(RAW[q][8]) : 0.f) - x_);  \
    const float a_ = bf2f(RAW[q][10]);                                                  \
    const float kk_ = kr_ * kkw * SC[q].x;                                              \
    const float k2_ = kr_ * (1.f + (a_ - 1.f) * kaw);                                   \
    float* sb_ = st + (BUF) * (16 * SST) + s_ * SST;                                    \
    sb_[lane] = __expf(bf2f(RAW[q][9]));                                                \
    sb_[64 + lane] = -kk_;                                                              \
    sb_[128 + lane] = kk_ * a_;                                                         \
    sb_[192 + lane] = k2_;                                                              \
    sb_[256 + lane] = r_;                                                               \
    sb_[320 + lane] = v_;                                                               \
    if (lane == 0) sb_[384] = SC[q].y;                                                  \
  }
#define RW_MAIN(CH)                                                                     \
  {                                                                                     \
    const int buf = (CH) & 1;                                                           \
    const float* sbase = st + buf * (16 * SST);                                         \
    float* yb = ybuf + buf * (16 * 16 * RPL);                                           \
    StepV<RPL> cur, nxt;                                                                \
    step_load<RPL>(cur, sbase, jl, rowbase);                                            \
    _Pragma("unroll 16") for (int s = 0; s < 16; ++s) {                                  \
      step_load<RPL>(nxt, sbase + ((s + 1) & 15) * SST, jl, rowbase);                   \
      const f32x2 w01 = {cur.w.x, cur.w.y}, w23 = {cur.w.z, cur.w.w};                   \
      const f32x2 n01 = {cur.nk.x, cur.nk.y}, n23 = {cur.nk.z, cur.nk.w};               \
      const f32x2 a01 = {cur.ka.x, cur.ka.y}, a23 = {cur.ka.z, cur.ka.w};               \
      const f32x2 k01 = {cur.k.x, cur.k.y}, k23 = {cur.k.z, cur.k.w};                   \
      const f32x2 r01 = {cur.r.x, cur.r.y}, r23 = {cur.r.z, cur.r.w};                   \
      _Pragma("unroll") for (int r = 0; r < RPL; ++r) {                                 \
        f32x2 pz2 = S01[r] * n01;                                                       \
        pz2 = S23[r] * n23 + pz2;                                                       \
        float sa = pz2.x + pz2.y;                                                       \
        const f32x2 vv = {cur.v[r], cur.v[r]};                                          \
        f32x2 b01 = S01[r] * w01;                                                       \
        f32x2 b23 = S23[r] * w23;                                                       \
        b01 = vv * k01 + b01;                                                           \
        b23 = vv * k23 + b23;                                                           \
        f32x2 y2 = b01 * r01;                                                           \
        y2 = b23 * r23 + y2;                                                            \
        float yb_ = y2.x + y2.y;                                                        \
        row16_sum2(sa, yb_);                                                            \
        const f32x2 sa2 = {sa, sa};                                                     \
        S01[r] = sa2 * a01 + b01;                                                       \
        S23[r] = sa2 * a23 + b23;                                                       \
        const float y = yb_ + sa * cur.kar;                                             \
        yb[s * (16 * RPL) + ywoff + r] = y;                                             \
      }                                                                                 \
      cur = nxt;                                                                        \
    }                                                                                   \
  }
#define RW_FLUSH(CH)                                                                    \
  {                                                                                     \
    const float* yb = ybuf + ((CH) & 1) * (16 * 16 * RPL);                              \
    const int s = tid >> 4, rl = (tid & 15) * RPL;                                      \
    const int tt = (CH) * 16 + s;                                                       \
    const int t = dir ? (T - 1 - tt) : tt;                                              \
    bf16_t* yo = yout + (size_t)(tb + t) * 512 + head * 64 + split * 16 * RPL + rl;     \
    if (RPL == 1) yo[0] = f2bf(yb[s * 16 + rl]);                                        \
    else if (RPL == 2) *(unsigned*)yo = pack2(yb[s * 32 + rl], yb[s * 32 + rl + 1]);    \
    else { uint2 u; u.x = pack2(yb[s * 64 + rl], yb[s * 64 + rl + 1]); u.y = pack2(yb[s * 64 + rl + 2], yb[s * 64 + rl + 3]); *(uint2*)yo = u; } \
  }

  RW_LOAD(rawA, scA, 0);
  RW_STAGE(rawA, scA, 0, 0);
  __syncthreads();
  for (int ch = 0; ch < nch; ++ch) {
    if (ch + 1 < nch) { RW_LOAD(rawA, scA, ch + 1); }
    RW_MAIN(ch);
    if (ch + 1 < nch) { RW_STAGE(rawA, scA, ch + 1, (ch + 1) & 1); }
    __syncthreads();
    RW_FLUSH(ch);
  }
#undef RW_MAIN
#undef RW_FLUSH
#undef RW_LOAD
#undef RW_STAGE
}

DEV void phase_rw_pre(const Params& p) {
  const bf16_t* proj = (const bf16_t*)(p.ws + O_H);
  const bf16_t* ap = (const bf16_t*)(p.ws + O_DER) + 2 * SLAB;
  float* scal = (float*)(p.ws + O_BONUS);
  const int lane = threadIdx.x & 63;
  const int gw = blockIdx.x * 4 + (threadIdx.x >> 6), nw = gridDim.x * 4;
  for (int t = gw; t < NTOK; t += nw) {
    int tb, T;
    seq_of_token(t, tb, T);
    const bool hp = t > tb, hn = t < tb + T - 1;
    const int op = hp ? -RW_LD : 0, on = hn ? RW_LD : 0;
    const bf16_t* row = proj + (size_t)t * RW_LD + lane;
    bf16_t raw[8][7];
#pragma unroll
    for (int h = 0; h < 8; ++h) {
      raw[h][0] = row[h * 64];
      raw[h][1] = row[h * 64 + op];
      raw[h][2] = row[h * 64 + on];
      raw[h][3] = row[512 + h * 64];
      raw[h][4] = row[512 + h * 64 + op];
      raw[h][5] = row[512 + h * 64 + on];
      raw[h][6] = ap[(size_t)t * 512 + h * 64 + lane];
    }
#pragma unroll
    for (int h = 0; h < 8; ++h) {
      const int hc = h * 64 + lane;
      float x = bf2f(raw[h][0]);
      const float r = x + p.in[14][hc] * ((hp ? bf2f(raw[h][1]) : 0.f) - x) + p.in[15][hc] * ((hn ? bf2f(raw[h][2]) : 0.f) - x);
      x = bf2f(raw[h][3]);
      const float kr = x + p.in[14][512 + hc] * ((hp ? bf2f(raw[h][4]) : 0.f) - x) + p.in[15][512 + hc] * ((hn ? bf2f(raw[h][5]) : 0.f) - x);
      const float a = bf2f(raw[h][6]);
      const float kkr = kr * p.in[23][hc];
      const float inv = rsqrtf(fmaxf(wave_sum_dpp(kkr * kkr), 1e-24f));
      const float kk = kkr * inv;
      const float k2 = kr * (1.f + (a - 1.f) * p.in[24][hc]);
      const float kar = wave_sum_dpp(kk * a * r);
      const float bo = wave_sum_dpp(r * k2 * p.in[25][hc]);
      if (lane == 0) *(float4*)(scal + ((size_t)t * 8 + h) * 4) = make_float4(inv, kar, bo, 0.f);
    }
  }
}

DEV void phase_rw_scan(const Params& p, char* smem) {
  float* st = (float*)smem;
  for (int item = blockIdx.x; item < 512; item += gridDim.x) {
    __syncthreads();
    if (item < 256) {
      const int scan = item >> 2, split = item & 3;
      const int sq = scan >> 4, head = (scan >> 1) & 7, dir = scan & 1;
      __builtin_amdgcn_s_setprio(3);
      rwkv_scan<1>(p, NPROMPT + sq * 8192, 8192, head, dir, split, st);
      __builtin_amdgcn_s_setprio(0);
    } else {
      const int it = item - 256;
      const int scan = it >> 1, split = it & 1;
      const int sq = scan >> 4, head = (scan >> 1) & 7, dir = scan & 1;
      rwkv_scan<2>(p, sq * 2048, 2048, head, dir, split, st);
    }
  }
}

DEV void phase_rw_post(const Params& p) {
  const bf16_t* proj = (const bf16_t*)(p.ws + O_H);
  bf16_t* yf = (bf16_t*)(p.ws + O_XB);
  const bf16_t* yb = yf + SLAB;
  const bf16_t* gate = (const bf16_t*)(p.ws + O_DER) + 2 * SLAB;
  const float* scal = (const float*)(p.ws + O_BONUS);
  const int lane = threadIdx.x & 63;
  const int gw = blockIdx.x * 4 + (threadIdx.x >> 6), nw = gridDim.x * 4;
  for (int t = gw; t < NTOK; t += nw) {
    int tb, T;
    seq_of_token(t, tb, T);
    const bool hp = t > tb, hn = t < tb + T - 1;
    const int op = hp ? -RW_LD : 0, on = hn ? RW_LD : 0;
    const bf16_t* vrow = proj + (size_t)t * RW_LD + 1024 + lane;
    bf16_t raw[8][6];
    float bo[8];
#pragma unroll
    for (int h = 0; h < 8; ++h) {
      const size_t o = (size_t)t * 512 + h * 64 + lane;
      raw[h][0] = yf[o];
      raw[h][1] = yb[o];
      raw[h][2] = vrow[h * 64];
      raw[h][3] = vrow[h * 64 + op];
      raw[h][4] = vrow[h * 64 + on];
      raw[h][5] = gate[o];
      bo[h] = scal[((size_t)t * 8 + h) * 4 + 2];
    }
    bf16_t res[8];
#pragma unroll
    for (int h = 0; h < 8; ++h) {
      const int hc = h * 64 + lane;
      const float y = bf2f(raw[h][0]) + bf2f(raw[h][1]);
      const float mu = wave_sum_dpp(y) * (1.f / 64.f);
      const float dy = y - mu;
      const float var = wave_sum_dpp(dy * dy) * (1.f / 64.f);
      const float yn = dy * rsqrtf(var + 64e-5f) * p.in[26][hc] + p.in[27][hc];
      const float x = bf2f(raw[h][2]);
      const float v = x + p.in[14][1024 + hc] * ((hp ? bf2f(raw[h][3]) : 0.f) - x) + p.in[15][1024 + hc] * ((hn ? bf2f(raw[h][4]) : 0.f) - x);
      res[h] = f2bf((yn + bo[h] * v) * bf2f(raw[h][5]));
    }
#pragma unroll
    for (int h = 0; h < 8; ++h) yf[(size_t)t * 512 + h * 64 + lane] = res[h];
  }
}

DEV int seq_of_rowtile(int rt) { return rt < 64 ? (rt >> 3) : 8 + ((rt - 64) >> 5); }

DEV void phase_ca_qkv(const Params& p, char* smem) {
  const bf16_t* xb = (const bf16_t*)(p.ws + O_XB);
  bf16_t* qb = (bf16_t*)(p.ws + O_H);
  const bf16_t* memb = (const bf16_t*)(p.ws + O_MEMB);
  bf16_t* kb = (bf16_t*)(p.ws + O_KB);
  bf16_t* vt = (bf16_t*)(p.ws + O_VT);
  const bf16_t* wq = (const bf16_t*)(p.ws + W_B_Q);
  const bf16_t* wkv = (const bf16_t*)(p.ws + W_B_KV);
  {
    int rt, ct;
    for (int it = 0; tile_map(it, 8, rt, ct); ++it) {
      const int r0 = rt * TM, c0 = ct * 128;
      gemm_tile(xb + (size_t)r0 * DM, DM, nullptr, 0, DM, wq + (size_t)c0 * DM, DM, DM, smem,
                [&](int ru, int rl, int c, float v0, float v1) {
                  bf16_t* o = qb + (size_t)(r0 + ru) * DM + c0;
                  const unsigned off = (unsigned)(rl * DM + c);
                  o[off] = f2bf(v0); o[off + 32] = f2bf(v1);
                });
    }
  }
  {
    for (int t2 = blockIdx.x; t2 < 12 * 16; t2 += gridDim.x) {
      const int rt = t2 >> 4, ct = t2 & 15;
      const int r0 = rt * TM, c0 = ct * 128;
      if (ct < 8) {
        bf16_t* o = kb + (size_t)r0 * DM + c0;
        gemm_tile(memb + (size_t)r0 * DM, DM, nullptr, 0, DM, wkv + (size_t)c0 * DM, DM, DM, smem,
                  [&](int ru, int rl, int c, float v0, float v1) {
                    const unsigned off = (unsigned)(rl * DM + c);
                    (o + ru * DM)[off] = f2bf(v0);
                    (o + ru * DM)[off + 32] = f2bf(v1);
                  });
      } else {
        bf16_t* o = vt + ((size_t)rt * 1024 + (c0 - 1024)) * 256;
        gemm_tile(memb + (size_t)r0 * DM, DM, nullptr, 0, DM, wkv + (size_t)c0 * DM, DM, DM, smem,
                  [&](int ru, int rl, int c, float v0, float v1) {
                    const unsigned off = (unsigned)(c * 256 + rl);
                    (o + ru)[off] = f2bf(v0);
                    (o + ru)[off + 32 * 256] = f2bf(v1);
                  });
      }
    }
  }
}
DEV void phase_ca_scores(const Params& p, char* smem) {
  const bf16_t* qb = (const bf16_t*)(p.ws + O_H);
  const bf16_t* kb = (const bf16_t*)(p.ws + O_KB);
  float* sc = (float*)(p.ws + O_SCORES);
  int rt, ct8;
  for (int it = 0; tile_map(it, 8, rt, ct8); ++it) {
    const int h = ct8 >> 1, nt = ct8 & 1;
    const int b = seq_of_rowtile(rt), r0 = rt * TM;
    gemm_tile(qb + (size_t)r0 * DM + h * 256, DM, nullptr, 0, 256,
              kb + (size_t)(b * 256 + nt * 128) * DM + h * 256, DM, 256, smem,
              [&](int ru, int rl, int c, float v0, float v1) {
                float* o = sc + (size_t)(r0 + ru) * DM + h * 256 + nt * 128;
                const unsigned off = (unsigned)(rl * DM + c);
                o[off] = v0 * 0.0625f; o[off + 32] = v1 * 0.0625f;
              });
  }
}
DEV void phase_ca_softmax(const Params& p) {
  const float* sc = (const float*)(p.ws + O_SCORES);
  bf16_t* pb = (bf16_t*)(p.ws + O_H);
  const int lane = threadIdx.x & 63;
  const int gw = blockIdx.x * 4 + (threadIdx.x >> 6), nw = gridDim.x * 4;
  const int total = NTOK * 4;
  for (int it = gw; it < total; it += 4 * nw) {
    float4 v[4];
#pragma unroll
    for (int u = 0; u < 4; ++u) {
      const int i2 = it + u * nw;
      v[u] = *(const float4*)(sc + (size_t)(i2 < total ? i2 : it) * 256 + lane * 4);
    }
#pragma unroll
    for (int u = 0; u < 4; ++u) {
      const int i2 = it + u * nw;
      float mx = fmaxf(fmaxf(v[u].x, v[u].y), fmaxf(v[u].z, v[u].w));
      mx = fmaxf(mx, dppf<0x128>(mx)); mx = fmaxf(mx, dppf<0x124>(mx)); mx = fmaxf(mx, dppf<0x122>(mx)); mx = fmaxf(mx, dppf<0x121>(mx));
      {
        const int xi = __builtin_bit_cast(int, mx);
        const float m0 = __builtin_bit_cast(float, __builtin_amdgcn_readlane(xi, 0));
        const float m1 = __builtin_bit_cast(float, __builtin_amdgcn_readlane(xi, 16));
        const float m2 = __builtin_bit_cast(float, __builtin_amdgcn_readlane(xi, 32));
        const float m3 = __builtin_bit_cast(float, __builtin_amdgcn_readlane(xi, 48));
        mx = fmaxf(fmaxf(m0, m1), fmaxf(m2, m3));
      }
      const float e0 = __expf(v[u].x - mx), e1 = __expf(v[u].y - mx), e2 = __expf(v[u].z - mx), e3 = __expf(v[u].w - mx);
      const float inv = 1.f / wave_sum_dpp(e0 + e1 + e2 + e3);
      if (i2 < total) {
        uint2 w;
        w.x = pack2(e0 * inv, e1 * inv);
        w.y = pack2(e2 * inv, e3 * inv);
        *(uint2*)(pb + (size_t)i2 * 256 + lane * 4) = w;
      }
    }
  }
}
DEV void phase_ca_pv(const Params& p, char* smem) {
  const bf16_t* pb = (const bf16_t*)(p.ws + O_H);
  const bf16_t* vt = (const bf16_t*)(p.ws + O_VT);
  bf16_t* attn = (bf16_t*)(p.ws + O_XB);
  int rt, ct8;
  for (int it = 0; tile_map(it, 8, rt, ct8); ++it) {
    const int h = ct8 >> 1, nt = ct8 & 1;
    const int b = seq_of_rowtile(rt), r0 = rt * TM;
    gemm_tile(pb + (size_t)r0 * DM + h * 256, DM, nullptr, 0, 256,
              vt + ((size_t)b * 1024 + h * 256 + nt * 128) * 256, 256, 256, smem,
              [&](int ru, int rl, int c, float v0, float v1) {
                bf16_t* o = attn + (size_t)(r0 + ru) * DM + h * 256 + nt * 128;
                const unsigned off = (unsigned)(rl * DM + c);
                o[off] = f2bf(v0); o[off + 32] = f2bf(v1);
              });
  }
}

DEV void phase_convert_x(const Params& p) {
  bf16_t* xb = (bf16_t*)(p.ws + O_XB);
  const size_t n4 = (size_t)NTOK * DM / 4;
  const size_t np4 = (size_t)NPROMPT * DM / 4;
  const size_t stride = (size_t)gridDim.x * 256;
  for (size_t i = (size_t)blockIdx.x * 256 + threadIdx.x; i < n4; i += 8 * stride) {
    float4 v[8];
#pragma unroll
    for (int u = 0; u < 8; ++u) {
      size_t j = i + u * stride;
      if (j >= n4) j = i;
      v[u] = j < np4 ? ((const float4*)p.in[0])[j] : ((const float4*)p.in[1])[j - np4];
    }
#pragma unroll
    for (int u = 0; u < 8; ++u) {
      const size_t j = i + u * stride;
      if (j < n4) {
        uint2 w;
        w.x = pack2(v[u].x, v[u].y);
        w.y = pack2(v[u].z, v[u].w);
        ((uint2*)xb)[j] = w;
      }
    }
  }
}

constexpr int NPHASE = 25;
constexpr int SMEM_BYTES = 64 * 1024;

DEV void run_phase(const Params& p, int ph, char* smem) {
  char* ws = p.ws;
    switch (ph) {
      case 0:
        wconv(p.in[4], 2 * DFF, DM, 2 * DFF, 1, 0, (bf16_t*)(ws + W_A_FFN_IN), smem);
        wconv(p.in[5], DM, DFF, DM, 0, 0, (bf16_t*)(ws + W_A_FFN_OUT), smem);
        wconv(p.in[8], 3424, DM, 1568, 0, 0, (bf16_t*)(ws + W_A_MIX_IN), smem);
        wconv(p.in[8], 3424, DM, 1856, 0, 1568, (bf16_t*)(ws + W_A_MIX_IN) + (size_t)1664 * DM, smem);
        wconv(p.in[17], 512, 64, 512, 0, 0, (bf16_t*)(ws + W_A_UPF), smem);
        wconv(p.in[19], 512, 64, 512, 0, 0, (bf16_t*)(ws + W_A_UPB), smem);
        wconv(p.in[21], 512, 64, 512, 0, 0, (bf16_t*)(ws + W_A_AUP), smem);
        wconv(p.in[22], 512, 128, 512, 0, 0, (bf16_t*)(ws + W_A_GUP), smem);
        phase_convert_x(p);
        break;
      case 1: phase_ffn_in(p, (const bf16_t*)(ws + W_A_FFN_IN), smem); break;
      case 2: phase_gemm_res(p, (const bf16_t*)(ws + O_H), DFF, nullptr, 0, DFF, DFF, (const bf16_t*)(ws + W_A_FFN_OUT), 0.5f, true, smem); break;
      case 3: phase_ln(p, p.in[6], p.in[7], true, false); break;
      case 4: phase_gemm_bf16((const bf16_t*)(ws + O_XB), DM, (const bf16_t*)(ws + W_A_MIX_IN), DM, 1568, (bf16_t*)(ws + O_H), GLA_LD, smem); break;
      case 5: phase_gla_a(p, smem); break;
      case 6: phase_gla_b(p); break;
      case 7: phase_gla_c(p, smem); break;
      case 8: phase_gemm_bf16((const bf16_t*)(ws + O_XB), DM, (const bf16_t*)(ws + W_A_MIX_IN) + (size_t)1664 * DM, DM, 1856, (bf16_t*)(ws + O_H), RW_LD, smem); break;
      case 9: phase_rw_act(p); break;
      case 10: phase_rw_lowrank(p, smem); break;
      case 11: phase_rw_pre(p); break;
      case 12: phase_rw_scan(p, smem); break;
      case 13: phase_gemm_bf16((const bf16_t*)(ws + O_ACTG), 128, (const bf16_t*)(ws + W_A_GUP), 128, 512, (bf16_t*)(ws + O_DER) + 2 * SLAB, 512, smem); break;
      case 14:
        phase_rw_post(p);
        wconv(p.in[28], DM, DM, DM, 0, 0, (bf16_t*)(ws + W_B_MIX_OUT), smem);
        wconv(p.in[33], DM, DM, DM, 0, 0, (bf16_t*)(ws + W_B_Q), smem);
        wconv(p.in[34], 2 * DM, DM, 2 * DM, 0, 0, (bf16_t*)(ws + W_B_KV), smem);
        wconv(p.in[35], DM, DM, DM, 0, 0, (bf16_t*)(ws + W_B_O), smem);
        wconv(p.in[38], 2 * DFF, DM, 2 * DFF, 1, 0, (bf16_t*)(ws + W_B_FFN_IN), smem);
        wconv(p.in[39], DM, DFF, DM, 0, 0, (bf16_t*)(ws + W_B_FFN_OUT), smem);
        break;
      case 15: phase_gemm_res(p, (const bf16_t*)(ws + O_MIXG), 512, (const bf16_t*)(ws + O_XB), 512, 512, DM, (const bf16_t*)(ws + W_B_MIX_OUT), 1.0f, false, smem); break;
      case 16: phase_ln(p, p.in[29], p.in[30], true, true); break;
      case 17: phase_ca_qkv(p, smem); break;
      case 18: phase_ca_scores(p, smem); break;
      case 19: phase_ca_softmax(p); break;
      case 20: phase_ca_pv(p, smem); break;
      case 21: phase_gemm_res(p, (const bf16_t*)(ws + O_XB), DM, nullptr, 0, DM, DM, (const bf16_t*)(ws + W_B_O), 1.0f, false, smem); break;
      case 22: phase_ln(p, p.in[36], p.in[37], true, false); break;
      case 23: phase_ffn_in(p, (const bf16_t*)(ws + W_B_FFN_IN), smem); break;
      case 24: phase_gemm_res(p, (const bf16_t*)(ws + O_H), DFF, nullptr, 0, DFF, DFF, (const bf16_t*)(ws + W_B_FFN_OUT), 0.5f, false, smem); break;
      case 25: phase_ln(p, p.in[40], p.in[41], false, false); break;
      default: break;
    }
}

constexpr size_t O_BAR = 463 * MiB + 768 * 1024;
#define XB_TMO      128
#define XB_XCNT(j)  (256  + 64 * (j))
#define XB_XSUB(j)  (1280 + 64 * (j))
#define XB_XGEN(j)  (2304 + 64 * (j))
#define XB_TOP      3328
#define XB_TOPGEN   3392
#define XCD_BAR_WORDS 3456
#define XB_SPIN_CAP (1u << 18)
#define LAS __attribute__((address_space(3)))

__device__ __forceinline__ unsigned xb_ld(unsigned* p)              { return __hip_atomic_load(p, __ATOMIC_RELAXED, __HIP_MEMORY_SCOPE_AGENT); }
__device__ __forceinline__ unsigned xb_add(unsigned* p, unsigned v) { return __hip_atomic_fetch_add(p, v, __ATOMIC_RELAXED, __HIP_MEMORY_SCOPE_AGENT); }
__device__ __forceinline__ unsigned xb_xcc_id() { return (unsigned)__builtin_amdgcn_s_getreg((3 << 11) | 20) & 0xFu; }
#define XB_SPIN(cond, bar) do { unsigned _sp = 0; while (cond) { __builtin_amdgcn_s_sleep(1); \
    if ((++_sp & 255u) == 0u) { if (xb_ld(&(bar)[XB_TMO])) break; if (_sp > XB_SPIN_CAP) { atomicAdd(&(bar)[XB_TMO], 1u); break; } } } } while (0)

struct XcdBarrier {
    unsigned* bar; unsigned x;
    volatile LAS unsigned* st;
};

__device__ __forceinline__ XcdBarrier xcd_barrier_post(unsigned* bar, volatile LAS unsigned* st) {
    XcdBarrier b; b.bar = bar; b.x = xb_xcc_id(); b.st = st;
    if (threadIdx.x == 0) (void)xb_add(&bar[XB_XCNT(b.x)], 1u);
    return b;
}
__device__ __forceinline__ void xcd_barrier_complete(unsigned* bar, unsigned x, unsigned& nloc, unsigned& nx) {
    const unsigned G = gridDim.x * gridDim.y * gridDim.z;
    unsigned sum, cnt, mine, sp = 0u;
    for (;;) {
        sum = 0u; cnt = 0u; mine = 0u;
#pragma unroll
        for (unsigned j = 0; j < 16; ++j) { const unsigned c = xb_ld(&bar[XB_XCNT(j)]); sum += c; cnt += (c > 0u) ? 1u : 0u; mine = (j == x) ? c : mine; }
        if (sum == G) break;
        __builtin_amdgcn_s_sleep(1);
        if ((++sp & 255u) == 0u) { if (xb_ld(&bar[XB_TMO])) break; if (sp > XB_SPIN_CAP) { atomicAdd(&bar[XB_TMO], 1u); break; } }
    }
    nloc = mine > 0u ? mine : 1u; nx = cnt > 0u ? cnt : 1u;
}

__device__ __forceinline__ void xcd_barrier(const XcdBarrier& b) {
    asm volatile("s_waitcnt vmcnt(0)" ::: "memory");
    __syncthreads();
    if (threadIdx.x == 0) {
        unsigned* bar = b.bar;
        __builtin_amdgcn_s_waitcnt(0);
        unsigned nloc = b.st[0], nx = b.st[1];
        if (nloc == 0u) { xcd_barrier_complete(bar, b.x, nloc, nx); b.st[0] = nloc; b.st[1] = nx; }
        const unsigned old = xb_add(&bar[XB_XSUB(b.x)], 1u);
        const unsigned gen = old / nloc;
        if (old + 1u == (gen + 1u) * nloc) {
            __builtin_amdgcn_fence(__ATOMIC_RELEASE, "agent");
            asm volatile("s_waitcnt vmcnt(0)" ::: "memory");
            const unsigned og = xb_add(&bar[XB_TOP], 1u);
            const unsigned tg = og / nx;
            if (og + 1u == (tg + 1u) * nx) xb_add(&bar[XB_TOPGEN], 1u);
            else XB_SPIN(xb_ld(&bar[XB_TOPGEN]) == tg, bar);
            __builtin_amdgcn_fence(__ATOMIC_ACQUIRE, "agent");
            xb_add(&bar[XB_XGEN(b.x)], 1u);
            asm volatile("s_waitcnt vmcnt(0)" ::: "memory");
        } else {
            XB_SPIN(xb_ld(&bar[XB_XGEN(b.x)]) == gen, bar);
            __builtin_amdgcn_fence(__ATOMIC_ACQUIRE, "agent");
            asm volatile("s_waitcnt vmcnt(0)" ::: "memory");
        }
    }
    __syncthreads();
}

#define PHASE_STEP(N) if (ph_lo <= N && N < ph_hi) { for (int rep = 0; rep <= (int)((dup >> N) & 1u); ++rep) { run_phase(p, N, smem); if (N + 1 < ph_hi) { if (ph_lo < 0) grid.sync(); else { XcdBarrier xb_; xb_.bar = (unsigned*)(p.ws + O_BAR); xb_.st = (volatile LAS unsigned*)&xb_words; xb_.x = xb_.st[2]; xcd_barrier(xb_); } } } }
__global__ void __launch_bounds__(256, 2) mega(Params p, int ph_lo, int ph_hi, unsigned dup) {
  __shared__ __attribute__((aligned(16))) char smem[SMEM_BYTES];
  cg::grid_group grid = cg::this_grid();
  __shared__ uint4 xb_words;
  if (threadIdx.x == 0) xb_words = make_uint4(0u, 0u, 0u, 0u);
  __syncthreads();
  if (ph_hi - ph_lo > 1) {
    XcdBarrier xb = xcd_barrier_post((unsigned*)(p.ws + O_BAR), (volatile LAS unsigned*)&xb_words);
    if (threadIdx.x == 0) xb_words.z = xb.x;
    __syncthreads();
  }
  PHASE_STEP(0)
  PHASE_STEP(1)
  PHASE_STEP(2)
  PHASE_STEP(3)
  PHASE_STEP(4)
  PHASE_STEP(5)
  PHASE_STEP(6)
  PHASE_STEP(7)
  PHASE_STEP(8)
  PHASE_STEP(9)
  PHASE_STEP(10)
  PHASE_STEP(11)
  PHASE_STEP(12)
  PHASE_STEP(13)
  PHASE_STEP(14)
  PHASE_STEP(15)
  PHASE_STEP(16)
  PHASE_STEP(17)
  PHASE_STEP(18)
  PHASE_STEP(19)
  PHASE_STEP(20)
  PHASE_STEP(21)
  PHASE_STEP(22)
  PHASE_STEP(23)
  PHASE_STEP(24)
  PHASE_STEP(25)
}

#ifdef PHASE_TEST
template <int PH> __global__ void __launch_bounds__(256, 2) mega_t(Params p) {
  __shared__ __attribute__((aligned(16))) char smem[SMEM_BYTES];
  run_phase(p, PH, smem);
}
template __global__ void mega_t<0>(Params);
template __global__ void mega_t<1>(Params);
template __global__ void mega_t<2>(Params);
template __global__ void mega_t<3>(Params);
template __global__ void mega_t<4>(Params);
template __global__ void mega_t<5>(Params);
template __global__ void mega_t<6>(Params);
template __global__ void mega_t<7>(Params);
template __global__ void mega_t<8>(Params);
template __global__ void mega_t<9>(Params);
template __global__ void mega_t<10>(Params);
template __global__ void mega_t<11>(Params);
template __global__ void mega_t<12>(Params);
template __global__ void mega_t<13>(Params);
template __global__ void mega_t<14>(Params);
template __global__ void mega_t<15>(Params);
template __global__ void mega_t<16>(Params);
template __global__ void mega_t<17>(Params);
template __global__ void mega_t<18>(Params);
template __global__ void mega_t<19>(Params);
template __global__ void mega_t<20>(Params);
template __global__ void mega_t<21>(Params);
template __global__ void mega_t<22>(Params);
template __global__ void mega_t<23>(Params);
template __global__ void mega_t<24>(Params);
template __global__ void mega_t<25>(Params);
#endif

extern "C" void kernel_launch(void* const* d_in, const int* in_sizes, int n_in, void* d_out, int out_size,
                              void* d_ws, size_t ws_size, hipStream_t stream) {
  if (ws_size < WS_NEED || n_in < 42) {
    fprintf(stderr, "kernel_launch: workspace too small (%zu) or inputs missing (%d)\n", ws_size, n_in);
    return;
  }
  static int grid_blocks = 0;
  if (!grid_blocks) {
    int dev = 0, cus = 0, per_cu = 0;
    hipGetDevice(&dev);
    hipDeviceGetAttribute(&cus, hipDeviceAttributeMultiprocessorCount, dev);
    hipOccupancyMaxActiveBlocksPerMultiprocessor(&per_cu, mega, 256, 0);
    if (per_cu > 2) per_cu = 2;
    if (per_cu < 1) per_cu = 1;
    grid_blocks = cus * per_cu;
  }
  Params p{};
  for (int i = 0; i < 42; ++i) p.in[i] = (const float*)d_in[i];
  p.out = (float*)d_out;
  p.ws = (char*)d_ws;
  const int nph = NPHASE + 1;
#if MULTI_LAUNCH
  for (int ph = 0; ph < nph; ++ph) {
    hipLaunchKernelGGL(mega, dim3(grid_blocks), dim3(256), 0, stream, p, ph, ph + 1, 0u);
  }
#else
#ifndef PROBE_DUP
#define PROBE_DUP 0u
#endif
  hipMemsetAsync((char*)d_ws + O_BAR, 0, XCD_BAR_WORDS * 4, stream);
  int lo = 0, hi = nph;
  unsigned dup = PROBE_DUP;
  void* args[] = {&p, &lo, &hi, &dup};
  hipError_t e = hipLaunchCooperativeKernel((void*)mega, dim3(grid_blocks), dim3(256), args, 0, stream);
  if (e != hipSuccess) fprintf(stderr, "cooperative launch failed: %s (grid %d)\n", hipGetErrorString(e), grid_blocks);
#endif
}
```

```cpp
#include <hip/hip_runtime.h>
#include <hip/hip_bf16.h>
#include <hip/hip_cooperative_groups.h>
#include <cstdio>
namespace cg = cooperative_groups;

#ifndef MULTI_LAUNCH
#define MULTI_LAUNCH 0
#endif

typedef unsigned short bf16_t;
using bf16x8 = __attribute__((ext_vector_type(8))) short;
using f32x16 = __attribute__((ext_vector_type(16))) float;
using u32x4 = __attribute__((ext_vector_type(4))) unsigned;
using f32x2 = __attribute__((ext_vector_type(2))) float;
using f32x4v = __attribute__((ext_vector_type(4))) float;

#define DEV __device__ __forceinline__

constexpr int NTOK = 49152;
constexpr int NPROMPT = 16384;
constexpr int DM = 1024;
constexpr int DFF = 2816;
constexpr int GLA_LD = 1568;
constexpr int RW_LD = 1856;
constexpr float ALPHA = 1.189207115002721f;
constexpr size_t MiB = 1ull << 20;
constexpr size_t SLAB = (size_t)NTOK * 512;

constexpr size_t W_A_FFN_IN = 0, W_A_FFN_OUT = 11 * MiB, W_A_MIX_IN = 17 * MiB, W_A_UPF = 24 * MiB,
                 W_A_UPB = 24 * MiB + 65536, W_A_AUP = 24 * MiB + 2 * 65536, W_A_GUP = 24 * MiB + 3 * 65536;
constexpr size_t W_B_MIX_OUT = 0, W_B_Q = 2 * MiB, W_B_KV = 4 * MiB, W_B_O = 8 * MiB, W_B_FFN_IN = 10 * MiB, W_B_FFN_OUT = 21 * MiB;
constexpr size_t O_XB = 27 * MiB;
constexpr size_t O_H = 123 * MiB;
constexpr size_t O_KV = 270 * MiB;
constexpr size_t O_DEC = 462 * MiB;
constexpr size_t O_DER = 297 * MiB;
constexpr size_t O_ACTG = 441 * MiB;
constexpr size_t O_BONUS = 453 * MiB;
constexpr size_t O_MIXG = 464 * MiB;
constexpr size_t O_MEMB = 219 * MiB, O_KB = 225 * MiB, O_VT = 231 * MiB, O_SCORES = 237 * MiB;
constexpr size_t WS_NEED = 512 * MiB;

struct Params {
  const float* in[42];
  float* out;
  char* ws;
};

DEV bf16_t f2bf(float f) { return __builtin_bit_cast(bf16_t, (__bf16)f); }
DEV float bf2f(bf16_t b) { return __uint_as_float(((unsigned)b) << 16); }
typedef __bf16 nbf2_t __attribute__((ext_vector_type(2)));
typedef float nf2_t __attribute__((ext_vector_type(2)));
DEV unsigned pack2(float a, float b) {
  const nf2_t v = {a, b};
  return __builtin_bit_cast(unsigned, __builtin_convertvector(v, nbf2_t));
}
DEV float sigm(float x) { return __builtin_amdgcn_rcpf(1.f + __expf(-x)); }
DEV float tanh_fast(float x) { return 1.f - 2.f * __builtin_amdgcn_rcpf(1.f + __expf(2.f * x)); }
DEV float silu(float x) { return x * sigm(x); }
DEV float logsig(float x) { return fminf(x, 0.f) - __logf(1.f + __expf(-fabsf(x))); }
DEV float wave_sum(float v) {
#pragma unroll
  for (int o = 32; o > 0; o >>= 1) v += __shfl_xor(v, o);
  return v;
}
DEV float wave_max(float v) {
#pragma unroll
  for (int o = 32; o > 0; o >>= 1) v = fmaxf(v, __shfl_xor(v, o));
  return v;
}
template <int CTRL> DEV float dppf(float x) {
  return __builtin_bit_cast(float, __builtin_amdgcn_mov_dpp(__builtin_bit_cast(int, x), CTRL, 0xf, 0xf, true));
}
DEV float row16_sum(float x) {
  x += dppf<0x128>(x);
  x += dppf<0x124>(x);
  x += dppf<0x122>(x);
  x += dppf<0x121>(x);
  return x;
}
DEV void row16_sum2(float& a, float& b) {
  asm volatile("s_nop 1\n\tv_add_f32_dpp %0, %0, %0 row_ror:8 row_mask:0xf bank_mask:0xf\n\tv_add_f32_dpp %1, %1, %1 row_ror:8 row_mask:0xf bank_mask:0xf\n\t"
               "s_nop 1\n\tv_add_f32_dpp %0, %0, %0 row_ror:4 row_mask:0xf bank_mask:0xf\n\tv_add_f32_dpp %1, %1, %1 row_ror:4 row_mask:0xf bank_mask:0xf\n\t"
               "s_nop 1\n\tv_add_f32_dpp %0, %0, %0 row_ror:2 row_mask:0xf bank_mask:0xf\n\tv_add_f32_dpp %1, %1, %1 row_ror:2 row_mask:0xf bank_mask:0xf\n\t"
               "s_nop 1\n\tv_add_f32_dpp %0, %0, %0 row_ror:1 row_mask:0xf bank_mask:0xf\n\tv_add_f32_dpp %1, %1, %1 row_ror:1 row_mask:0xf bank_mask:0xf\n\t"
               "s_nop 0"
               : "+v"(a), "+v"(b));
}
DEV float wave_sum_dpp(float x) {
  x = row16_sum(x);
  const int xi = __builtin_bit_cast(int, x);
  const float s0 = __builtin_bit_cast(float, __builtin_amdgcn_readlane(xi, 0));
  const float s1 = __builtin_bit_cast(float, __builtin_amdgcn_readlane(xi, 16));
  const float s2 = __builtin_bit_cast(float, __builtin_amdgcn_readlane(xi, 32));
  const float s3 = __builtin_bit_cast(float, __builtin_amdgcn_readlane(xi, 48));
  return (s0 + s1) + (s2 + s3);
}
DEV void seq_of_token(int t, int& tb, int& T) {
  if (t < NPROMPT) { tb = t & ~2047; T = 2048; }
  else { int u = t - NPROMPT; tb = NPROMPT + (u & ~8191); T = 8192; }
}
DEV const float* xin_row(const Params& p, int row) {
  return row < NPROMPT ? p.in[0] + (size_t)row * DM : p.in[1] + (size_t)(row - NPROMPT) * DM;
}
DEV void unpack8(uint4 u, float* v) {
  v[0] = __uint_as_float(u.x << 16); v[1] = __uint_as_float(u.x & 0xffff0000u);
  v[2] = __uint_as_float(u.y << 16); v[3] = __uint_as_float(u.y & 0xffff0000u);
  v[4] = __uint_as_float(u.z << 16); v[5] = __uint_as_float(u.z & 0xffff0000u);
  v[6] = __uint_as_float(u.w << 16); v[7] = __uint_as_float(u.w & 0xffff0000u);
}

DEV void unpack8p(uint4 u, f32x2* v) {
  v[0] = (f32x2){__uint_as_float(u.x << 16), __uint_as_float(u.x & 0xffff0000u)};
  v[1] = (f32x2){__uint_as_float(u.y << 16), __uint_as_float(u.y & 0xffff0000u)};
  v[2] = (f32x2){__uint_as_float(u.z << 16), __uint_as_float(u.z & 0xffff0000u)};
  v[3] = (f32x2){__uint_as_float(u.w << 16), __uint_as_float(u.w & 0xffff0000u)};
}

constexpr int LDT = 72;

constexpr int TM = 256;
constexpr int NRT = NTOK / TM;
struct GRegs { u32x4 a0, a1, a2, a3, b0, b1; };
DEV void gemm_gload(GRegs& g, const bf16_t* A0, int lda0, const bf16_t* A1, int lda1, int ksplit,
                    const bf16_t* Bt, int ldb, int k0, int tid) {
  const bf16_t* Ab; int lda, kk;
  if (k0 < ksplit) { Ab = A0; lda = lda0; kk = k0; }
  else { Ab = A1; lda = lda1; kk = k0 - ksplit; }
  const int row = tid >> 2, kc = (tid & 3) * 8;
  const bf16_t* pa = Ab + (size_t)row * lda + kk + kc;
  const bf16_t* pb = Bt + (size_t)row * ldb + k0 + kc;
  g.a0 = *(const u32x4*)(pa);
  g.a1 = *(const u32x4*)(pa + (size_t)64 * lda);
  g.a2 = *(const u32x4*)(pa + (size_t)128 * lda);
  g.a3 = *(const u32x4*)(pa + (size_t)192 * lda);
  g.b0 = *(const u32x4*)(pb);
  g.b1 = *(const u32x4*)(pb + (size_t)64 * ldb);
}
DEV void gemm_lds_write(const GRegs& g, bf16_t* wa, bf16_t* wb) {
  *(u32x4*)(wa) = g.a0; *(u32x4*)(wa + 64 * 32) = g.a1; *(u32x4*)(wa + 128 * 32) = g.a2; *(u32x4*)(wa + 192 * 32) = g.a3;
  *(u32x4*)(wb) = g.b0; *(u32x4*)(wb + 64 * 32) = g.b1;
}

constexpr int GSA = 256 * 32;
constexpr int GST = (256 + 128) * 32;
template <bool RES, class Epi>
DEV void gemm_tile_x(const bf16_t* A0, int lda0, const bf16_t* A1, int lda1, int ksplit,
                     const bf16_t* Bt, int ldb, int K, char* smem, const float* resb, Epi epi) {
  bf16_t* sbase = (bf16_t*)smem;
  const int tid = threadIdx.x, lane = tid & 63, wv = tid >> 6;
  const int wm = wv >> 1, wn = wv & 1;
  f32x16 acc[4][2];
#pragma unroll
  for (int i = 0; i < 4; ++i)
#pragma unroll
    for (int j = 0; j < 2; ++j)
#pragma unroll
      for (int r = 0; r < 16; ++r) acc[i][j][r] = 0.f;
  GRegs g, g1;
  const int nk = K >> 5;
  const int woff = (tid >> 2) * 32 + (((tid & 3) ^ ((tid >> 4) & 3)) << 3);
  const int swz = (lane >> 2) & 3, hh = lane >> 5;
  const int raoff = (wm * 128 + (lane & 31)) * 32;
  const int rboff = GSA + (wn * 64 + (lane & 31)) * 32;
  const int ko0 = ((0 + hh) ^ swz) << 3, ko1 = ((2 + hh) ^ swz) << 3;

  __syncthreads();
  gemm_gload(g, A0, lda0, A1, lda1, ksplit, Bt, ldb, 0, tid);
  if (nk > 1) gemm_gload(g1, A0, lda0, A1, lda1, ksplit, Bt, ldb, 32, tid);
  gemm_lds_write(g, sbase + woff, sbase + GSA + woff);
  if (nk > 2) gemm_gload(g, A0, lda0, A1, lda1, ksplit, Bt, ldb, 64, tid);
  __syncthreads();
#define GEMM_COMPUTE(ST)                                                                                  \
  _Pragma("unroll") for (int ks = 0; ks < 2; ++ks) {                                                      \
    const int ko = ks ? ko1 : ko0;                                                                        \
    bf16x8 a[4], b[2];                                                                                    \
    _Pragma("unroll") for (int mi = 0; mi < 4; ++mi) a[mi] = *(const bf16x8*)((ST) + raoff + mi * 32 * 32 + ko); \
    _Pragma("unroll") for (int ni = 0; ni < 2; ++ni) b[ni] = *(const bf16x8*)((ST) + rboff + ni * 32 * 32 + ko); \
    _Pragma("unroll") for (int mi = 0; mi < 4; ++mi)                                                      \
      _Pragma("unroll") for (int ni = 0; ni < 2; ++ni)                                                    \
        acc[mi][ni] = __builtin_amdgcn_mfma_f32_32x32x16_bf16(a[mi], b[ni], acc[mi][ni], 0, 0, 0);        \
  }
  for (int kt = 0; kt < nk; kt += 2) {
    GEMM_COMPUTE(sbase);
    if (kt + 1 < nk) gemm_lds_write(g1, sbase + GST + woff, sbase + GST + GSA + woff);
    if (kt + 3 < nk) gemm_gload(g1, A0, lda0, A1, lda1, ksplit, Bt, ldb, (kt + 3) * 32, tid);
    __syncthreads();
    if (kt + 1 < nk) {
      GEMM_COMPUTE(sbase + GST);
      if (kt + 2 < nk) gemm_lds_write(g, sbase + woff, sbase + GSA + woff);
      if (kt + 4 < nk) gemm_gload(g, A0, lda0, A1, lda1, ksplit, Bt, ldb, (kt + 4) * 32, tid);
      __syncthreads();
    }
  }
#undef GEMM_COMPUTE
  const int rl = wm * 128 + 4 * (lane >> 5);
  const int col = wn * 64 + (lane & 31);
  const unsigned resoff = (unsigned)(rl * DM + col);
#pragma unroll
  for (int mi = 0; mi < 4; ++mi) {
#pragma unroll
    for (int rh = 0; rh < 2; ++rh) {
      float x0[8], x1[8];
      if (RES) {
#pragma unroll
        for (int r8 = 0; r8 < 8; ++r8) {
          const int r = rh * 8 + r8;
          const int ru = mi * 32 + (r & 3) + 8 * (r >> 2);
          const float* rp = resb + ru * DM;
          x0[r8] = rp[resoff];
          x1[r8] = rp[resoff + 32];
        }
      }
#pragma unroll
      for (int r8 = 0; r8 < 8; ++r8) {
        const int r = rh * 8 + r8;
        const int ru = mi * 32 + (r & 3) + 8 * (r >> 2);
        if (RES) epi(ru, rl, col, acc[mi][0][r], acc[mi][1][r], x0[r8], x1[r8]);
        else epi(ru, rl, col, acc[mi][0][r], acc[mi][1][r], 0.f, 0.f);
        if ((r8 & 3) == 3) __builtin_amdgcn_sched_barrier(0);
      }
    }
  }
}
template <class Epi>
DEV void gemm_tile(const bf16_t* A0, int lda0, const bf16_t* A1, int lda1, int ksplit,
                   const bf16_t* Bt, int ldb, int K, char* smem, Epi epi) {
  gemm_tile_x<false>(A0, lda0, A1, lda1, ksplit, Bt, ldb, K, smem, nullptr,
                     [&](int ru, int rl, int c, float v0, float v1, float, float) { epi(ru, rl, c, v0, v1); });
}

DEV void wconv(const float* src, int ld, int K, int N, int mode, int coloff, bf16_t* dst, char* smem) {
  float* tile = (float*)smem;
  const int tid = threadIdx.x;
  const int nkt = K >> 6, nnt = N >> 5, nn4 = (nnt + 3) >> 2;
  for (int tl = blockIdx.x; tl < nkt * nn4; tl += gridDim.x) {
    const int kt = tl % nkt, n4 = tl / nkt;
    __syncthreads();
    {
      const int n = tid & 31, kk = tid >> 5;
      float v[4][8];
#pragma unroll
      for (int u = 0; u < 4; ++u) {
        int nt = n4 * 4 + u;
        if (nt >= nnt) nt = nnt - 1;
        const int cb = mode ? ((nt & 1) * DFF + (nt >> 1) * 32) : (coloff + nt * 32);
#pragma unroll
        for (int i = 0; i < 8; ++i) v[u][i] = src[(size_t)(kt * 64 + kk + 8 * i) * ld + cb + n];
      }
#pragma unroll
      for (int u = 0; u < 4; ++u)
#pragma unroll
        for (int i = 0; i < 8; ++i) tile[u * (64 * 33) + (kk + 8 * i) * 33 + n] = v[u][i];
    }
    __syncthreads();
    {
      const int k2 = tid & 31, nn = tid >> 5;
#pragma unroll
      for (int u = 0; u < 4; ++u) {
        const int nt = n4 * 4 + u;
        if (nt < nnt) {
#pragma unroll
          for (int i = 0; i < 4; ++i) {
            const int n = nn + 8 * i;
            const unsigned w = pack2(tile[u * (64 * 33) + (2 * k2) * 33 + n], tile[u * (64 * 33) + (2 * k2 + 1) * 33 + n]);
            *(unsigned*)(dst + (size_t)(nt * 32 + n) * K + kt * 64 + 2 * k2) = w;
          }
        }
      }
    }
  }
  __syncthreads();
}

DEV void ln_load(const float* src, float4 (&v)[4], int lane) {
#pragma unroll
  for (int i = 0; i < 4; ++i) v[i] = *(const float4*)(src + (i * 64 + lane) * 4);
}
DEV void ln_finish(float4 (&v)[4], float* dstf, bf16_t* dstb, const float* g, const float* b, int lane) {
  float s = 0.f;
#pragma unroll
  for (int i = 0; i < 4; ++i) s += v[i].x + v[i].y + v[i].z + v[i].w;
  const float mu = wave_sum_dpp(s) * (1.f / 1024.f);
  float q = 0.f;
#pragma unroll
  for (int i = 0; i < 4; ++i) {
    v[i].x -= mu; v[i].y -= mu; v[i].z -= mu; v[i].w -= mu;
    q += v[i].x * v[i].x + v[i].y * v[i].y + v[i].z * v[i].z + v[i].w * v[i].w;
  }
  const float rs = rsqrtf(wave_sum_dpp(q) * (1.f / 1024.f) + 1e-5f);
#pragma unroll
  for (int i = 0; i < 4; ++i) {
    const int c = (i * 64 + lane) * 4;
    const float4 gg = *(const float4*)(g + c), bb = *(const float4*)(b + c);
    float4 o;
    o.x = v[i].x * rs * gg.x + bb.x; o.y = v[i].y * rs * gg.y + bb.y;
    o.z = v[i].z * rs * gg.z + bb.z; o.w = v[i].w * rs * gg.w + bb.w;
    if (dstf) *(float4*)(dstf + c) = o;
    if (dstb) { uint2 u; u.x = pack2(o.x, o.y); u.y = pack2(o.z, o.w); *(uint2*)(dstb + c) = u; }
  }
}

DEV void phase_ln(const Params& p, const float* g, const float* b, bool write_xb, bool do_mem) {
  const int lane = threadIdx.x & 63;
  const int gw = blockIdx.x * 4 + (threadIdx.x >> 6), nw = gridDim.x * 4;
  bf16_t* xb = (bf16_t*)(p.ws + O_XB);
  for (int r = gw; r < NTOK; r += 2 * nw) {
    const int r2 = r + nw;
    float4 v0[4], v1[4];
    float* row0 = p.out + (size_t)r * DM;
    float* row1 = p.out + (size_t)(r2 < NTOK ? r2 : r) * DM;
    ln_load(row0, v0, lane);
    ln_load(row1, v1, lane);
    ln_finish(v0, row0, write_xb ? xb + (size_t)r * DM : nullptr, g, b, lane);
    if (r2 < NTOK) ln_finish(v1, row1, write_xb ? xb + (size_t)r2 * DM : nullptr, g, b, lane);
  }
  if (do_mem) {
    for (int m = gw; m < 3072; m += nw) {
      const float* src = m < 2048 ? p.in[2] + (size_t)m * DM : p.in[3] + (size_t)(m - 2048) * DM;
      float4 v0[4];
      ln_load(src, v0, lane);
      ln_finish(v0, nullptr, (bf16_t*)(p.ws + O_MEMB) + (size_t)m * DM, p.in[31], p.in[32], lane);
    }
  }
}

DEV bool tile_map(int it, int nct, int& rt, int& ct) {
  const int bpx = gridDim.x >> 3, xcd = blockIdx.x & 7, j = blockIdx.x >> 3;
  const int q = j + it * bpx;
  if (q >= 24 * nct) return false;
  const int band = q / (8 * nct), qq = q - band * 8 * nct;
  rt = xcd * 24 + band * 8 + (qq & 7);
  ct = qq >> 3;
  return true;
}

DEV void phase_ffn_in(const Params& p, const bf16_t* wt, char* smem) {
  const bf16_t* xb = (const bf16_t*)(p.ws + O_XB);
  bf16_t* h = (bf16_t*)(p.ws + O_H);
  const int nct = 44;
  int rt, ct;
  for (int it = 0; tile_map(it, nct, rt, ct); ++it) {
    bf16_t* hb = h + (size_t)rt * TM * DFF + ct * 64;
    gemm_tile(xb + (size_t)rt * TM * DM, DM, nullptr, 0, DM, wt + (size_t)ct * 128 * DM, DM, DM, smem,
              [&](int ru, int rl, int c, float v0, float v1) {
                (hb + ru * DFF)[(unsigned)(rl * DFF + (c >> 6) * 32 + (c & 31))] = f2bf(silu(v0) * v1);
              });
  }
}
DEV void phase_gemm_res(const Params& p, const bf16_t* A0, int lda0, const bf16_t* A1, int lda1, int ksplit, int K,
                        const bf16_t* wt, float scale, bool res_is_input, char* smem) {
  const int nct = 8;
  int rt, ct;
  for (int it = 0; tile_map(it, nct, rt, ct); ++it) {
    const int r0 = rt * TM, c0 = ct * 128;
    const bf16_t* a1 = A1 ? A1 + (size_t)r0 * lda1 : nullptr;
    const float* resb = (res_is_input ? xin_row(p, r0) : p.out + (size_t)r0 * DM) + c0;
    float* outb = p.out + (size_t)r0 * DM + c0;
    gemm_tile_x<true>(A0 + (size_t)r0 * lda0, lda0, a1, lda1, ksplit, wt + (size_t)c0 * K, K, K, smem, resb,
              [&](int ru, int rl, int c, float v0, float v1, float x0, float x1) {
                float* op = outb + ru * DM;
                const unsigned off = (unsigned)(rl * DM + c);
                op[off] = ALPHA * x0 + scale * v0;
                op[off + 32] = ALPHA * x1 + scale * v1;
              });
  }
}
DEV void phase_gemm_bf16(const bf16_t* A, int lda, const bf16_t* wt, int K, int N, bf16_t* out, int ldo, char* smem) {
  const int nct = (N + 127) >> 7;
  int rt, ct;
  for (int it = 0; tile_map(it, nct, rt, ct); ++it) {
    const int r0 = rt * TM, c0 = ct * 128;
    gemm_tile(A + (size_t)r0 * lda, lda, nullptr, 0, K, wt + (size_t)c0 * K, K, K, smem,
              [&](int ru, int rl, int c, float v0, float v1) {
                bf16_t* o = out + (size_t)(r0 + ru) * ldo + c0;
                const unsigned off = (unsigned)(rl * ldo + c);
                const int cc = c0 + c;
                if (cc < N) o[off] = f2bf(v0);
                if (cc + 32 < N) o[off + 32] = f2bf(v1);
              });
  }
}

constexpr int GL = 72;
struct GlaSmemM {
  bf16_t VT[128 * GL];
  bf16_t R1[128 * GL];
  bf16_t QB[64 * GL];
  bf16_t P[64 * GL];
  float gd[64 * 32];
  float tot[256];
  float blast[64];
};
static_assert(sizeof(GlaSmemM) <= 65536, "GlaSmemM too big");
constexpr int OBS = 132;

DEV int mfma_row(int r, int lane) { return (r & 3) + 8 * (r >> 2) + 4 * (lane >> 5); }
DEV void mma_k64(f32x16& acc, const bf16_t* sA, const bf16_t* sB, int lane) {
  const int o = (lane & 31) * GL + (lane >> 5) * 8;
#pragma unroll
  for (int ks = 0; ks < 4; ++ks) {
    const bf16x8 a = *(const bf16x8*)(sA + o + ks * 16);
    const bf16x8 b = *(const bf16x8*)(sB + o + ks * 16);
    acc = __builtin_amdgcn_mfma_f32_32x32x16_bf16(a, b, acc, 0, 0, 0);
  }
}
DEV void gla_load_vtg(const bf16_t* proj, int t0, int h, GlaSmemM* s) {
  const int tid = threadIdx.x;
#pragma unroll
  for (int i = 0; i < 4; ++i) {
    const int id = tid + 256 * i, c = id & 63, ec = id >> 6;
    const uint4 u = *(const uint4*)(proj + (size_t)(t0 + c) * GLA_LD + 512 + h * 128 + ec * 8);
    const unsigned w[4] = {u.x, u.y, u.z, u.w};
#pragma unroll
    for (int j = 0; j < 4; ++j) {
      s->VT[(ec * 8 + 2 * j) * GL + c] = (bf16_t)(w[j] & 0xffffu);
      s->VT[(ec * 8 + 2 * j + 1) * GL + c] = (bf16_t)(w[j] >> 16);
    }
  }
  {
    const int c = tid >> 2, part = tid & 3;
    const uint4 u = *(const uint4*)(proj + (size_t)(t0 + c) * GLA_LD + 1536 + part * 8);
    float v[8];
    unpack8(u, v);
#pragma unroll
    for (int j = 0; j < 8; ++j) s->gd[c * 32 + part * 8 + j] = v[j];
  }
}
DEV void gla_gates(const Params& p, int h, int dir, const float* gd, float* tot, float (&b)[16], float& bl) {
  const int tid = threadIdx.x, d = tid & 63, cq = tid >> 6;
  const float* up = dir ? p.in[11] : p.in[9];
  const float* gb = dir ? p.in[12] : p.in[10];
  float u[16];
#pragma unroll
  for (int m = 0; m < 16; ++m) u[m] = up[m * 256 + h * 64 + d];
  const float bias = gb[h * 64 + d];
#pragma unroll
  for (int i = 0; i < 16; ++i) {
    const int c = cq * 16 + i;
    float z = bias;
#pragma unroll
    for (int m4 = 0; m4 < 4; ++m4) {
      const float4 g4 = *(const float4*)(gd + c * 32 + dir * 16 + m4 * 4);
      z += g4.x * u[m4 * 4] + g4.y * u[m4 * 4 + 1] + g4.z * u[m4 * 4 + 2] + g4.w * u[m4 * 4 + 3];
    }
    b[i] = logsig(z) * (1.f / 16.f);
  }
  float run = 0.f;
  if (dir == 0) {
#pragma unroll
    for (int i = 0; i < 16; ++i) { run += b[i]; b[i] = run; }
  } else {
#pragma unroll
    for (int i = 15; i >= 0; --i) { run += b[i]; b[i] = run; }
  }
  tot[cq * 64 + d] = run;
  __syncthreads();
  const float t0 = tot[d], t1 = tot[64 + d], t2 = tot[128 + d], t3 = tot[192 + d];
  float off;
  if (dir == 0) off = (cq > 0 ? t0 : 0.f) + (cq > 1 ? t1 : 0.f) + (cq > 2 ? t2 : 0.f);
  else off = (cq < 3 ? t3 : 0.f) + (cq < 2 ? t2 : 0.f) + (cq < 1 ? t1 : 0.f);
#pragma unroll
  for (int i = 0; i < 16; ++i) b[i] += off;
  bl = (t0 + t1) + (t2 + t3);
}

DEV void phase_gla_a(const Params& p, char* smem) {
  GlaSmemM* s = (GlaSmemM*)smem;
  const bf16_t* proj = (const bf16_t*)(p.ws + O_H);
  float* kv = (float*)(p.ws + O_KV);
  float* dec = (float*)(p.ws + O_DEC);
  const int tid = threadIdx.x, lane = tid & 63, wv = tid >> 6;
  for (int item = blockIdx.x; item < 768 * 4; item += gridDim.x) {
    const int gch = item >> 2, h = item & 3, t0 = gch * 64;
    __syncthreads();
    gla_load_vtg(proj, t0, h, s);
    float kf[16];
    {
      const int d = tid & 63, cq = tid >> 6;
#pragma unroll
      for (int i = 0; i < 16; ++i) kf[i] = bf2f(proj[(size_t)(t0 + cq * 16 + i) * GLA_LD + 256 + h * 64 + d]);
    }
    __syncthreads();
    for (int dir = 0; dir < 2; ++dir) {
      float bb[16], bl;
      gla_gates(p, h, dir, s->gd, s->tot, bb, bl);
      {
        const int d = tid & 63, cq = tid >> 6;
        unsigned w[8];
#pragma unroll
        for (int i = 0; i < 8; ++i)
          w[i] = pack2(kf[2 * i] * __expf(bl - bb[2 * i]), kf[2 * i + 1] * __expf(bl - bb[2 * i + 1]));
        bf16_t* dst = s->R1 + d * GL + cq * 16;
        *(u32x4*)(dst) = (u32x4){w[0], w[1], w[2], w[3]};
        *(u32x4*)(dst + 8) = (u32x4){w[4], w[5], w[6], w[7]};
        if (cq == 0) s->blast[d] = bl;
      }
      __syncthreads();
      f32x16 acc[2];
#pragma unroll
      for (int j = 0; j < 2; ++j)
#pragma unroll
        for (int r = 0; r < 16; ++r) acc[j][r] = 0.f;
#pragma unroll
      for (int db = 0; db < 2; ++db) mma_k64(acc[db], s->VT + wv * 32 * GL, s->R1 + db * 32 * GL, lane);
      const size_t kvi = (size_t)item * 2 + dir;
      float* ob = kv + kvi * 8192;
#pragma unroll
      for (int db = 0; db < 2; ++db)
#pragma unroll
        for (int r = 0; r < 16; ++r) {
          const int e = wv * 32 + mfma_row(r, lane), d = db * 32 + (lane & 31);
          ob[e * 64 + d] = acc[db][r];
        }
      if (tid < 64) dec[kvi * 64 + tid] = __expf(s->blast[tid]);
      __syncthreads();
    }
  }
}

DEV void phase_gla_b(const Params& p) {
  float* kv = (float*)(p.ws + O_KV);
  const float* dec = (const float*)(p.ws + O_DEC);
  const int tid = threadIdx.x;
  for (int unit = blockIdx.x; unit < 96 * 32; unit += gridDim.x) {
    const int sid = unit >> 5, part = unit & 31;
    const int sq = sid >> 3, h = (sid >> 1) & 3, dir = sid & 1;
    int c0, nch;
    if (sq < 4) { c0 = 256 + sq * 128; nch = 128; }
    else { c0 = (sq - 4) * 32; nch = 32; }
    const int e = part * 256 + tid;
    float S = 0.f;
    for (int n0 = 0; n0 < nch; n0 += 8) {
      float tmp[8], dc[8];
#pragma unroll
      for (int u = 0; u < 8; ++u) {
        const int n = n0 + u;
        const int ci = dir ? (c0 + nch - 1 - n) : (c0 + n);
        const size_t idx = ((size_t)ci * 4 + h) * 2 + dir;
        tmp[u] = kv[idx * 8192 + e];
        dc[u] = dec[idx * 64 + (e & 63)];
      }
#pragma unroll
      for (int u = 0; u < 8; ++u) {
        const int n = n0 + u;
        const int ci = dir ? (c0 + nch - 1 - n) : (c0 + n);
        const size_t idx = ((size_t)ci * 4 + h) * 2 + dir;
        kv[idx * 8192 + e] = S;
        S = dc[u] * S + tmp[u];
      }
    }
  }
}

DEV void phase_gla_c(const Params& p, char* smem) {
  GlaSmemM* s = (GlaSmemM*)smem;
  const bf16_t* proj = (const bf16_t*)(p.ws + O_H);
  const float* kv = (const float*)(p.ws + O_KV);
  bf16_t* mixed = (bf16_t*)(p.ws + O_MIXG);
  const int tid = threadIdx.x, lane = tid & 63, wv = tid >> 6;
  const int cg_ = tid >> 4, eg = tid & 15;
  float* Ob = (float*)s->R1;
  static_assert(64 * OBS * 4 <= (128 + 64 + 64) * GL * 2, "output staging does not fit");
  for (int item = blockIdx.x; item < 768 * 4; item += gridDim.x) {
    const int gch = item >> 2, h = item & 3, t0 = gch * 64;
    __syncthreads();
    gla_load_vtg(proj, t0, h, s);
    float qf[16], kf[16];
    {
      const int d = tid & 63, cq = tid >> 6;
#pragma unroll
      for (int i = 0; i < 16; ++i) {
        const bf16_t* row = proj + (size_t)(t0 + cq * 16 + i) * GLA_LD + h * 64 + d;
        qf[i] = bf2f(row[0]) * 0.125f;
        kf[i] = bf2f(row[256]);
      }
    }
    __syncthreads();
    const int cb = wv & 1, eb0 = (wv >> 1) * 2;
    f32x16 acc[2];
#pragma unroll
    for (int j = 0; j < 2; ++j)
#pragma unroll
      for (int r = 0; r < 16; ++r) acc[j][r] = 0.f;
    for (int dir = 0; dir < 2; ++dir) {
      {
        float bb[16], bl;
        gla_gates(p, h, dir, s->gd, s->tot, bb, bl);
        const int d = tid & 63, cq = tid >> 6;
        const float bref = 0.5f * bl;
#pragma unroll
        for (int i = 0; i < 16; ++i) {
          const int c = cq * 16 + i;
          const float b = bb[i];
          const float q = qf[i];
          const float k = kf[i];
          s->R1[c * GL + d] = f2bf(q * __expf(b - bref));
          s->R1[(64 + c) * GL + d] = f2bf(k * __expf(bref - b));
          s->QB[c * GL + d] = f2bf(q * __expf(b));
        }
      }
      __syncthreads();
      {
        const int sb = wv >> 1, cbs = wv & 1;
        f32x16 sc;
#pragma unroll
        for (int r = 0; r < 16; ++r) sc[r] = 0.f;
        mma_k64(sc, s->R1 + (64 + sb * 32) * GL, s->R1 + cbs * 32 * GL, lane);
        const int c = cbs * 32 + (lane & 31);
#pragma unroll
        for (int g = 0; g < 4; ++g) {
          float v[4];
#pragma unroll
          for (int i = 0; i < 4; ++i) {
            const int sr = sb * 32 + 8 * g + 4 * (lane >> 5) + i;
            const bool keep = dir ? (sr >= c) : (sr <= c);
            v[i] = keep ? sc[4 * g + i] : 0.f;
          }
          uint2 w;
          w.x = pack2(v[0], v[1]);
          w.y = pack2(v[2], v[3]);
          *(uint2*)(s->P + c * GL + sb * 32 + 8 * g + 4 * (lane >> 5)) = w;
        }
      }
      const float* Sp = kv + ((size_t)item * 2 + dir) * 8192 + tid * 4;
      f32x4v sv[8];
#pragma unroll
      for (int i = 0; i < 8; ++i) sv[i] = *(const f32x4v*)(Sp + i * 1024);
      __syncthreads();
#pragma unroll
      for (int i = 0; i < 8; ++i) {
        const int el = (tid + 256 * i) * 4, e = el >> 6, d = el & 63;
        uint2 w;
        w.x = pack2(sv[i].x, sv[i].y);
        w.y = pack2(sv[i].z, sv[i].w);
        *(uint2*)(s->R1 + e * GL + d) = w;
      }
#pragma unroll
      for (int j = 0; j < 2; ++j) mma_k64(acc[j], s->P + cb * 32 * GL, s->VT + (eb0 + j) * 32 * GL, lane);
      __syncthreads();
#pragma unroll
      for (int j = 0; j < 2; ++j) mma_k64(acc[j], s->QB + cb * 32 * GL, s->R1 + (eb0 + j) * 32 * GL, lane);
      __syncthreads();
    }
#pragma unroll
    for (int j = 0; j < 2; ++j)
#pragma unroll
      for (int r = 0; r < 16; ++r) {
        const int c = cb * 32 + mfma_row(r, lane), e = (eb0 + j) * 32 + (lane & 31);
        Ob[c * OBS + e] = acc[j][r];
      }
    __syncthreads();
    float ng[8];
#pragma unroll
    for (int j = 0; j < 8; ++j) ng[j] = p.in[13][h * 128 + eg * 8 + j];
#pragma unroll
    for (int i = 0; i < 4; ++i) {
      const int cr = cg_ * 4 + i;
      const float4 o0 = *(const float4*)(Ob + cr * OBS + eg * 8), o1 = *(const float4*)(Ob + cr * OBS + eg * 8 + 4);
      const float o[8] = {o0.x, o0.y, o0.z, o0.w, o1.x, o1.y, o1.z, o1.w};
      float ss = 0.f;
#pragma unroll
      for (int j = 0; j < 8; ++j) ss += o[j] * o[j];
      ss = row16_sum(ss);
      const float rs = rsqrtf(ss * (1.f / 128.f) + 1e-5f);
      const int t = t0 + cr;
      float g[8];
      unpack8(*(const uint4*)(proj + (size_t)t * GLA_LD + 1024 + h * 128 + eg * 8), g);
      uint4 u;
      u.x = pack2(o[0] * rs * ng[0] * silu(g[0]), o[1] * rs * ng[1] * silu(g[1]));
      u.y = pack2(o[2] * rs * ng[2] * silu(g[2]), o[3] * rs * ng[3] * silu(g[3]));
      u.z = pack2(o[4] * rs * ng[4] * silu(g[4]), o[5] * rs * ng[5] * silu(g[5]));
      u.w = pack2(o[6] * rs * ng[6] * silu(g[6]), o[7] * rs * ng[7] * silu(g[7]));
      *(uint4*)(mixed + (size_t)t * 512 + h * 128 + eg * 8) = u;
    }
  }
}

DEV void phase_rw_act(const Params& p) {
  const bf16_t* proj = (const bf16_t*)(p.ws + O_H);
  bf16_t* awda = (bf16_t*)(p.ws + O_XB);
  bf16_t* ag = (bf16_t*)(p.ws + O_ACTG);
  const int total = NTOK * 160;
  const int stride = gridDim.x * 256;
  for (int base = blockIdx.x * 256 + threadIdx.x; base < total; base += 8 * stride) {
    unsigned x[8], pv[8], nx[8];
#pragma unroll
    for (int u = 0; u < 8; ++u) {
      int idx = base + u * stride;
      if (idx >= total) idx = base;
      const int t = idx / 160, cp = idx - t * 160;
      int tb, T;
      seq_of_token(t, tb, T);
      const bf16_t* ptr = proj + (size_t)t * RW_LD + 1536 + cp * 2;
      x[u] = *(const unsigned*)ptr;
      pv[u] = *(const unsigned*)(ptr + (t > tb ? -RW_LD : 0));
      nx[u] = *(const unsigned*)(ptr + (t < tb + T - 1 ? RW_LD : 0));
    }
#pragma unroll
    for (int u = 0; u < 8; ++u) {
      const int idx = base + u * stride;
      if (idx < total) {
        const int t = idx / 160, cp = idx - t * 160;
        int tb, T;
        seq_of_token(t, tb, T);
        const bool hp = t > tb, hn = t < tb + T - 1;
        const int rc = 1536 + cp * 2;
        float v[2];
#pragma unroll
        for (int e = 0; e < 2; ++e) {
          const float xx = e ? __uint_as_float(x[u] & 0xffff0000u) : __uint_as_float(x[u] << 16);
          const float pp = hp ? (e ? __uint_as_float(pv[u] & 0xffff0000u) : __uint_as_float(pv[u] << 16)) : 0.f;
          const float nn = hn ? (e ? __uint_as_float(nx[u] & 0xffff0000u) : __uint_as_float(nx[u] << 16)) : 0.f;
          v[e] = xx + p.in[14][rc + e] * (pp - xx) + p.in[15][rc + e] * (nn - xx);
        }
        const int col = cp * 2;
        if (col < 128) *(unsigned*)(awda + (size_t)t * 192 + col) = pack2(tanh_fast(v[0]), tanh_fast(v[1]));
        else if (col < 192) *(unsigned*)(awda + (size_t)t * 192 + col) = pack2(v[0], v[1]);
        else *(unsigned*)(ag + (size_t)t * 128 + (col - 192)) = pack2(sigm(v[0]), sigm(v[1]));
      }
    }
  }
}

DEV void phase_rw_lowrank(const Params& p, char* smem) {
  const bf16_t* awda = (const bf16_t*)(p.ws + O_XB);
  bf16_t* der = (bf16_t*)(p.ws + O_DER);
  int rt, ct12;
  for (int it = 0; tile_map(it, 12, rt, ct12); ++it) {
    const int which = ct12 >> 2, ct = ct12 & 3;
    const int r0 = rt * TM, c0 = ct * 128;
    const bf16_t* wt = (const bf16_t*)(p.ws + (which == 0 ? W_A_UPF : which == 1 ? W_A_UPB : W_A_AUP));
    const float* bias = which == 0 ? p.in[16] : which == 1 ? p.in[18] : p.in[20];
    bf16_t* out = der + (size_t)which * SLAB;
    gemm_tile(awda + (size_t)r0 * 192 + which * 64, 192, nullptr, 0, 64, wt + (size_t)c0 * 64, 64, 64, smem,
              [&](int ru, int rl, int c, float v0, float v1) {
                bf16_t* o = out + (size_t)(r0 + ru) * 512 + c0;
                const unsigned off = (unsigned)(rl * 512 + c);
                const float z0 = bias[c0 + c] + v0, z1 = bias[c0 + c + 32] + v1;
                if (which < 2) { o[off] = f2bf(-0.6065306597f * sigm(z0)); o[off + 32] = f2bf(-0.6065306597f * sigm(z1)); }
                else { o[off] = f2bf(sigm(z0)); o[off + 32] = f2bf(sigm(z1)); }
              });
  }
}

constexpr int SST = 388;
template <int RPL>
struct StepV { f32x4v w, nk, ka, k, r; float v[RPL]; float kar; };
template <int RPL>
DEV void step_load(StepV<RPL>& x, const float* sb, int jl, int rowbase) {
  x.w = *(const f32x4v*)(sb + jl * 4);
  x.nk = *(const f32x4v*)(sb + 64 + jl * 4);
  x.ka = *(const f32x4v*)(sb + 128 + jl * 4);
  x.k = *(const f32x4v*)(sb + 192 + jl * 4);
  x.r = *(const f32x4v*)(sb + 256 + jl * 4);
#pragma unroll
  for (int r = 0; r < RPL; ++r) x.v[r] = sb[320 + rowbase + r];
  x.kar = sb[384];
}

template <int RPL>
DEV void rwkv_scan(const Params& p, int tb, int T, int head, int dir, int split, float* st) {
  const int tid = threadIdx.x, lane = tid & 63, wv = tid >> 6;
  const int jl = lane & 15, ig = lane >> 4;
  const int hc = head * 64 + lane;
  float* ybuf = st + 2 * 16 * SST;
  const bf16_t* proj = (const bf16_t*)(p.ws + O_H);
  const bf16_t* ldp = (const bf16_t*)(p.ws + O_DER) + (size_t)dir * SLAB;
  const bf16_t* ap = (const bf16_t*)(p.ws + O_DER) + 2 * SLAB;
  bf16_t* yout = (bf16_t*)(p.ws + O_XB) + (size_t)dir * SLAB;
  const float* scal = (const float*)(p.ws + O_BONUS);
  const float mpr = p.in[14][hc], mnr = p.in[15][hc];
  const float mpk = p.in[14][512 + hc], mnk = p.in[15][512 + hc];
  const float mpv = p.in[14][1024 + hc], mnv = p.in[15][1024 + hc];
  const float kkw = p.in[23][hc], kaw = p.in[24][hc];
  const int rowl = wv * 4 * RPL + ig * RPL;
  const int rowbase = split * 16 * RPL + rowl;
  const int nch = T >> 4;
  const int ywoff = (jl == 0) ? rowl : (2 * 16 * 16 * RPL + rowl);
  f32x2 S01[RPL], S23[RPL];
#pragma unroll
  for (int r = 0; r < RPL; ++r) { S01[r] = (f32x2){0.f, 0.f}; S23[r] = (f32x2){0.f, 0.f}; }
  bf16_t rawA[4][11];
  float2 scA[4];

#define RW_LOAD(RAW, SC, CH)                                                            \
  _Pragma("unroll") for (int q = 0; q < 4; ++q) {                                       \
    const int tt_ = (CH) * 16 + wv * 4 + q;                                             \
    const int t_ = dir ? (T - 1 - tt_) : tt_;                                           \
    const bf16_t* row_ = proj + (size_t)(tb + t_) * RW_LD + hc;                         \
    const int op_ = t_ > 0 ? -RW_LD : 0, on_ = t_ < T - 1 ? RW_LD : 0;                  \
    _Pragma("unroll") for (int w = 0; w < 3; ++w) {                                     \
      RAW[q][w * 3 + 0] = row_[w * 512];                                                \
      RAW[q][w * 3 + 1] = row_[w * 512 + op_];                                          \
      RAW[q][w * 3 + 2] = row_[w * 512 + on_];                                          \
    }                                                                                   \
    RAW[q][9] = ldp[(size_t)(tb + t_) * 512 + hc];                                      \
    RAW[q][10] = ap[(size_t)(tb + t_) * 512 + hc];                                      \
    SC[q] = *(const float2*)(scal + ((size_t)(tb + t_) * 8 + head) * 4);                \
  }
#define RW_STAGE(RAW, SC, CH, BUF)                                                      \
  _Pragma("unroll") for (int q = 0; q < 4; ++q) {                                       \
    const int s_ = wv * 4 + q;                                                          \
    const int tt_ = (CH) * 16 + s_;                                                     \
    const int t_ = dir ? (T - 1 - tt_) : tt_;                                           \
    const bool hp_ = t_ > 0, hn_ = t_ < T - 1;                                          \
    float x_ = bf2f(RAW[q][0]);                                                         \
    const float r_ = x_ + mpr * ((hp_ ? bf2f(RAW[q][1]) : 0.f) - x_) + mnr * ((hn_ ? bf2f(RAW[q][2]) : 0.f) - x_);  \
    x_ = bf2f(RAW[q][3]);                                                               \
    const float kr_ = x_ + mpk * ((hp_ ? bf2f(RAW[q][4]) : 0.f) - x_) + mnk * ((hn_ ? bf2f(RAW[q][5]) : 0.f) - x_); \
    x_ = bf2f(RAW[q][6]);                                                               \
    const float v_ = x_ + mpv * ((hp_ ? bf2f(RAW[q][7]) : 0.f) - x_) + mnv * ((hn_ ? bf2f(RAW[q][8]) : 0.f) - x_);  \
    const float a_ = bf2f(RAW[q][10]);                                                  \
    const float kk_ = kr_ * kkw * SC[q].x;                                              \
    const float k2_ = kr_ * (1.f + (a_ - 1.f) * kaw);                                   \
    float* sb_ = st + (BUF) * (16 * SST) + s_ * SST;                                    \
    sb_[lane] = __expf(bf2f(RAW[q][9]));                                                \
    sb_[64 + lane] = -kk_;                                                              \
    sb_[128 + lane] = kk_ * a_;                                                         \
    sb_[192 + lane] = k2_;                                                              \
    sb_[256 + lane] = r_;                                                               \
    sb_[320 + lane] = v_;                                                               \
    if (lane == 0) sb_[384] = SC[q].y;                                                  \
  }
#define RW_MAIN(CH)                                                                     \
  {                                                                                     \
    const int buf = (CH) & 1;                                                           \
    const float* sbase = st + buf * (16 * SST);                                         \
    float* yb = ybuf + buf * (16 * 16 * RPL);                                           \
    StepV<RPL> cur, nxt;                                                                \
    step_load<RPL>(cur, sbase, jl, rowbase);                                            \
    _Pragma("unroll 16") for (int s = 0; s < 16; ++s) {                                  \
      step_load<RPL>(nxt, sbase + ((s + 1) & 15) * SST, jl, rowbase);                   \
      const f32x2 w01 = {cur.w.x, cur.w.y}, w23 = {cur.w.z, cur.w.w};                   \
      const f32x2 n01 = {cur.nk.x, cur.nk.y}, n23 = {cur.nk.z, cur.nk.w};               \
      const f32x2 a01 = {cur.ka.x, cur.ka.y}, a23 = {cur.ka.z, cur.ka.w};               \
      const f32x2 k01 = {cur.k.x, cur.k.y}, k23 = {cur.k.z, cur.k.w};                   \
      const f32x2 r01 = {cur.r.x, cur.r.y}, r23 = {cur.r.z, cur.r.w};                   \
      _Pragma("unroll") for (int r = 0; r < RPL; ++r) {                                 \
        f32x2 pz2 = S01[r] * n01;                                                       \
        pz2 = S23[r] * n23 + pz2;                                                       \
        float sa = pz2.x + pz2.y;                                                       \
        const f32x2 vv = {cur.v[r], cur.v[r]};                                          \
        f32x2 b01 = S01[r] * w01;                                                       \
        f32x2 b23 = S23[r] * w23;                                                       \
        b01 = vv * k01 + b01;                                                           \
        b23 = vv * k23 + b23;                                                           \
        f32x2 y2 = b01 * r01;                                                           \
        y2 = b23 * r23 + y2;                                                            \
        float yb_ = y2.x + y2.y;                                                        \
        row16_sum2(sa, yb_);                                                            \
        const f32x2 sa2 = {sa, sa};                                                     \
        S01[r] = sa2 * a01 + b01;                                                       \
        S23[r] = sa2 * a23 + b23;                                                       \
        const float y = yb_ + sa * cur.kar;                                             \
        yb[s * (16 * RPL) + ywoff + r] = y;                                             \
      }                                                                                 \
      cur = nxt;                                                                        \
    }                                                                                   \
  }
#define RW_FLUSH(CH)                                                                    \
  {                                                                                     \
    const float* yb = ybuf + ((CH) & 1) * (16 * 16 * RPL);                              \
    const int s = tid >> 4, rl = (tid & 15) * RPL;                                      \
    const int tt = (CH) * 16 + s;                                                       \
    const int t = dir ? (T - 1 - tt) : tt;                                              \
    bf16_t* yo = yout + (size_t)(tb + t) * 512 + head * 64 + split * 16 * RPL + rl;     \
    if (RPL == 1) yo[0] = f2bf(yb[s * 16 + rl]);                                        \
    else if (RPL == 2) *(unsigned*)yo = pack2(yb[s * 32 + rl], yb[s * 32 + rl + 1]);    \
    else { uint2 u; u.x = pack2(yb[s * 64 + rl], yb[s * 64 + rl + 1]); u.y = pack2(yb[s * 64 + rl + 2], yb[s * 64 + rl + 3]); *(uint2*)yo = u; } \
  }

  RW_LOAD(rawA, scA, 0);
  RW_STAGE(rawA, scA, 0, 0);
  __syncthreads();
  for (int ch = 0; ch < nch; ++ch) {
    if (ch + 1 < nch) { RW_LOAD(rawA, scA, ch + 1); }
    RW_MAIN(ch);
    if (ch + 1 < nch) { RW_STAGE(rawA, scA, ch + 1, (ch + 1) & 1); }
    __syncthreads();
    RW_FLUSH(ch);
  }
#undef RW_MAIN
#undef RW_FLUSH
#undef RW_LOAD
#undef RW_STAGE
}

DEV void phase_rw_pre(const Params& p) {
  const bf16_t* proj = (const bf16_t*)(p.ws + O_H);
  const bf16_t* ap = (const bf16_t*)(p.ws + O_DER) + 2 * SLAB;
  float* scal = (float*)(p.ws + O_BONUS);
  const int lane = threadIdx.x & 63;
  const int gw = blockIdx.x * 4 + (threadIdx.x >> 6), nw = gridDim.x * 4;
  for (int t = gw; t < NTOK; t += nw) {
    int tb, T;
    seq_of_token(t, tb, T);
    const bool hp = t > tb, hn = t < tb + T - 1;
    const int op = hp ? -RW_LD : 0, on = hn ? RW_LD : 0;
    const bf16_t* row = proj + (size_t)t * RW_LD + lane;
    bf16_t raw[8][7];
#pragma unroll
    for (int h = 0; h < 8; ++h) {
      raw[h][0] = row[h * 64];
      raw[h][1] = row[h * 64 + op];
      raw[h][2] = row[h * 64 + on];
      raw[h][3] = row[512 + h * 64];
      raw[h][4] = row[512 + h * 64 + op];
      raw[h][5] = row[512 + h * 64 + on];
      raw[h][6] = ap[(size_t)t * 512 + h * 64 + lane];
    }
#pragma unroll
    for (int h = 0; h < 8; ++h) {
      const int hc = h * 64 + lane;
      float x = bf2f(raw[h][0]);
      const float r = x + p.in[14][hc] * ((hp ? bf2f(raw[h][1]) : 0.f) - x) + p.in[15][hc] * ((hn ? bf2f(raw[h][2]) : 0.f) - x);
      x = bf2f(raw[h][3]);
      const float kr = x + p.in[14][512 + hc] * ((hp ? bf2f(raw[h][4]) : 0.f) - x) + p.in[15][512 + hc] * ((hn ? bf2f(raw[h][5]) : 0.f) - x);
      const float a = bf2f(raw[h][6]);
      const float kkr = kr * p.in[23][hc];
      const float inv = rsqrtf(fmaxf(wave_sum_dpp(kkr * kkr), 1e-24f));
      const float kk = kkr * inv;
      const float k2 = kr * (1.f + (a - 1.f) * p.in[24][hc]);
      const float kar = wave_sum_dpp(kk * a * r);
      const float bo = wave_sum_dpp(r * k2 * p.in[25][hc]);
      if (lane == 0) *(float4*)(scal + ((size_t)t * 8 + h) * 4) = make_float4(inv, kar, bo, 0.f);
    }
  }
}

DEV void phase_rw_scan(const Params& p, char* smem) {
  float* st = (float*)smem;
  for (int item = blockIdx.x; item < 512; item += gridDim.x) {
    __syncthreads();
    if (item < 256) {
      const int scan = item >> 2, split = item & 3;
      const int sq = scan >> 4, head = (scan >> 1) & 7, dir = scan & 1;
      __builtin_amdgcn_s_setprio(3);
      rwkv_scan<1>(p, NPROMPT + sq * 8192, 8192, head, dir, split, st);
      __builtin_amdgcn_s_setprio(0);
    } else {
      const int it = item - 256;
      const int scan = it >> 1, split = it & 1;
      const int sq = scan >> 4, head = (scan >> 1) & 7, dir = scan & 1;
      rwkv_scan<2>(p, sq * 2048, 2048, head, dir, split, st);
    }
  }
}

DEV void phase_rw_post(const Params& p) {
  const bf16_t* proj = (const bf16_t*)(p.ws + O_H);
  bf16_t* yf = (bf16_t*)(p.ws + O_XB);
  const bf16_t* yb = yf + SLAB;
  const bf16_t* gate = (const bf16_t*)(p.ws + O_DER) + 2 * SLAB;
  const float* scal = (const float*)(p.ws + O_BONUS);
  const int lane = threadIdx.x & 63;
  const int gw = blockIdx.x * 4 + (threadIdx.x >> 6), nw = gridDim.x * 4;
  for (int t = gw; t < NTOK; t += nw) {
    int tb, T;
    seq_of_token(t, tb, T);
    const bool hp = t > tb, hn = t < tb + T - 1;
    const int op = hp ? -RW_LD : 0, on = hn ? RW_LD : 0;
    const bf16_t* vrow = proj + (size_t)t * RW_LD + 1024 + lane;
    bf16_t raw[8][6];
    float bo[8];
#pragma unroll
    for (int h = 0; h < 8; ++h) {
      const size_t o = (size_t)t * 512 + h * 64 + lane;
      raw[h][0] = yf[o];
      raw[h][1] = yb[o];
      raw[h][2] = vrow[h * 64];
      raw[h][3] = vrow[h * 64 + op];
      raw[h][4] = vrow[h * 64 + on];
      raw[h][5] = gate[o];
      bo[h] = scal[((size_t)t * 8 + h) * 4 + 2];
    }
    bf16_t res[8];
#pragma unroll
    for (int h = 0; h < 8; ++h) {
      const int hc = h * 64 + lane;
      const float y = bf2f(raw[h][0]) + bf2f(raw[h][1]);
      const float mu = wave_sum_dpp(y) * (1.f / 64.f);
      const float dy = y - mu;
      const float var = wave_sum_dpp(dy * dy) * (1.f / 64.f);
      const float yn = dy * rsqrtf(var + 64e-5f) * p.in[26][hc] + p.in[27][hc];
      const float x = bf2f(raw[h][2]);
      const float v = x + p.in[14][1024 + hc] * ((hp ? bf2f(raw[h][3]) : 0.f) - x) + p.in[15][1024 + hc] * ((hn ? bf2f(raw[h][4]) : 0.f) - x);
      res[h] = f2bf((yn + bo[h] * v) * bf2f(raw[h][5]));
    }
#pragma unroll
    for (int h = 0; h < 8; ++h) yf[(size_t)t * 512 + h * 64 + lane] = res[h];
  }
}

DEV int seq_of_rowtile(int rt) { return rt < 64 ? (rt >> 3) : 8 + ((rt - 64) >> 5); }

DEV void phase_ca_qkv(const Params& p, char* smem) {
  const bf16_t* xb = (const bf16_t*)(p.ws + O_XB);
  bf16_t* qb = (bf16_t*)(p.ws + O_H);
  const bf16_t* memb = (const bf16_t*)(p.ws + O_MEMB);
  bf16_t* kb = (bf16_t*)(p.ws + O_KB);
  bf16_t* vt = (bf16_t*)(p.ws + O_VT);
  const bf16_t* wq = (const bf16_t*)(p.ws + W_B_Q);
  const bf16_t* wkv = (const bf16_t*)(p.ws + W_B_KV);
  {
    int rt, ct;
    for (int it = 0; tile_map(it, 8, rt, ct); ++it) {
      const int r0 = rt * TM, c0 = ct * 128;
      gemm_tile(xb + (size_t)r0 * DM, DM, nullptr, 0, DM, wq + (size_t)c0 * DM, DM, DM, smem,
                [&](int ru, int rl, int c, float v0, float v1) {
                  bf16_t* o = qb + (size_t)(r0 + ru) * DM + c0;
                  const unsigned off = (unsigned)(rl * DM + c);
                  o[off] = f2bf(v0); o[off + 32] = f2bf(v1);
                });
    }
  }
  {
    for (int t2 = blockIdx.x; t2 < 12 * 16; t2 += gridDim.x) {
      const int rt = t2 >> 4, ct = t2 & 15;
      const int r0 = rt * TM, c0 = ct * 128;
      if (ct < 8) {
        bf16_t* o = kb + (size_t)r0 * DM + c0;
        gemm_tile(memb + (size_t)r0 * DM, DM, nullptr, 0, DM, wkv + (size_t)c0 * DM, DM, DM, smem,
                  [&](int ru, int rl, int c, float v0, float v1) {
                    const unsigned off = (unsigned)(rl * DM + c);
                    (o + ru * DM)[off] = f2bf(v0);
                    (o + ru * DM)[off + 32] = f2bf(v1);
                  });
      } else {
        bf16_t* o = vt + ((size_t)rt * 1024 + (c0 - 1024)) * 256;
        gemm_tile(memb + (size_t)r0 * DM, DM, nullptr, 0, DM, wkv + (size_t)c0 * DM, DM, DM, smem,
                  [&](int ru, int rl, int c, float v0, float v1) {
                    const unsigned off = (unsigned)(c * 256 + rl);
                    (o + ru)[off] = f2bf(v0);
                    (o + ru)[off + 32 * 256] = f2bf(v1);
                  });
      }
    }
  }
}
DEV void phase_ca_scores(const Params& p, char* smem) {
  const bf16_t* qb = (const bf16_t*)(p.ws + O_H);
  const bf16_t* kb = (const bf16_t*)(p.ws + O_KB);
  float* sc = (float*)(p.ws + O_SCORES);
  int rt, ct8;
  for (int it = 0; tile_map(it, 8, rt, ct8); ++it) {
    const int h = ct8 >> 1, nt = ct8 & 1;
    const int b = seq_of_rowtile(rt), r0 = rt * TM;
    gemm_tile(qb + (size_t)r0 * DM + h * 256, DM, nullptr, 0, 256,
              kb + (size_t)(b * 256 + nt * 128) * DM + h * 256, DM, 256, smem,
              [&](int ru, int rl, int c, float v0, float v1) {
                float* o = sc + (size_t)(r0 + ru) * DM + h * 256 + nt * 128;
                const unsigned off = (unsigned)(rl * DM + c);
                o[off] = v0 * 0.0625f; o[off + 32] = v1 * 0.0625f;
              });
  }
}
DEV void phase_ca_softmax(const Params& p) {
  const float* sc = (const float*)(p.ws + O_SCORES);
  bf16_t* pb = (bf16_t*)(p.ws + O_H);
  const int lane = threadIdx.x & 63;
  const int gw = blockIdx.x * 4 + (threadIdx.x >> 6), nw = gridDim.x * 4;
  const int total = NTOK * 4;
  for (int it = gw; it < total; it += 4 * nw) {
    float4 v[4];
#pragma unroll
    for (int u = 0; u < 4; ++u) {
      const int i2 = it + u * nw;
      v[u] = *(const float4*)(sc + (size_t)(i2 < total ? i2 : it) * 256 + lane * 4);
    }
#pragma unroll
    for (int u = 0; u < 4; ++u) {
      const int i2 = it + u * nw;
      float mx = fmaxf(fmaxf(v[u].x, v[u].y), fmaxf(v[u].z, v[u].w));
      mx = fmaxf(mx, dppf<0x128>(mx)); mx = fmaxf(mx, dppf<0x124>(mx)); mx = fmaxf(mx, dppf<0x122>(mx)); mx = fmaxf(mx, dppf<0x121>(mx));
      {
        const int xi = __builtin_bit_cast(int, mx);
        const float m0 = __builtin_bit_cast(float, __builtin_amdgcn_readlane(xi, 0));
        const float m1 = __builtin_bit_cast(float, __builtin_amdgcn_readlane(xi, 16));
        const float m2 = __builtin_bit_cast(float, __builtin_amdgcn_readlane(xi, 32));
        const float m3 = __builtin_bit_cast(float, __builtin_amdgcn_readlane(xi, 48));
        mx = fmaxf(fmaxf(m0, m1), fmaxf(m2, m3));
      }
      const float e0 = __expf(v[u].x - mx), e1 = __expf(v[u].y - mx), e2 = __expf(v[u].z - mx), e3 = __expf(v[u].w - mx);
      const float inv = 1.f / wave_sum_dpp(e0 + e1 + e2 + e3);
      if (i2 < total) {
        uint2 w;
        w.x = pack2(e0 * inv, e1 * inv);
        w.y = pack2(e2 * inv, e3 * inv);
        *(uint2*)(pb + (size_t)i2 * 256 + lane * 4) = w;
      }
    }
  }
}
DEV void phase_ca_pv(const Params& p, char* smem) {
  const bf16_t* pb = (const bf16_t*)(p.ws + O_H);
  const bf16_t* vt = (const bf16_t*)(p.ws + O_VT);
  bf16_t* attn = (bf16_t*)(p.ws + O_XB);
  int rt, ct8;
  for (int it = 0; tile_map(it, 8, rt, ct8); ++it) {
    const int h = ct8 >> 1, nt = ct8 & 1;
    const int b = seq_of_rowtile(rt), r0 = rt * TM;
    gemm_tile(pb + (size_t)r0 * DM + h * 256, DM, nullptr, 0, 256,
              vt + ((size_t)b * 1024 + h * 256 + nt * 128) * 256, 256, 256, smem,
              [&](int ru, int rl, int c, float v0, float v1) {
                bf16_t* o = attn + (size_t)(r0 + ru) * DM + h * 256 + nt * 128;
                const unsigned off = (unsigned)(rl * DM + c);
                o[off] = f2bf(v0); o[off + 32] = f2bf(v1);
              });
  }
}

DEV void phase_convert_x(const Params& p) {
  bf16_t* xb = (bf16_t*)(p.ws + O_XB);
  const size_t n4 = (size_t)NTOK * DM / 4;
  const size_t np4 = (size_t)NPROMPT * DM / 4;
  const size_t stride = (size_t)gridDim.x * 256;
  for (size_t i = (size_t)blockIdx.x * 256 + threadIdx.x; i < n4; i += 8 * stride) {
    float4 v[8];
#pragma unroll
    for (int u = 0; u < 8; ++u) {
      size_t j = i + u * stride;
      if (j >= n4) j = i;
      v[u] = j < np4 ? ((const float4*)p.in[0])[j] : ((const float4*)p.in[1])[j - np4];
    }
#pragma unroll
    for (int u = 0; u < 8; ++u) {
      const size_t j = i + u * stride;
      if (j < n4) {
        uint2 w;
        w.x = pack2(v[u].x, v[u].y);
        w.y = pack2(v[u].z, v[u].w);
        ((uint2*)xb)[j] = w;
      }
    }
  }
}

constexpr int NPHASE = 25;
constexpr int SMEM_BYTES = 64 * 1024;

DEV void run_phase(const Params& p, int ph, char* smem) {
  char* ws = p.ws;
    switch (ph) {
      case 0:
        wconv(p.in[4], 2 * DFF, DM, 2 * DFF, 1, 0, (bf16_t*)(ws + W_A_FFN_IN), smem);
        wconv(p.in[5], DM, DFF, DM, 0, 0, (bf16_t*)(ws + W_A_FFN_OUT), smem);
        wconv(p.in[8], 3424, DM, 1568, 0, 0, (bf16_t*)(ws + W_A_MIX_IN), smem);
        wconv(p.in[8], 3424, DM, 1856, 0, 1568, (bf16_t*)(ws + W_A_MIX_IN) + (size_t)1664 * DM, smem);
        wconv(p.in[17], 512, 64, 512, 0, 0, (bf16_t*)(ws + W_A_UPF), smem);
        wconv(p.in[19], 512, 64, 512, 0, 0, (bf16_t*)(ws + W_A_UPB), smem);
        wconv(p.in[21], 512, 64, 512, 0, 0, (bf16_t*)(ws + W_A_AUP), smem);
        wconv(p.in[22], 512, 128, 512, 0, 0, (bf16_t*)(ws + W_A_GUP), smem);
        phase_convert_x(p);
        break;
      case 1: phase_ffn_in(p, (const bf16_t*)(ws + W_A_FFN_IN), smem); break;
      case 2: phase_gemm_res(p, (const bf16_t*)(ws + O_H), DFF, nullptr, 0, DFF, DFF, (const bf16_t*)(ws + W_A_FFN_OUT), 0.5f, true, smem); break;
      case 3: phase_ln(p, p.in[6], p.in[7], true, false); break;
      case 4: phase_gemm_bf16((const bf16_t*)(ws + O_XB), DM, (const bf16_t*)(ws + W_A_MIX_IN), DM, 1568, (bf16_t*)(ws + O_H), GLA_LD, smem); break;
      case 5: phase_gla_a(p, smem); break;
      case 6: phase_gla_b(p); break;
      case 7: phase_gla_c(p, smem); break;
      case 8: phase_gemm_bf16((const bf16_t*)(ws + O_XB), DM, (const bf16_t*)(ws + W_A_MIX_IN) + (size_t)1664 * DM, DM, 1856, (bf16_t*)(ws + O_H), RW_LD, smem); break;
      case 9: phase_rw_act(p); break;
      case 10: phase_rw_lowrank(p, smem); break;
      case 11: phase_rw_pre(p); break;
      case 12: phase_rw_scan(p, smem); break;
      case 13: phase_gemm_bf16((const bf16_t*)(ws + O_ACTG), 128, (const bf16_t*)(ws + W_A_GUP), 128, 512, (bf16_t*)(ws + O_DER) + 2 * SLAB, 512, smem); break;
      case 14:
        phase_rw_post(p);
        wconv(p.in[28], DM, DM, DM, 0, 0, (bf16_t*)(ws + W_B_MIX_OUT), smem);
        wconv(p.in[33], DM, DM, DM, 0, 0, (bf16_t*)(ws + W_B_Q), smem);
        wconv(p.in[34], 2 * DM, DM, 2 * DM, 0, 0, (bf16_t*)(ws + W_B_KV), smem);
        wconv(p.in[35], DM, DM, DM, 0, 0, (bf16_t*)(ws + W_B_O), smem);
        wconv(p.in[38], 2 * DFF, DM, 2 * DFF, 1, 0, (bf16_t*)(ws + W_B_FFN_IN), smem);
        wconv(p.in[39], DM, DFF, DM, 0, 0, (bf16_t*)(ws + W_B_FFN_OUT), smem);
        break;
      case 15: phase_gemm_res(p, (const bf16_t*)(ws + O_MIXG), 512, (const bf16_t*)(ws + O_XB), 512, 512, DM, (const bf16_t*)(ws + W_B_MIX_OUT), 1.0f, false, smem); break;
      case 16: phase_ln(p, p.in[29], p.in[30], true, true); break;
      case 17: phase_ca_qkv(p, smem); break;
      case 18: phase_ca_scores(p, smem); break;
      case 19: phase_ca_softmax(p); break;
      case 20: phase_ca_pv(p, smem); break;
      case 21: phase_gemm_res(p, (const bf16_t*)(ws + O_XB), DM, nullptr, 0, DM, DM, (const bf16_t*)(ws + W_B_O), 1.0f, false, smem); break;
      case 22: phase_ln(p, p.in[36], p.in[37], true, false); break;
      case 23: phase_ffn_in(p, (const bf16_t*)(ws + W_B_FFN_IN), smem); break;
      case 24: phase_gemm_res(p, (const bf16_t*)(ws + O_H), DFF, nullptr, 0, DFF, DFF, (const bf16_t*)(ws + W_B_FFN_OUT), 0.5f, false, smem); break;
      case 25: phase_ln(p, p.in[40], p.in[41], false, false); break;
      default: break;
    }
}

constexpr size_t O_BAR = 463 * MiB + 768 * 1024;
#define XB_TMO      128
#define XB_XCNT(j)  (256  + 64 * (j))
#define XB_XSUB(j)  (1280 + 64 * (j))
#define XB_XGEN(j)  (2304 + 64 * (j))
#define XB_TOP      3328
#define XB_TOPGEN   3392
#define XCD_BAR_WORDS 3456
#define XB_SPIN_CAP (1u << 18)
#define LAS __attribute__((address_space(3)))

__device__ __forceinline__ unsigned xb_ld(unsigned* p)              { return __hip_atomic_load(p, __ATOMIC_RELAXED, __HIP_MEMORY_SCOPE_AGENT); }
__device__ __forceinline__ unsigned xb_add(unsigned* p, unsigned v) { return __hip_atomic_fetch_add(p, v, __ATOMIC_RELAXED, __HIP_MEMORY_SCOPE_AGENT); }
__device__ __forceinline__ unsigned xb_xcc_id() { return (unsigned)__builtin_amdgcn_s_getreg((3 << 11) | 20) & 0xFu; }
#define XB_SPIN(cond, bar) do { unsigned _sp = 0; while (cond) { __builtin_amdgcn_s_sleep(16); \
    if ((++_sp & 255u) == 0u) { if (xb_ld(&(bar)[XB_TMO])) break; if (_sp > XB_SPIN_CAP) { atomicAdd(&(bar)[XB_TMO], 1u); break; } } } } while (0)

struct XcdBarrier {
    unsigned* bar; unsigned x;
    volatile LAS unsigned* st;
};

__device__ __forceinline__ XcdBarrier xcd_barrier_post(unsigned* bar, volatile LAS unsigned* st) {
    XcdBarrier b; b.bar = bar; b.x = xb_xcc_id(); b.st = st;
    if (threadIdx.x == 0) (void)xb_add(&bar[XB_XCNT(b.x)], 1u);
    return b;
}
__device__ __forceinline__ void xcd_barrier_complete(unsigned* bar, unsigned x, unsigned& nloc, unsigned& nx) {
    const unsigned G = gridDim.x * gridDim.y * gridDim.z;
    unsigned sum, cnt, mine, sp = 0u;
    for (;;) {
        sum = 0u; cnt = 0u; mine = 0u;
#pragma unroll
        for (unsigned j = 0; j < 16; ++j) { const unsigned c = xb_ld(&bar[XB_XCNT(j)]); sum += c; cnt += (c > 0u) ? 1u : 0u; mine = (j == x) ? c : mine; }
        if (sum == G) break;
        __builtin_amdgcn_s_sleep(1);
        if ((++sp & 255u) == 0u) { if (xb_ld(&bar[XB_TMO])) break; if (sp > XB_SPIN_CAP) { atomicAdd(&bar[XB_TMO], 1u); break; } }
    }
    nloc = mine > 0u ? mine : 1u; nx = cnt > 0u ? cnt : 1u;
}

__device__ __forceinline__ void xcd_barrier(const XcdBarrier& b) {
    asm volatile("s_waitcnt vmcnt(0)" ::: "memory");
    __syncthreads();
    if (threadIdx.x == 0) {
        unsigned* bar = b.bar;
        __builtin_amdgcn_s_waitcnt(0);
        unsigned nloc = b.st[0], nx = b.st[1];
        if (nloc == 0u) { xcd_barrier_complete(bar, b.x, nloc, nx); b.st[0] = nloc; b.st[1] = nx; }
        const unsigned old = xb_add(&bar[XB_XSUB(b.x)], 1u);
        const unsigned gen = old / nloc;
        if (old + 1u == (gen + 1u) * nloc) {
            __builtin_amdgcn_fence(__ATOMIC_RELEASE, "agent");
            asm volatile("s_waitcnt vmcnt(0)" ::: "memory");
            const unsigned og = xb_add(&bar[XB_TOP], 1u);
            const unsigned tg = og / nx;
            if (og + 1u == (tg + 1u) * nx) xb_add(&bar[XB_TOPGEN], 1u);
            else XB_SPIN(xb_ld(&bar[XB_TOPGEN]) == tg, bar);
            __builtin_amdgcn_fence(__ATOMIC_ACQUIRE, "agent");
            xb_add(&bar[XB_XGEN(b.x)], 1u);
            asm volatile("s_waitcnt vmcnt(0)" ::: "memory");
        } else {
            XB_SPIN(xb_ld(&bar[XB_XGEN(b.x)]) == gen, bar);
            __builtin_amdgcn_fence(__ATOMIC_ACQUIRE, "agent");
            asm volatile("s_waitcnt vmcnt(0)" ::: "memory");
        }
    }
    __syncthreads();
}

#define PHASE_STEP(N) if (ph_lo <= N && N < ph_hi) { for (int rep = 0; rep <= (int)((dup >> N) & 1u); ++rep) { run_phase(p, N, smem); if (N + 1 < ph_hi) { if (ph_lo < 0) grid.sync(); else { XcdBarrier xb_; xb_.bar = (unsigned*)(p.ws + O_BAR); xb_.st = (volatile LAS unsigned*)&xb_words; xb_.x = xb_.st[2]; xcd_barrier(xb_); } } } }
__global__ void __launch_bounds__(256, 2) mega(Params p, int ph_lo, int ph_hi, unsigned dup) {
  __shared__ __attribute__((aligned(16))) char smem[SMEM_BYTES];
  cg::grid_group grid = cg::this_grid();
  __shared__ uint4 xb_words;
  if (threadIdx.x == 0) xb_words = make_uint4(0u, 0u, 0u, 0u);
  __syncthreads();
  if (ph_hi - ph_lo > 1) {
    XcdBarrier xb = xcd_barrier_post((unsigned*)(p.ws + O_BAR), (volatile LAS unsigned*)&xb_words);
    if (threadIdx.x == 0) xb_words.z = xb.x;
    __syncthreads();
  }
  PHASE_STEP(0)
  PHASE_STEP(1)
  PHASE_STEP(2)
  PHASE_STEP(3)
  PHASE_STEP(4)
  PHASE_STEP(5)
  PHASE_STEP(6)
  PHASE_STEP(7)
  PHASE_STEP(8)
  PHASE_STEP(9)
  PHASE_STEP(10)
  PHASE_STEP(11)
  PHASE_STEP(12)
  PHASE_STEP(13)
  PHASE_STEP(14)
  PHASE_STEP(15)
  PHASE_STEP(16)
  PHASE_STEP(17)
  PHASE_STEP(18)
  PHASE_STEP(19)
  PHASE_STEP(20)
  PHASE_STEP(21)
  PHASE_STEP(22)
  PHASE_STEP(23)
  PHASE_STEP(24)
  PHASE_STEP(25)
}

#ifdef PHASE_TEST
template <int PH> __global__ void __launch_bounds__(256, 2) mega_t(Params p) {
  __shared__ __attribute__((aligned(16))) char smem[SMEM_BYTES];
  run_phase(p, PH, smem);
}
template __global__ void mega_t<0>(Params);
template __global__ void mega_t<1>(Params);
template __global__ void mega_t<2>(Params);
template __global__ void mega_t<3>(Params);
template __global__ void mega_t<4>(Params);
template __global__ void mega_t<5>(Params);
template __global__ void mega_t<6>(Params);
template __global__ void mega_t<7>(Params);
template __global__ void mega_t<8>(Params);
template __global__ void mega_t<9>(Params);
template __global__ void mega_t<10>(Params);
template __global__ void mega_t<11>(Params);
template __global__ void mega_t<12>(Params);
template __global__ void mega_t<13>(Params);
template __global__ void mega_t<14>(Params);
template __global__ void mega_t<15>(Params);
template __global__ void mega_t<16>(Params);
template __global__ void mega_t<17>(Params);
template __global__ void mega_t<18>(Params);
template __global__ void mega_t<19>(Params);
template __global__ void mega_t<20>(Params);
template __global__ void mega_t<21>(Params);
template __global__ void mega_t<22>(Params);
template __global__ void mega_t<23>(Params);
template __global__ void mega_t<24>(Params);
template __global__ void mega_t<25>(Params);
#endif

extern "C" void kernel_launch(void* const* d_in, const int* in_sizes, int n_in, void* d_out, int out_size,
                              void* d_ws, size_t ws_size, hipStream_t stream) {
  if (ws_size < WS_NEED || n_in < 42) {
    fprintf(stderr, "kernel_launch: workspace too small (%zu) or inputs missing (%d)\n", ws_size, n_in);
    return;
  }
  static int grid_blocks = 0;
  if (!grid_blocks) {
    int dev = 0, cus = 0, per_cu = 0;
    hipGetDevice(&dev);
    hipDeviceGetAttribute(&cus, hipDeviceAttributeMultiprocessorCount, dev);
    hipOccupancyMaxActiveBlocksPerMultiprocessor(&per_cu, mega, 256, 0);
    if (per_cu > 2) per_cu = 2;
    if (per_cu < 1) per_cu = 1;
    grid_blocks = cus * per_cu;
  }
  Params p{};
  for (int i = 0; i < 42; ++i) p.in[i] = (const float*)d_in[i];
  p.out = (float*)d_out;
  p.ws = (char*)d_ws;
  const int nph = NPHASE + 1;
#if MULTI_LAUNCH
  for (int ph = 0; ph < nph; ++ph) {
    hipLaunchKernelGGL(mega, dim3(grid_blocks), dim3(256), 0, stream, p, ph, ph + 1, 0u);
  }
#else
#ifndef PROBE_DUP
#define PROBE_DUP 0u
#endif
  hipMemsetAsync((char*)d_ws + O_BAR, 0, XCD_BAR_WORDS * 4, stream);
  int lo = 0, hi = nph;
  unsigned dup = PROBE_DUP;
  void* args[] = {&p, &lo, &hi, &dup};
  hipError_t e = hipLaunchCooperativeKernel((void*)mega, dim3(grid_blocks), dim3(256), args, 0, stream);
  if (e != hipSuccess) fprintf(stderr, "cooperative launch failed: %s (grid %d)\n", hipGetErrorString(e), grid_blocks);
#endif
}
```
